# Optimizing an MI355X kernel written in HIP

```python
import numpy as np
import jax
import jax.numpy as jnp
from jax import lax

D_MODEL = 1024
BATCH = 2
SEQ = 8192
DEPTH = 2

HEAD_DIM = 64
N_HEADS_MIX = 4
W_MIX = N_HEADS_MIX * HEAD_DIM
N_MIXERS = 4
QBLK = 128
ROPE_THETA = 500000.0
ROPE_DIMS = HEAD_DIM // 4
EPS = 1e-6
NEG = -1e30
BIG = 1e30

NSA_CMP_LEN = 32
NSA_CMP_STRIDE = 16
NSA_CMP_HIDDEN = 2 * HEAD_DIM
NSA_SEL_LEN = 64
NSA_TOPN = 16
NSA_WINDOW = 512

DIL_CONFIGS = ((128, 1), (512, 4), (2048, 16))

FOX_BIAS_INIT = 2.0

D_FF = 2816
N_EXPERTS = 8
TOP_K = 2
N_DENSE_LAYERS = (DEPTH + 1) // 2
N_MOE_LAYERS = DEPTH // 2

IN_SIZES = (W_MIX, 6 * HEAD_DIM, 3 * N_HEADS_MIX, 3 * W_MIX, 3 * W_MIX, 3 * W_MIX, N_HEADS_MIX, N_MIXERS * D_MODEL)
IN_COLS = sum(IN_SIZES)
POS_OFFSET_MAX = 4096

kernel_name = 'hybrid_nsa_dilated_stickbreak_fox_moe'


def rmsnorm(x, g):
    xf = x.astype(jnp.float32)
    y = xf * lax.rsqrt(jnp.mean(xf * xf, axis=-1, keepdims=True) + EPS)
    return (y * g).astype(x.dtype)


def rope_tables(positions):
    inv = ROPE_THETA ** (-jnp.arange(0, ROPE_DIMS, 2, dtype=jnp.float32) / ROPE_DIMS)
    ang = positions.astype(jnp.float32)[..., None] * inv
    return jnp.cos(ang), jnp.sin(ang)


def apply_rope(x, cos, sin):
    if x.ndim == 4:
        cos, sin = cos[:, :, None, :], sin[:, :, None, :]
    half = ROPE_DIMS // 2
    x1, x2, rest = x[..., :half], x[..., half:ROPE_DIMS], x[..., ROPE_DIMS:]
    rot = jnp.concatenate([x1 * cos - x2 * sin, x2 * cos + x1 * sin], axis=-1).astype(x.dtype)
    return jnp.concatenate([rot, rest], axis=-1)


def masked_softmax(s, mask):
    p = jax.nn.softmax(jnp.where(mask, s, NEG), axis=-1)
    return jnp.where(mask, p, 0.0)


def to_blocks(a):
    b, s = a.shape[:2]
    return jnp.moveaxis(a.reshape(b, s // QBLK, QBLK, *a.shape[2:]), 1, 0)


def from_blocks(a):
    a = jnp.moveaxis(a, 0, 1)
    return a.reshape(a.shape[0], -1, *a.shape[3:])


def compress(x, pe, w1, w2):
    b, s, dh = x.shape
    r = NSA_CMP_LEN // NSA_CMP_STRIDE
    ch = x.reshape(b, s // NSA_CMP_STRIDE, NSA_CMP_STRIDE, dh)
    nc = ch.shape[1] - r + 1
    blk = jnp.concatenate([ch[:, i:i + nc] for i in range(r)], axis=2) + pe
    return jax.nn.gelu(blk.reshape(b, nc, NSA_CMP_LEN * dh) @ w1) @ w2


def cmp_to_sel_overlap(nc, n_sel):
    c0 = np.arange(nc) * NSA_CMP_STRIDE
    c1 = c0 + NSA_CMP_LEN
    s0 = np.arange(n_sel) * NSA_SEL_LEN
    s1 = s0 + NSA_SEL_LEN
    return ((c0[:, None] < s1[None, :]) & (c1[:, None] > s0[None, :])).astype(np.float32)


def nsa_attention(q_nr, q_r, kc_raw, vc_raw, ks, vs, kw, vw, gate_logits, pe_k, pe_v, ck1, ck2, cv1, cv2):
    b, s, h, dh = q_r.shape
    scale = dh ** -0.5
    t_idx = jnp.arange(s)
    kc = compress(kc_raw, pe_k, ck1, ck2)
    vc = compress(vc_raw, pe_v, cv1, cv2)
    nc = kc.shape[1]
    c_end = jnp.arange(nc) * NSA_CMP_STRIDE + NSA_CMP_LEN - 1
    c_mask = c_end[None, :] <= t_idx[:, None]
    sc = jnp.einsum('bthd,bcd->bhtc', q_nr, kc).astype(jnp.float32) * scale
    p_cmp = masked_softmax(sc, c_mask)
    o_cmp = jnp.einsum('bhtc,bcd->bthd', p_cmp.astype(vc.dtype), vc)
    n_sel = s // NSA_SEL_LEN
    n_top = min(NSA_TOPN, n_sel)
    overlap = jnp.asarray(cmp_to_sel_overlap(nc, n_sel))
    imp = jnp.einsum('bhtc,cj->btj', p_cmp, overlap)
    j = jnp.arange(n_sel)[None, :]
    cur = (t_idx // NSA_SEL_LEN)[:, None]
    valid = j <= cur
    forced = (j == 0) | (j == cur) | (j == cur - 1)
    score = jnp.where(valid, jnp.where(forced, BIG, imp), NEG)
    _, sel = lax.top_k(score, n_top)
    ks_blk = ks.reshape(b, n_sel, NSA_SEL_LEN, dh)
    vs_blk = vs.reshape(b, n_sel, NSA_SEL_LEN, dh)
    gather = jax.vmap(lambda kb, ib: kb[ib])

    def sel_block(args):
        qb, ib, t0 = args
        t = t0 + jnp.arange(QBLK)
        kg = gather(ks_blk, ib)
        vg = gather(vs_blk, ib)
        sco = jnp.einsum('bqhd,bqnld->bhqnl', qb, kg).astype(jnp.float32) * scale
        kpos = ib[..., None] * NSA_SEL_LEN + jnp.arange(NSA_SEL_LEN)
        m = (kpos <= t[None, :, None, None]).reshape(b, 1, QBLK, -1)
        p = masked_softmax(sco.reshape(b, h, QBLK, -1), m).reshape(b, h, QBLK, n_top, NSA_SEL_LEN)
        return jnp.einsum('bhqnl,bqnld->bqhd', p.astype(vg.dtype), vg)

    starts = jnp.arange(s // QBLK) * QBLK
    o_sel = from_blocks(lax.map(sel_block, (to_blocks(q_r), to_blocks(sel), starts)))
    nb = s // QBLK
    wc = NSA_WINDOW // QBLK

    def band(a):
        ac = jnp.pad(a.reshape(b, nb, QBLK, dh), ((0, 0), (wc, 0), (0, 0), (0, 0)))
        return jnp.concatenate([ac[:, i:i + nb] for i in range(wc + 1)], axis=2)

    kb, vb = band(kw), band(vw)
    qpos = t_idx.reshape(nb, QBLK)
    kpos = jnp.arange(nb)[:, None] * QBLK - NSA_WINDOW + jnp.arange((wc + 1) * QBLK)[None, :]
    diff = qpos[:, :, None] - kpos[:, None, :]
    wmask = (kpos[:, None, :] >= 0) & (diff >= 0) & (diff < NSA_WINDOW)
    sw = jnp.einsum('bnqhd,bnkd->bhnqk', q_r.reshape(b, nb, QBLK, h, dh), kb).astype(jnp.float32) * scale
    pw = masked_softmax(sw, wmask)
    o_win = jnp.einsum('bhnqk,bnkd->bnqhd', pw.astype(vb.dtype), vb).reshape(b, s, h, dh)
    g = jax.nn.sigmoid(gate_logits).reshape(b, s, h, 3, 1)
    return g[:, :, :, 0] * o_cmp + g[:, :, :, 1] * o_sel + g[:, :, :, 2] * o_win


def dilated_attention(q, k, v):
    b, s, h, dh = q.shape
    scale = dh ** -0.5

    def blk(args):
        qb, t0 = args
        t = t0 + jnp.arange(QBLK)
        outs, lses = [], []
        for (w, d) in DIL_CONFIGS:
            m = jnp.arange(w // d + 1)
            idx = t[:, None] - m[None, :] * d
            valid = idx >= 0
            idx = jnp.maximum(idx, 0)
            kg, vg = k[:, idx], v[:, idx]
            sco = jnp.einsum('bqhd,bqmhd->bhqm', qb, kg).astype(jnp.float32) * scale
            sco = jnp.where(valid, sco, NEG)
            lse = jax.nn.logsumexp(sco, axis=-1)
            p = jnp.exp(sco - lse[..., None])
            outs.append(jnp.einsum('bhqm,bqmhd->bqhd', p.astype(vg.dtype), vg))
            lses.append(lse)
        wts = jax.nn.softmax(jnp.stack(lses), axis=0)
        return jnp.einsum('gbhq,gbqhd->bqhd', wts.astype(v.dtype), jnp.stack(outs))

    starts = jnp.arange(s // QBLK) * QBLK
    return from_blocks(lax.map(blk, (to_blocks(q), starts)))


def stick_breaking_attention(q, k, v):
    b, s, h, dh = q.shape
    scale = dh ** -0.5
    s_idx = jnp.arange(s)

    def blk(args):
        qb, t0 = args
        t = t0 + jnp.arange(QBLK)
        z = jnp.einsum('bqhd,bshd->bhqs', qb, k).astype(jnp.float32) * scale
        strict = s_idx[None, :] < t[:, None]
        log_1mb = jnp.where(strict, jax.nn.log_sigmoid(-z), 0.0)
        after = lax.cumsum(log_1mb, axis=3, reverse=True) - log_1mb
        a = jnp.where(strict, jnp.exp(jax.nn.log_sigmoid(z) + after), 0.0)
        return jnp.einsum('bhqs,bshd->bqhd', a.astype(v.dtype), v)

    starts = jnp.arange(s // QBLK) * QBLK
    return from_blocks(lax.map(blk, (to_blocks(q), starts)))


def forgetting_attention(q, k, v, log_f):
    b, s, h, dh = q.shape
    scale = dh ** -0.5
    fc = jnp.cumsum(log_f, axis=1)
    f_k = jnp.transpose(fc, (0, 2, 1))
    s_idx = jnp.arange(s)

    def blk(args):
        qb, fq, t0 = args
        t = t0 + jnp.arange(QBLK)
        sco = jnp.einsum('bqhd,bshd->bhqs', qb, k).astype(jnp.float32) * scale
        sco = sco + jnp.transpose(fq, (0, 2, 1))[..., None] - f_k[:, :, None, :]
        p = masked_softmax(sco, s_idx[None, :] <= t[:, None])
        return jnp.einsum('bhqs,bshd->bqhd', p.astype(v.dtype), v)

    starts = jnp.arange(s // QBLK) * QBLK
    return from_blocks(lax.map(blk, (to_blocks(q), to_blocks(fc), starts)))


def hybrid_mixer(h, cos, sin, w_in, qk_gain, pe_k, pe_v, ck1, ck2, cv1, cv2, fox_b, w_branch, w_out):
    b, s, _ = h.shape
    split_at = [int(v) for v in np.cumsum(IN_SIZES)[:-1]]
    a_q, a_kv, a_g, b_qkv, c_qkv, d_qkv, d_f, merge_logits = jnp.split(h @ w_in, split_at, axis=-1)
    heads = lambda t: t.reshape(b, s, N_HEADS_MIX, HEAD_DIM)
    q_a = rmsnorm(heads(a_q), qk_gain[0])
    kc, vc, ksl, vsl, kw, vw = jnp.split(a_kv, 6, axis=-1)
    o_a = nsa_attention(q_a, apply_rope(q_a, cos, sin), rmsnorm(kc, qk_gain[1]), vc,
                        apply_rope(rmsnorm(ksl, qk_gain[2]), cos, sin), vsl,
                        apply_rope(rmsnorm(kw, qk_gain[3]), cos, sin), vw,
                        a_g, pe_k, pe_v, ck1, ck2, cv1, cv2)
    qb, kb, vb = jnp.split(b_qkv, 3, axis=-1)
    o_b = dilated_attention(apply_rope(rmsnorm(heads(qb), qk_gain[4]), cos, sin),
                            apply_rope(rmsnorm(heads(kb), qk_gain[5]), cos, sin), heads(vb))
    qc, kc2, vc2 = jnp.split(c_qkv, 3, axis=-1)
    o_c = stick_breaking_attention(heads(qc), heads(kc2), heads(vc2))
    qd, kd, vd = jnp.split(d_qkv, 3, axis=-1)
    log_f = jax.nn.log_sigmoid((d_f + fox_b).astype(jnp.float32))
    o_d = forgetting_attention(rmsnorm(heads(qd), qk_gain[6]), rmsnorm(heads(kd), qk_gain[7]), heads(vd), log_f)
    o = jnp.stack([o_a, o_b, o_c, o_d]).reshape(N_MIXERS, b, s, W_MIX)
    y = jnp.einsum('mbsk,mkd->bsmd', o, w_branch)
    gates = jax.nn.sigmoid(merge_logits).reshape(b, s, N_MIXERS, D_MODEL)
    return jnp.sum(gates * y, axis=2) @ w_out


def swiglu(h, w1, w3, w2):
    return (jax.nn.silu(h @ w1) * (h @ w3)) @ w2


def moe_swiglu(h, router_w, w1, w3, w2):
    b, s, d = h.shape
    xt = h.reshape(-1, d)
    logits = (xt @ router_w).astype(jnp.float32)
    top_v, top_i = lax.top_k(logits, TOP_K)
    gate = jax.nn.softmax(top_v, axis=-1)
    e_flat = top_i.reshape(-1)
    order = jnp.argsort(e_flat)
    tok = order // TOP_K
    xs = xt[tok]
    sizes = jax.ops.segment_sum(jnp.ones_like(e_flat), e_flat, num_segments=N_EXPERTS).astype(jnp.int32)
    a = lax.ragged_dot(xs, w1, sizes)
    g = lax.ragged_dot(xs, w3, sizes)
    y = lax.ragged_dot(jax.nn.silu(a) * g, w2, sizes)
    y = y * gate.reshape(-1)[order][:, None].astype(y.dtype)
    return jnp.zeros_like(xt).at[tok].add(y).reshape(b, s, d)


def setup_inputs(seed: int = 0) -> dict:
    key = jax.random.key(seed)
    ks = jax.random.split(key, 28)
    f32 = jnp.float32

    def nrm(k, shape, fan_in, gain=1.0):
        return jax.random.normal(k, shape, f32) * (gain * fan_in ** -0.5)

    def gain(k, shape):
        return 1.0 + 0.02 * jax.random.normal(k, shape, f32)

    cl = NSA_CMP_LEN * HEAD_DIM
    return {
        'x': jax.random.normal(ks[0], (BATCH, SEQ, D_MODEL), f32),
        'c': jax.random.normal(ks[1], (BATCH, D_MODEL), f32),
        'positions': jnp.arange(SEQ, dtype=jnp.int32)[None, :] + jax.random.randint(ks[2], (BATCH, 1), 0, POS_OFFSET_MAX, dtype=jnp.int32),
        'w_ada': nrm(ks[3], (DEPTH, D_MODEL, 6 * D_MODEL), D_MODEL, 0.5),
        'b_ada': 0.02 * jax.random.normal(ks[4], (DEPTH, 6 * D_MODEL), f32),
        'norm_mix': gain(ks[5], (DEPTH, D_MODEL)),
        'norm_ffn': gain(ks[6], (DEPTH, D_MODEL)),
        'w_in': nrm(ks[7], (DEPTH, D_MODEL, IN_COLS), D_MODEL),
        'qk_gain': gain(ks[8], (DEPTH, 8, HEAD_DIM)),
        'nsa_pe_k': 0.02 * jax.random.normal(ks[9], (DEPTH, NSA_CMP_LEN, HEAD_DIM), f32),
        'nsa_pe_v': 0.02 * jax.random.normal(ks[10], (DEPTH, NSA_CMP_LEN, HEAD_DIM), f32),
        'nsa_ck_w1': nrm(ks[11], (DEPTH, cl, NSA_CMP_HIDDEN), cl),
        'nsa_ck_w2': nrm(ks[12], (DEPTH, NSA_CMP_HIDDEN, HEAD_DIM), NSA_CMP_HIDDEN),
        'nsa_cv_w1': nrm(ks[13], (DEPTH, cl, NSA_CMP_HIDDEN), cl),
        'nsa_cv_w2': nrm(ks[14], (DEPTH, NSA_CMP_HIDDEN, HEAD_DIM), NSA_CMP_HIDDEN),
        'fox_bias': FOX_BIAS_INIT + 0.1 * jax.random.normal(ks[15], (DEPTH, N_HEADS_MIX), f32),
        'w_branch': nrm(ks[16], (DEPTH, N_MIXERS, W_MIX, D_MODEL), W_MIX),
        'w_out': nrm(ks[17], (DEPTH, D_MODEL, D_MODEL), D_MODEL),
        'ffn_w1': nrm(ks[18], (N_DENSE_LAYERS, D_MODEL, D_FF), D_MODEL),
        'ffn_w3': nrm(ks[19], (N_DENSE_LAYERS, D_MODEL, D_FF), D_MODEL),
        'ffn_w2': nrm(ks[20], (N_DENSE_LAYERS, D_FF, D_MODEL), D_FF),
        'router_w': nrm(ks[21], (N_MOE_LAYERS, D_MODEL, N_EXPERTS), D_MODEL),
        'moe_w1': nrm(ks[22], (N_MOE_LAYERS, N_EXPERTS, D_MODEL, D_FF), D_MODEL),
        'moe_w3': nrm(ks[23], (N_MOE_LAYERS, N_EXPERTS, D_MODEL, D_FF), D_MODEL),
        'moe_w2': nrm(ks[24], (N_MOE_LAYERS, N_EXPERTS, D_FF, D_MODEL), D_FF),
    }


def reference(x, c, positions, w_ada, b_ada, norm_mix, norm_ffn, w_in, qk_gain, nsa_pe_k, nsa_pe_v,
              nsa_ck_w1, nsa_ck_w2, nsa_cv_w1, nsa_cv_w2, fox_bias, w_branch, w_out,
              ffn_w1, ffn_w3, ffn_w2, router_w, moe_w1, moe_w3, moe_w2):
    cos, sin = rope_tables(positions)
    c_act = jax.nn.silu(c)
    for l in range(DEPTH):
        mod = (c_act @ w_ada[l] + b_ada[l])[:, None, :]
        sh_a, sc_a, g_a, sh_f, sc_f, g_f = jnp.split(mod, 6, axis=-1)
        h = rmsnorm(x, norm_mix[l]) * (1.0 + sc_a) + sh_a
        x = x + g_a * hybrid_mixer(h, cos, sin, w_in[l], qk_gain[l], nsa_pe_k[l], nsa_pe_v[l],
                                   nsa_ck_w1[l], nsa_ck_w2[l], nsa_cv_w1[l], nsa_cv_w2[l],
                                   fox_bias[l], w_branch[l], w_out[l])
        h = rmsnorm(x, norm_ffn[l]) * (1.0 + sc_f) + sh_f
        if l % 2 == 0:
            f = swiglu(h, ffn_w1[l // 2], ffn_w3[l // 2], ffn_w2[l // 2])
        else:
            f = moe_swiglu(h, router_w[l // 2], moe_w1[l // 2], moe_w3[l // 2], moe_w2[l // 2])
        x = x + g_f * f
    return x
```

```cpp
#include <hip/hip_runtime.h>
#include <cstdio>
#include <cstdint>

#ifndef MK_ONE_LAUNCH
#define MK_ONE_LAUNCH 0
#endif
#ifndef PHMASK
#define PHMASK 0xFFFFu
#endif
#define PHON(k) (((PHMASK) >> (k)) & 1u)

namespace pg8 {
#define PG8_LAS __attribute__((address_space(3)))
typedef unsigned short bf16_t;
typedef short bf16x8 __attribute__((ext_vector_type(8)));
typedef float f32x4 __attribute__((ext_vector_type(4)));
typedef unsigned u32x4 __attribute__((ext_vector_type(4)));
constexpr int BM = 256, BK = 64, HALF = 128, HTB = HALF * BK * 2, STAGE_BYTES = 8 * HTB, NXCD = 8, WGM = 8;

__host__ __device__ __forceinline__ int lds_byte(int r, int c) { const int st = (r >> 4) * 2 + (c >> 5), rr = r & 15, cc = c & 31, ob = rr * 64 + cc * 2; return st * 1024 + (ob ^ (((ob >> 9) & 1) << 5)); }
__host__ __device__ __forceinline__ void stage_rc(int b, int& R, int& C) { const int st = b / 1024, sb = b % 1024, swz = sb ^ (((sb >> 9) & 1) << 5); R = (st >> 1) * 16 + swz / 64; C = (st & 1) * 32 + (swz % 64) / 2; }
__host__ __device__ __forceinline__ int perm32(int rho) { const int n = rho >> 4, i = rho & 15; return 8 * (i >> 2) + 4 * n + (i & 3); }

struct Unit { int pm, pn, z; };
struct Gemm { const bf16_t* A; const bf16_t* Bt; int lda; int K; };

__host__ __device__ __forceinline__ void tile_pmpn(int wgid, int nM, int nN, int& pm, int& pn) {
    const int nwg = nM * nN;
    { const int q = nwg / NXCD, r = nwg % NXCD, xcd = wgid % NXCD, off = wgid / NXCD; wgid = (xcd < r ? xcd * (q + 1) : r * (q + 1) + (xcd - r) * q) + off; }
    const int nig = WGM * nN, gid = wgid / nig, fm = gid * WGM, gsz = (nM - fm) < WGM ? (nM - fm) : WGM;
    pm = fm + ((wgid % nig) % gsz); pn = (wgid % nig) / gsz;
}
struct StaticOrder {
    int nM, nN, nwg, G, c;
    __device__ void init(int M, int N, int G_, int c_) { nM = M / BM; nN = N / BM; nwg = nM * nN; G = G_; c = c_; }
    __device__ bool next(int i, Unit& u) const { const long L = (long)i * G + c; if (L >= nwg) return false; tile_pmpn((int)L, nM, nN, u.pm, u.pn); u.z = 0; return true; }
    __device__ const char* a_base(const Gemm& g, const Unit& u) const { return (const char*)g.A + (size_t)u.pm * BM * g.lda * 2; }
    __device__ const char* b_base(const Gemm& g, const Unit& u) const { return (const char*)g.Bt + (size_t)u.pn * BM * g.K * 2; }
    __device__ int row_tok(const Unit&, int) const { return 0; }
};
struct BranchOrder {
    int nM, nN, nwg, G, c;
    __device__ void init(int M, int N, int G_, int c_) { nM = M / BM; nN = N / BM; nwg = nM * nN; G = G_; c = c_; }
    __device__ bool next(int i, Unit& u) const { const long L = (long)(i >> 2) * G + c; if (L >= nwg) return false; tile_pmpn((int)L, nM, nN, u.pm, u.pn); u.z = i & 3; return true; }
    __device__ const char* a_base(const Gemm& g, const Unit& u) const { return (const char*)g.A + ((size_t)u.pm * BM * g.lda + (size_t)u.z * 256) * 2; }
    __device__ const char* b_base(const Gemm& g, const Unit& u) const { return (const char*)g.Bt + ((size_t)u.z * 1024 * 256 + (size_t)u.pn * BM * g.K) * 2; }
    __device__ int row_tok(const Unit&, int) const { return 0; }
};
struct MoeOrder {
    int G, c, nN; int pre[9]; const int* list; int cnt[8]; size_t zstrideB;
    __device__ void init(unsigned* counts, const int* list_, int nN_, size_t zstrideB_, int G_, int c_) {
        G = G_; c = c_; nN = nN_; list = list_; zstrideB = zstrideB_; int p = 0;
#pragma unroll
        for (int e = 0; e < 8; ++e) { int n = __builtin_amdgcn_readfirstlane((int)__hip_atomic_load(counts + 64 * e, __ATOMIC_RELAXED, __HIP_MEMORY_SCOPE_AGENT)); if (n > 16384) n = 16384; cnt[e] = n; pre[e] = p; p += (n + 255) >> 8; }
        pre[8] = p;
    }
    __device__ bool next(int i, Unit& u) const {
        const long L = (long)i * G + c; if (L >= (long)pre[8] * nN) return false;
        const int rt = (int)(L / nN); u.pn = (int)(L % nN); u.pm = rt; int e = 0;
#pragma unroll
        for (int k = 1; k < 8; ++k) e += (rt >= pre[k]) ? 1 : 0;
        u.z = e; return true;
    }
    __device__ const char* a_base(const Gemm& g, const Unit& u) const { return (const char*)g.A + (size_t)u.pm * BM * g.lda * 2; }
    __device__ const char* b_base(const Gemm& g, const Unit& u) const { return (const char*)g.Bt + ((size_t)u.z * zstrideB + (size_t)u.pn * BM * g.K) * 2; }
    __device__ int row_tok(const Unit& u, int r) const {
        int e = 0, c0 = 0, p0 = 0;
#pragma unroll
        for (int k = 0; k < 8; ++k) if (k == u.z) { c0 = cnt[k]; p0 = pre[k]; }
        const int idx = (u.pm - p0) * 256 + r; (void)e;
        return idx < c0 ? list[u.z * 16384 + idx] : 0;
    }
};

__device__ __forceinline__ int lane_id_fresh_pg8() { int l; asm volatile("v_mbcnt_lo_u32_b32 %0, -1, 0\n\tv_mbcnt_hi_u32_b32 %0, -1, %0" : "=v"(l)); return l; }
__device__ __forceinline__ unsigned cvt_pk_bf16(float lo, float hi) { unsigned r; asm volatile("v_cvt_pk_bf16_f32 %0, %1, %2" : "=v"(r) : "v"(lo), "v"(hi)); return r; }

struct EpiStore {
    static constexpr bool PERM = true;
    bf16_t* O; int ldc;
    __device__ __forceinline__ void operator()(const f32x4 (&acc)[2][2][4][2], const Unit& u, int wr, int wc, int fr, int fq) const {
        const unsigned base = ((unsigned)(u.pm * BM + wr * 64 + fr) * (unsigned)ldc + (unsigned)(u.pn * BM + wc * 32 + 8 * fq)) * 2u;
        char* Ob = (char*)O;
#pragma unroll
        for (int ai = 0; ai < 2; ++ai)
#pragma unroll
            for (int m = 0; m < 4; ++m) { const unsigned off = base + (unsigned)((ai * HALF + m * 16) * 2) * (unsigned)ldc;
#pragma unroll
                for (int bj = 0; bj < 2; ++bj) { const f32x4 v0 = acc[ai][bj][m][0], v1 = acc[ai][bj][m][1];
                    u32x4 w; w.x = cvt_pk_bf16(v0[0], v0[1]); w.y = cvt_pk_bf16(v0[2], v0[3]); w.z = cvt_pk_bf16(v1[0], v1[1]); w.w = cvt_pk_bf16(v1[2], v1[3]);
                    *(u32x4*)(Ob + (off + (unsigned)(bj * HALF * 2))) = w; } }
    }
};
__device__ __forceinline__ float silu_f(float a) { return a * __builtin_amdgcn_rcpf(1.0f + __expf(-a)); }
struct EpiSwiglu {
    static constexpr bool PERM = true;
    bf16_t* O; int ldc;
    __device__ __forceinline__ void operator()(const f32x4 (&acc)[2][2][4][2], const Unit& u, int wr, int wc, int fr, int fq) const {
        const unsigned base = ((unsigned)(u.pm * BM + wr * 64 + fr) * (unsigned)ldc + (unsigned)(u.pn * HALF + wc * 32 + 8 * fq)) * 2u;
        char* Ob = (char*)O;
#pragma unroll
        for (int ai = 0; ai < 2; ++ai)
#pragma unroll
            for (int m = 0; m < 4; ++m) { const unsigned off = base + (unsigned)((ai * HALF + m * 16) * 2) * (unsigned)ldc;
                float h[8];
#pragma unroll
                for (int n = 0; n < 2; ++n)
#pragma unroll
                    for (int j = 0; j < 4; ++j) h[n * 4 + j] = silu_f(acc[ai][0][m][n][j]) * acc[ai][1][m][n][j];
                u32x4 w; w.x = cvt_pk_bf16(h[0], h[1]); w.y = cvt_pk_bf16(h[2], h[3]); w.z = cvt_pk_bf16(h[4], h[5]); w.w = cvt_pk_bf16(h[6], h[7]);
                *(u32x4*)(Ob + off) = w; }
    }
};
struct EpiResid {
    static constexpr bool PERM = false;
    const float* xin; float* out; const float* gate; int gate_bstride;
    __device__ __forceinline__ void operator()(const f32x4 (&acc)[2][2][4][2], const Unit& u, int wr, int wc, int fr, int fq) const {
        const int b = (u.pm * BM) >> 13; const int col0 = u.pn * BM + wc * 32 + 4 * fq;
        f32x4 gv[2][2];
#pragma unroll
        for (int bj = 0; bj < 2; ++bj)
#pragma unroll
            for (int n = 0; n < 2; ++n) gv[bj][n] = *(const f32x4*)(gate + (size_t)b * gate_bstride + col0 + bj * HALF + n * 16);
        const unsigned base = ((unsigned)(u.pm * BM + wr * 64 + fr) * 1024u + (unsigned)col0) * 4u;
        const char* xb = (const char*)xin; char* ob = (char*)out;
#pragma unroll
        for (int ai = 0; ai < 2; ++ai)
#pragma unroll
            for (int m = 0; m < 4; ++m) { const unsigned off = base + (unsigned)((ai * HALF + m * 16) * 4096);
#pragma unroll
                for (int bj = 0; bj < 2; ++bj)
#pragma unroll
                    for (int n = 0; n < 2; ++n) { const unsigned o2 = off + (unsigned)((bj * HALF + n * 16) * 4); const f32x4 xi = *(const f32x4*)(xb + o2); *(f32x4*)(ob + o2) = xi + gv[bj][n] * acc[ai][bj][m][n]; }
                if (m & 1) asm volatile("" ::: "memory"); }
    }
};
__device__ __forceinline__ float sigmoid_f(float a) { return __builtin_amdgcn_rcpf(1.0f + __expf(-a)); }
struct EpiGate {
    static constexpr bool PERM = true;
    const bf16_t* proj; int ldp; int cmg; float* G; bf16_t* gated;
    __device__ __forceinline__ void operator()(const f32x4 (&acc)[2][2][4][2], const Unit& u, int wr, int wc, int fr, int fq) const {
        const unsigned row0 = (unsigned)(u.pm * BM + wr * 64 + fr), col0 = (unsigned)(u.pn * BM + wc * 32 + 8 * fq);
        const unsigned pbase = (row0 * (unsigned)ldp + (unsigned)(cmg + u.z * 1024) + col0) * 2u, gbase = (row0 * 1024u + col0) * 4u;
        const char* pb = (const char*)proj; char* gb = (char*)G; char* ob = (char*)gated;
#pragma unroll
        for (int ai = 0; ai < 2; ++ai)
#pragma unroll
            for (int m = 0; m < 4; ++m) { const unsigned rr = (unsigned)(ai * HALF + m * 16);
#pragma unroll
                for (int bj = 0; bj < 2; ++bj) {
                    const u32x4 mg = *(const u32x4*)(pb + (pbase + rr * (unsigned)(ldp * 2) + (unsigned)(bj * HALF * 2)));
                    const unsigned go = gbase + rr * 4096u + (unsigned)(bj * HALF * 4);
                    float v[8];
#pragma unroll
                    for (int k = 0; k < 4; ++k) { const unsigned w = mg[k]; const float l0 = __uint_as_float(w << 16), l1 = __uint_as_float(w & 0xffff0000u);
                        v[2 * k] = sigmoid_f(l0) * acc[ai][bj][m][k >> 1][(2 * k) & 3]; v[2 * k + 1] = sigmoid_f(l1) * acc[ai][bj][m][k >> 1][(2 * k + 1) & 3]; }
                    if (u.z != 0) { const f32x4 g0 = *(const f32x4*)(gb + go), g1 = *(const f32x4*)(gb + go + 16);
#pragma unroll
                        for (int k = 0; k < 4; ++k) { v[k] += g0[k]; v[4 + k] += g1[k]; } }
                    if (u.z != 3) { *(f32x4*)(gb + go) = (f32x4){v[0], v[1], v[2], v[3]}; *(f32x4*)(gb + go + 16) = (f32x4){v[4], v[5], v[6], v[7]}; }
                    else { u32x4 w; w.x = cvt_pk_bf16(v[0], v[1]); w.y = cvt_pk_bf16(v[2], v[3]); w.z = cvt_pk_bf16(v[4], v[5]); w.w = cvt_pk_bf16(v[6], v[7]); *(u32x4*)(ob + (go >> 1)) = w; } }
                asm volatile("" ::: "memory"); }
    }
};

template <class Epi, class Sched, bool ALIGN_EPI, bool GATHER>
__device__ __forceinline__ void gemm_phase(PG8_LAS unsigned char* lds, const Gemm g, const Sched& S, const Epi& E, int tid) {
    asm volatile("" : "+v"(tid));
    const int wid = __builtin_amdgcn_readfirstlane(tid >> 6), lane = tid & 63, wr = wid >> 2, wc = wid & 3, fr = lane & 15, fq = lane >> 4;
    int K = g.K; asm volatile("" : "+s"(K));
    const int nt = K / BK;
    unsigned voffA[2], voffB[2]; int RA[2], CA[2];
#pragma unroll
    for (int i = 0; i < 2; ++i) { int R, C; stage_rc(tid * 16 + i * 8192, R, C); const int Rb = Epi::PERM ? ((R & ~31) + perm32(R & 31)) : R;
        RA[i] = R; CA[i] = C; voffA[i] = (unsigned)(R * g.lda + C) * 2u; voffB[i] = (unsigned)(Rb * K + C) * 2u; }
    const size_t kstep = (size_t)(BK * 2);
    const size_t hstepA = (size_t)HALF * g.lda * 2, hstepB = (size_t)HALF * K * 2;
    const unsigned ldsw = (unsigned)wid * 1024u;
    const int aoff = lds_byte(wr * 64 + fr, fq * 8), boff = lds_byte(wc * 32 + fr, fq * 8);
#define PG8_SA(b, h) (((b) * 2 + (h)) * HTB)
#define PG8_SB(b, h) ((4 + (b) * 2 + (h)) * HTB)
#define PG8_STAGE(bufoff, gbase, voff) do { _Pragma("unroll") for (int _i = 0; _i < 2; ++_i) \
        __builtin_amdgcn_global_load_lds((const unsigned*)((const char*)(gbase) + (voff)[_i]), (PG8_LAS unsigned*)(lds + (bufoff) + ldsw + _i * 8192), 16, 0, 0); } while (0)
#define PG8_STAGE_A(bufoff, kbase, h, GV) do { if constexpr (GATHER) { PG8_STAGE(bufoff, kbase, (GV)[h]); } else { PG8_STAGE(bufoff, (kbase) + (h) * hstepA, voffA); } } while (0)
#define PG8_LDA(dst, b, h) do { _Pragma("unroll") for (int m = 0; m < 4; ++m) _Pragma("unroll") for (int k = 0; k < 2; ++k) dst[m][k] = *(const PG8_LAS bf16x8*)(lds + PG8_SA(b, h) + aoff + m * 2048 + k * 1024); } while (0)
#define PG8_LDB(dst, b, h) do { _Pragma("unroll") for (int n = 0; n < 2; ++n) _Pragma("unroll") for (int k = 0; k < 2; ++k) dst[n][k] = *(const PG8_LAS bf16x8*)(lds + PG8_SB(b, h) + boff + n * 2048 + k * 1024); } while (0)
#define PG8_MMA(ai, bj, At, Bt) do { __builtin_amdgcn_s_setprio(1); _Pragma("unroll") for (int m = 0; m < 4; ++m) _Pragma("unroll") for (int n = 0; n < 2; ++n) _Pragma("unroll") for (int k = 0; k < 2; ++k) \
        acc[ai][bj][m][n] = __builtin_amdgcn_mfma_f32_16x16x32_bf16(Bt[n][k], At[m][k], acc[ai][bj][m][n], 0, 0, 0); __builtin_amdgcn_s_setprio(0); } while (0)
#define PG8_WAIT_V(n) asm volatile("s_waitcnt vmcnt(" #n ")" ::: "memory")
#define PG8_WAIT_L(n) asm volatile("s_waitcnt lgkmcnt(" #n ")" ::: "memory")
#define PG8_BAR __builtin_amdgcn_s_barrier()
#define PG8_SCHED __builtin_amdgcn_sched_barrier(0)
#define PG8_GOFFS(dst, un) do { _Pragma("unroll") for (int _h = 0; _h < 2; ++_h) _Pragma("unroll") for (int _i = 0; _i < 2; ++_i) \
        dst[_h][_i] = (unsigned)S.row_tok(un, _h * HALF + RA[_i]) * (unsigned)(g.lda * 2) + (unsigned)(CA[_i] * 2); } while (0)
    Unit cur, nxt; int ui = 0;
    if (!S.next(0, cur)) return;
    f32x4 acc[2][2][4][2];
#pragma unroll
    for (int a = 0; a < 2; ++a)
#pragma unroll
        for (int b = 0; b < 2; ++b)
#pragma unroll
            for (int m = 0; m < 4; ++m)
#pragma unroll
                for (int n = 0; n < 2; ++n) acc[a][b][m][n] = (f32x4){0.f, 0.f, 0.f, 0.f};
    bf16x8 At[4][2], B0[2][2], B1[2][2];
    unsigned gC[2][2] = {{0u, 0u}, {0u, 0u}}, gN[2][2] = {{0u, 0u}, {0u, 0u}};
    const char* cA = GATHER ? (const char*)g.A : S.a_base(g, cur); const char* cB = S.b_base(g, cur);
    if constexpr (GATHER) { PG8_GOFFS(gC, cur); asm volatile("s_waitcnt vmcnt(0)" ::: "memory"); }
    PG8_STAGE(PG8_SB(0, 0), cB, voffB); PG8_STAGE(PG8_SB(0, 1), cB + hstepB, voffB); PG8_STAGE_A(PG8_SA(0, 0), cA, 0, gC); PG8_STAGE_A(PG8_SA(0, 1), cA, 1, gC);
    if (wr == 1) PG8_BAR;
    PG8_WAIT_V(2); PG8_BAR;
    PG8_STAGE(PG8_SB(1, 0), cB + kstep, voffB); PG8_STAGE_A(PG8_SA(1, 0), cA + kstep, 0, gC); PG8_STAGE(PG8_SB(1, 1), cB + hstepB + kstep, voffB);
    PG8_WAIT_V(6); PG8_BAR;
    for (;;) {
        const bool has_next = S.next(ui + 1, nxt);
        const char* nA = GATHER ? (const char*)g.A : (has_next ? S.a_base(g, nxt) : cA); const char* nB = has_next ? S.b_base(g, nxt) : cB;
        if constexpr (GATHER) {
            if (has_next) { PG8_GOFFS(gN, nxt); }
            else {
#pragma unroll
                for (int _h = 0; _h < 2; ++_h)
#pragma unroll
                    for (int _i = 0; _i < 2; ++_i) gN[_h][_i] = gC[_h][_i];
            }
        }
        for (int t = 0; t < nt; t += 2) {
            const bool last = (t == nt - 2);
            const char* a1 = cA + (size_t)(t + 1) * kstep;
            const char* a2 = last ? nA : cA + (size_t)(t + 2) * kstep; const char* b2 = last ? nB : cB + (size_t)(t + 2) * kstep;
            const char* a3 = a2 + kstep; const char* b3 = b2 + kstep;
            unsigned g2[2][2];
            if constexpr (GATHER) {
#pragma unroll
                for (int _h = 0; _h < 2; ++_h)
#pragma unroll
                    for (int _i = 0; _i < 2; ++_i) g2[_h][_i] = last ? gN[_h][_i] : gC[_h][_i];
            }
            PG8_LDB(B0, 0, 0); PG8_LDB(B1, 0, 1); PG8_SCHED; PG8_LDA(At, 0, 0); PG8_STAGE_A(PG8_SA(1, 1), a1, 1, gC);
            PG8_WAIT_V(8); PG8_WAIT_L(0); PG8_BAR; PG8_MMA(0, 0, At, B0); PG8_MMA(0, 1, At, B1); PG8_BAR; PG8_SCHED;
            PG8_LDA(At, 0, 1); PG8_STAGE(PG8_SB(0, 0), b2, voffB); PG8_STAGE(PG8_SB(0, 1), b2 + hstepB, voffB); PG8_STAGE_A(PG8_SA(0, 0), a2, 0, g2);
            PG8_WAIT_V(8); PG8_WAIT_L(0); PG8_BAR; PG8_MMA(1, 0, At, B0); PG8_MMA(1, 1, At, B1); PG8_BAR; PG8_SCHED;
            PG8_LDB(B0, 1, 0); PG8_LDB(B1, 1, 1); PG8_SCHED; PG8_LDA(At, 1, 0); PG8_STAGE_A(PG8_SA(0, 1), a2, 1, g2);
            PG8_WAIT_V(8); PG8_WAIT_L(0); PG8_BAR; PG8_MMA(0, 0, At, B0); PG8_MMA(0, 1, At, B1); PG8_BAR; PG8_SCHED;
            PG8_LDA(At, 1, 1); PG8_STAGE(PG8_SB(1, 0), b3, voffB); PG8_STAGE(PG8_SB(1, 1), b3 + hstepB, voffB); PG8_STAGE_A(PG8_SA(1, 0), a3, 0, g2);
            PG8_WAIT_V(8); PG8_WAIT_L(0); PG8_BAR; PG8_MMA(1, 0, At, B0); PG8_MMA(1, 1, At, B1); PG8_BAR; PG8_SCHED;
        }
        if constexpr (ALIGN_EPI) { if (wr == 0) PG8_BAR; }
        { const int l2_ = lane_id_fresh_pg8();
          E(acc, cur, wr, wc, l2_ & 15, l2_ >> 4); }
        if (!has_next) break;
#pragma unroll
        for (int a = 0; a < 2; ++a)
#pragma unroll
            for (int b = 0; b < 2; ++b)
#pragma unroll
                for (int m = 0; m < 4; ++m)
#pragma unroll
                    for (int n = 0; n < 2; ++n) acc[a][b][m][n] = (f32x4){0.f, 0.f, 0.f, 0.f};
        cur = nxt; cA = nA; cB = nB; ++ui;
        if constexpr (GATHER) {
#pragma unroll
            for (int _h = 0; _h < 2; ++_h)
#pragma unroll
                for (int _i = 0; _i < 2; ++_i) gC[_h][_i] = gN[_h][_i];
        }
        if constexpr (ALIGN_EPI) { if (wr == 1) PG8_BAR; }
    }
    PG8_WAIT_V(0);
    if constexpr (!ALIGN_EPI) { if (wr == 0) PG8_BAR; }
    PG8_BAR;
#undef PG8_SA
#undef PG8_SB
#undef PG8_STAGE
#undef PG8_STAGE_A
#undef PG8_LDA
#undef PG8_LDB
#undef PG8_MMA
#undef PG8_WAIT_V
#undef PG8_WAIT_L
#undef PG8_BAR
#undef PG8_SCHED
#undef PG8_GOFFS
}
}

constexpr int NWAVES = 8;
constexpr int BATCH = 2, SEQ = 8192, D = 1024, M = BATCH * SEQ, NP = 7168, DFF = 2816, NE = 8, INC = 7056;
constexpr int MROWS_MOE = 2 * M + 2048;
constexpr int C_NSAQ = 0, C_KC = 256, C_VC = 320, C_KSL = 384, C_VSL = 448, C_KW = 512, C_VW = 576, C_AG = 640, C_DF = 652,
              C_BQ = 768, C_BK = 1024, C_BV = 1280, C_CQ = 1536, C_CK = 1792, C_CV = 2048, C_DQ = 2304, C_DK = 2560, C_DV = 2816, C_MG = 3072;
constexpr float EPS = 1e-6f;
constexpr float SKIP_THR = 40.0f;

constexpr size_t MiB = 1u << 20;
constexpr size_t WS_CTL = 0, CTL_ZERO_BYTES = 1 * MiB;
constexpr size_t WS_MOD = 1 * MiB;
constexpr size_t WS_LIST = 1 * MiB + 256 * 1024;
constexpr size_t WS_TOKINFO = 2 * MiB;
constexpr size_t WS_Y = 4 * MiB;
constexpr size_t WS_ROPE_C = 4 * MiB, WS_ROPE_S = 5 * MiB;
constexpr size_t WS_KCMP = 6 * MiB, WS_VCMP = 6 * MiB + 256 * 1024;
constexpr size_t WS_WIN = 16 * MiB;
constexpr size_t WS_WBR = 44 * MiB;
constexpr size_t WS_WOUT = 48 * MiB;
constexpr size_t WS_W13 = 52 * MiB;
constexpr size_t WS_W2 = 63 * MiB;
constexpr size_t WS_ARENA = 72 * MiB;
constexpr size_t WS_PROJ = WS_ARENA;
constexpr size_t WS_O = WS_ARENA + 224 * MiB;
constexpr size_t WS_GACC = WS_ARENA + 256 * MiB;
constexpr size_t WS_H = WS_ARENA + 320 * MiB;
constexpr size_t WS_HMID = WS_ARENA;
constexpr size_t WS_MOEW13 = WS_ARENA;
constexpr size_t WS_MOEW2 = WS_ARENA + 88 * MiB;
constexpr size_t WS_HMID_MOE = WS_ARENA + 132 * MiB;
constexpr size_t WS_END = WS_ARENA + 352 * MiB;
static_assert(WS_HMID_MOE + (size_t)MROWS_MOE * DFF * 2 <= WS_H, "moe hmid vs H");
static_assert(WS_Y + (size_t)MROWS_MOE * 1024 * 2 <= WS_ARENA, "Y overlay");
constexpr int CW_BAR = 4096;
constexpr int CW_MOECNT = 1024;

constexpr int RING_BYTES = 131072;
constexpr int MISC_OFF = RING_BYTES + 320;
constexpr int LDS_BYTES = 147456;

#define GAS __attribute__((address_space(1)))
#define LAS __attribute__((address_space(3)))
typedef unsigned short bf16;
typedef unsigned v4u __attribute__((ext_vector_type(4)));
typedef float f32x4 __attribute__((ext_vector_type(4)));
typedef GAS unsigned gu32;
#define RLX_AGENT __ATOMIC_RELAXED, __HIP_MEMORY_SCOPE_AGENT
#define LDS_WAIT() asm volatile("s_waitcnt lgkmcnt(0)" ::: "memory")
__device__ __forceinline__ unsigned f2bf(float f) { unsigned u = __builtin_bit_cast(unsigned, f); return (u + 0x7fffu + ((u >> 16) & 1u)) >> 16; }
__device__ __forceinline__ unsigned pk2(float lo, float hi) { return f2bf(lo) | (f2bf(hi) << 16); }
__device__ __forceinline__ float bf2f(unsigned short v) { return __uint_as_float((unsigned)v << 16); }
__device__ __forceinline__ int lane_id_fresh() { int l; asm volatile("v_mbcnt_lo_u32_b32 %0, -1, 0\n\tv_mbcnt_hi_u32_b32 %0, -1, %0" : "=v"(l)); return l; }

#define XB_TMO      128
#define XB_XCNT(j)  (256  + 64 * (j))
#define XB_XSUB(j)  (1280 + 64 * (j))
#define XB_XGEN(j)  (2304 + 64 * (j))
#define XB_TOP      3328
#define XB_TOPGEN   3392
#define XCD_BAR_WORDS 3456
#define XB_SPIN_CAP (1u << 22)
__device__ __forceinline__ unsigned xb_ld(unsigned* p)              { return __hip_atomic_load(p, __ATOMIC_RELAXED, __HIP_MEMORY_SCOPE_AGENT); }
__device__ __forceinline__ unsigned xb_add(unsigned* p, unsigned v) { return __hip_atomic_fetch_add(p, v, __ATOMIC_RELAXED, __HIP_MEMORY_SCOPE_AGENT); }
__device__ __forceinline__ unsigned xb_xcc_id() { return (unsigned)__builtin_amdgcn_s_getreg((3 << 11) | 20) & 0xFu; }
#define XB_SPIN(cond, bar) do { unsigned _sp = 0; while (cond) { __builtin_amdgcn_s_sleep(1); \
    if ((++_sp & 255u) == 0u) { if (xb_ld(&(bar)[XB_TMO])) break; if (_sp > XB_SPIN_CAP) { atomicAdd(&(bar)[XB_TMO], 1u); break; } } } } while (0)
struct XcdBarrier { unsigned* bar; unsigned x; volatile LAS unsigned* st; };
__device__ __forceinline__ XcdBarrier xcd_barrier_post(unsigned* bar, volatile LAS unsigned* st, bool leader) {
    XcdBarrier b; b.bar = bar; b.x = xb_xcc_id(); b.st = st;
    if (leader) (void)xb_add(&bar[XB_XCNT(b.x)], 1u);
    return b;
}
__device__ __forceinline__ void xcd_barrier_complete(unsigned* bar, unsigned x, unsigned& nloc, unsigned& nx) {
    const unsigned G = gridDim.x * gridDim.y * gridDim.z;
    unsigned sum, cnt, mine, sp = 0u;
    for (;;) {
        sum = 0u; cnt = 0u; mine = 0u;
#pragma unroll
        for (unsigned j = 0; j < 16; ++j) { const unsigned c = xb_ld(&bar[XB_XCNT(j)]); sum += c; cnt += (c > 0u) ? 1u : 0u; mine = (j == x) ? c : mine; }
        if (sum == G) break;
        __builtin_amdgcn_s_sleep(1);
        if ((++sp & 255u) == 0u) { if (xb_ld(&bar[XB_TMO])) break; if (sp > XB_SPIN_CAP) { atomicAdd(&bar[XB_TMO], 1u); break; } }
    }
    nloc = mine > 0u ? mine : 1u; nx = cnt > 0u ? cnt : 1u;
}
__device__ __forceinline__ void xcd_barrier(const XcdBarrier& b, bool leader) {
    asm volatile("s_waitcnt vmcnt(0)" ::: "memory");
    __syncthreads();
    if (leader) {
        unsigned* bar = b.bar;
        __builtin_amdgcn_s_waitcnt(0);
        unsigned nloc = b.st[0], nx = b.st[1];
        if (nloc == 0u) { xcd_barrier_complete(bar, b.x, nloc, nx); b.st[0] = nloc; b.st[1] = nx; }
        const unsigned old = xb_add(&bar[XB_XSUB(b.x)], 1u);
        const unsigned gen = old / nloc;
        if (old + 1u == (gen + 1u) * nloc) {
            __builtin_amdgcn_fence(__ATOMIC_RELEASE, "agent");
            asm volatile("s_waitcnt vmcnt(0)" ::: "memory");
            const unsigned og = xb_add(&bar[XB_TOP], 1u);
            const unsigned tg = og / nx;
            if (og + 1u == (tg + 1u) * nx) xb_add(&bar[XB_TOPGEN], 1u);
            else XB_SPIN(xb_ld(&bar[XB_TOPGEN]) == tg, bar);
            __builtin_amdgcn_fence(__ATOMIC_ACQUIRE, "agent");
            xb_add(&bar[XB_XGEN(b.x)], 1u);
            asm volatile("s_waitcnt vmcnt(0)" ::: "memory");
        } else {
            XB_SPIN(xb_ld(&bar[XB_XGEN(b.x)]) == gen, bar);
            __builtin_amdgcn_fence(__ATOMIC_ACQUIRE, "agent");
            asm volatile("s_waitcnt vmcnt(0)" ::: "memory");
        }
    }
    __syncthreads();
}

struct Args { const void* in[25]; float* out; unsigned char* ws; int ph_lo, ph_hi; };
typedef const __attribute__((address_space(4))) Args* ArgsP;
struct Frame {
    LAS unsigned char* lds;
    int tid, lane, wave, G, gw, NGW;
    unsigned char* ws;
    gu32* ctl;
};

template <int K> __device__ __forceinline__ float swz_xor(float v) { return __int_as_float(__builtin_amdgcn_ds_swizzle(__float_as_int(v), (K << 10) | 0x1f)); }
template <int K> __device__ __forceinline__ int swz_xor_i(int v) { return __builtin_amdgcn_ds_swizzle(v, (K << 10) | 0x1f); }
__device__ __forceinline__ float wave_sum(float v) {
    v += swz_xor<1>(v); v += swz_xor<2>(v); v += swz_xor<4>(v); v += swz_xor<8>(v); v += swz_xor<16>(v);
    const auto r = __builtin_amdgcn_permlane32_swap(__float_as_uint(v), __float_as_uint(v), false, false);
    return __uint_as_float(r[0]) + __uint_as_float(r[1]);
}

struct MapIdent { const float* W; int N; __device__ const float* operator()(int n) const { return W + n; } __device__ int stride() const { return N; } };
struct MapWin {
    const float* W;
    __device__ const float* operator()(int j) const {
        int o;
        if (j < 652) o = j; else if (j < 656) o = 2956 + (j - 652); else if (j < 768) return nullptr; else if (j < 3072) o = 652 + (j - 768); else o = 2960 + (j - 3072);
        return W + o;
    }
    __device__ int stride() const { return INC; }
};
struct MapW13 {
    const float* W1; const float* W3;
    __device__ const float* operator()(int j) const { const int tile = j >> 8, r = j & 255; return (r < 128) ? (W1 + tile * 128 + r) : (W3 + tile * 128 + (r - 128)); }
    __device__ int stride() const { return DFF; }
};
template <class Map>
__device__ __forceinline__ void transpose_item(const Map mp, int K, bf16* WT, LAS float* scr, int kb, int nb, int lane) {
    const int k0 = 64 * kb, n0 = 32 * nb; const float* cp = mp(n0 + (lane & 31)); const int st = mp.stride();
#pragma unroll 8
    for (int i = 0; i < 32; ++i) { const int kk = 2 * i + (lane >> 5); scr[kk * 33 + (lane & 31)] = cp ? cp[(size_t)(k0 + kk) * st] : 0.f; }
    LDS_WAIT(); asm volatile("" ::: "memory");
    const int c = lane & 7;
#pragma unroll
    for (int j = 0; j < 4; ++j) { const int n = (lane >> 3) + 8 * j; const LAS float* s = scr + (8 * c) * 33 + n;
        v4u o; o.x = pk2(s[0 * 33], s[1 * 33]); o.y = pk2(s[2 * 33], s[3 * 33]); o.z = pk2(s[4 * 33], s[5 * 33]); o.w = pk2(s[6 * 33], s[7 * 33]);
        *(GAS v4u*)(WT + (size_t)(n0 + n) * K + k0 + 8 * c) = o; }
    LDS_WAIT(); asm volatile("" ::: "memory");
}
template <class Map>
__device__ __forceinline__ void transpose_all(Frame& F, const Map mp, int K, int Nout, bf16* WT, int& itbase) {
    LAS float* scr = (LAS float*)(F.lds + F.wave * 16384);
    const int nblk = Nout / 32, n = (K / 64) * nblk;
    int first = (F.gw - (itbase % F.NGW) + F.NGW) % F.NGW;
    for (int it = first; it < n; it += F.NGW) transpose_item(mp, K, WT, scr, it / nblk, it % nblk, F.lane);
    itbase += n;
}

__device__ __forceinline__ float gelu_tanh(float x) { const float u = 0.7978845608028654f * (x + 0.044715f * x * x * x); return 0.5f * x * (1.0f + tanhf(u)); }
__device__ __forceinline__ float log_sigmoid(float x) { return fminf(x, 0.f) - log1pf(__expf(-fabsf(x))); }

__device__ __forceinline__ void load64(const bf16* p, float (&v)[64]) {
    const v4u* p4 = (const v4u*)p;
#pragma unroll
    for (int i = 0; i < 8; ++i) { const v4u u = p4[i];
#pragma unroll
        for (int k = 0; k < 4; ++k) { v[8 * i + 2 * k] = __uint_as_float(u[k] << 16); v[8 * i + 2 * k + 1] = __uint_as_float(u[k] & 0xffff0000u); } }
}
__device__ __forceinline__ float dot64(const bf16* p, const float (&q)[64]) {
    const v4u* p4 = (const v4u*)p; float s0 = 0.f, s1 = 0.f;
#pragma unroll
    for (int i = 0; i < 8; ++i) { if (i == 4) asm volatile("" ::: "memory"); const v4u u = p4[i];
#pragma unroll
        for (int k = 0; k < 4; ++k) { s0 += __uint_as_float(u[k] << 16) * q[8 * i + 2 * k]; s1 += __uint_as_float(u[k] & 0xffff0000u) * q[8 * i + 2 * k + 1]; } }
    return s0 + s1;
}
__device__ __forceinline__ void axpy64(const bf16* p, float w, float (&o)[64]) {
    const v4u* p4 = (const v4u*)p;
#pragma unroll
    for (int i = 0; i < 8; ++i) { if (i == 4) asm volatile("" ::: "memory"); const v4u u = p4[i];
#pragma unroll
        for (int k = 0; k < 4; ++k) { o[8 * i + 2 * k] += w * __uint_as_float(u[k] << 16); o[8 * i + 2 * k + 1] += w * __uint_as_float(u[k] & 0xffff0000u); } }
}
__device__ __forceinline__ void store64(bf16* p, const float (&v)[64]) {
    v4u* p4 = (v4u*)p;
#pragma unroll
    for (int i = 0; i < 8; ++i) { v4u u;
#pragma unroll
        for (int k = 0; k < 4; ++k) u[k] = pk2(v[8 * i + 2 * k], v[8 * i + 2 * k + 1]);
        p4[i] = u; }
}
#define SOFTMAX_STEP(s_, vp_) do { const float _s = (s_); if (_s > m_run) { const float _f = __expf(m_run - _s); l_run *= _f; _Pragma("unroll") for (int _d = 0; _d < 64; ++_d) o[_d] *= _f; m_run = _s; } \
    const float _p = __expf(_s - m_run); l_run += _p; axpy64((vp_), _p, o); } while (0)

__device__ __forceinline__ void phase_prologue(Frame& F, ArgsP a) {
    const float* c_in = (const float*)a->in[1]; const int* pos = (const int*)a->in[2];
    const float* w_ada = (const float*)a->in[3]; const float* b_ada = (const float*)a->in[4];
    {
        LAS float* sc = (LAS float*)(F.lds);
        LAS float* part = (LAS float*)(F.lds + 8192);
        for (int i = F.tid; i < 2048; i += NWAVES * 64) { const float v = c_in[i]; sc[i] = v / (1.0f + __expf(-v)); }
        __syncthreads();
        for (int it = blockIdx.x; it < 2 * 96; it += F.G) {
            const int l = it / 96, j0 = (it % 96) * 64; const float* W = w_ada + (size_t)l * 1024 * 6144 + j0 + F.lane;
            float a0 = 0.f, a1 = 0.f;
#pragma unroll 16
            for (int k = 0; k < 128; ++k) { const int kk = F.wave * 128 + k; const float w = W[(size_t)kk * 6144]; a0 += sc[kk] * w; a1 += sc[1024 + kk] * w; }
            part[(F.wave * 2 + 0) * 64 + F.lane] = a0; part[(F.wave * 2 + 1) * 64 + F.lane] = a1;
            __syncthreads();
            if (F.wave < 2) { float s = 0.f;
#pragma unroll
                for (int w = 0; w < 8; ++w) s += part[(w * 2 + F.wave) * 64 + F.lane];
                ((float*)(F.ws + WS_MOD))[((size_t)l * 2 + F.wave) * 6144 + j0 + F.lane] = s + b_ada[(size_t)l * 6144 + j0 + F.lane]; }
            __syncthreads();
        }
    }
    {
        float* rc = (float*)(F.ws + WS_ROPE_C); float* rs = (float*)(F.ws + WS_ROPE_S);
        for (int i = blockIdx.x * (NWAVES * 64) + F.tid; i < M * 8; i += F.G * NWAVES * 64) {
            const int tok = i >> 3, fi = i & 7;
            const float inv = fi == 0 ? 1.0f : fi == 1 ? 0.1939227432012558f : fi == 2 ? 0.03760603070259094f : fi == 3 ? 0.007292664609849453f : fi == 4 ? 0.0014142135623842478f
                            : fi == 5 ? 0.00027424818836152554f : fi == 6 ? 5.318296098266728e-05f : 1.0313386155758053e-05f;
            const float ang = (float)pos[tok] * inv;
            double rev = (double)ang * 0.15915494309189535; rev -= floor(rev);
            const float fr = (float)rev;
            rs[i] = __builtin_amdgcn_sinf(fr); rc[i] = __builtin_amdgcn_cosf(fr);
        }
    }
    {
        int itb = 0;
        const float* w_in = (const float*)a->in[7]; const float* w_br = (const float*)a->in[16]; const float* w_out = (const float*)a->in[17];
        for (int l = 0; l < 2; ++l) {
            transpose_all(F, MapWin{w_in + (size_t)l * 1024 * INC}, 1024, NP, (bf16*)(F.ws + WS_WIN) + (size_t)l * NP * 1024, itb);
            for (int z = 0; z < 4; ++z) transpose_all(F, MapIdent{w_br + ((size_t)l * 4 + z) * 256 * 1024, 1024}, 256, 1024, (bf16*)(F.ws + WS_WBR) + ((size_t)l * 4 + z) * 1024 * 256, itb);
            transpose_all(F, MapIdent{w_out + (size_t)l * 1024 * 1024, 1024}, 1024, 1024, (bf16*)(F.ws + WS_WOUT) + (size_t)l * 1024 * 1024, itb);
        }
        transpose_all(F, MapW13{(const float*)a->in[18], (const float*)a->in[19]}, 1024, 2 * DFF, (bf16*)(F.ws + WS_W13), itb);
        transpose_all(F, MapIdent{(const float*)a->in[20], 1024}, DFF, 1024, (bf16*)(F.ws + WS_W2), itb);
    }
}
__device__ __forceinline__ void phase_moe_weights(Frame& F, ArgsP a) {
    int itb = 0;
    const float* w1 = (const float*)a->in[22]; const float* w3 = (const float*)a->in[23]; const float* w2 = (const float*)a->in[24];
    for (int e = 0; e < NE; ++e) {
        transpose_all(F, MapW13{w1 + (size_t)e * 1024 * DFF, w3 + (size_t)e * 1024 * DFF}, 1024, 2 * DFF, (bf16*)(F.ws + WS_MOEW13) + (size_t)e * 2 * DFF * 1024, itb);
        transpose_all(F, MapIdent{w2 + (size_t)e * DFF * 1024, 1024}, DFF, 1024, (bf16*)(F.ws + WS_MOEW2) + (size_t)e * 1024 * DFF, itb);
    }
}

template <bool ROUTE>
__device__ __forceinline__ void phase_norm(Frame& F, const float* x, const float* nw, const float* sh, const float* sc, const float* router) {
    bf16* H = (bf16*)(F.ws + WS_H);
    const int rows_per = ROUTE ? 8 : 1;
    for (int r0 = F.gw * rows_per; r0 < M; r0 += F.NGW * rows_per) {
        const int b = r0 >> 13;
        f32x4 A[4], Bv[4];
#pragma unroll
        for (int j = 0; j < 4; ++j) { const int c = 4 * F.lane + 256 * j; const f32x4 w = *(const f32x4*)(nw + c), s = *(const f32x4*)(sc + (size_t)b * 6144 + c); A[j] = w * (s + 1.0f); Bv[j] = *(const f32x4*)(sh + (size_t)b * 6144 + c); }
        int myE = 0; float myG = 0.f;
        for (int rr = 0; rr < rows_per; ++rr) {
            const int m = r0 + rr;
            const GAS f32x4* xr = (const GAS f32x4*)(x + (size_t)m * D) + F.lane;
            f32x4 v[4]; float s2 = 0.f;
#pragma unroll
            for (int j = 0; j < 4; ++j) { v[j] = xr[64 * j]; s2 += (v[j].x * v[j].x + v[j].y * v[j].y) + (v[j].z * v[j].z + v[j].w * v[j].w); }
            const float rstd = 1.0f / sqrtf(wave_sum(s2) * (1.f / D) + EPS);
#pragma unroll
            for (int j = 0; j < 4; ++j) v[j] = (v[j] * rstd) * A[j] + Bv[j];
            GAS unsigned long long* o8 = (GAS unsigned long long*)(H + (size_t)m * D) + F.lane;
#pragma unroll
            for (int j = 0; j < 4; ++j) o8[64 * j] = (unsigned long long)pk2(v[j].x, v[j].y) | ((unsigned long long)pk2(v[j].z, v[j].w) << 32);
            if constexpr (ROUTE) {
                float lg[8];
#pragma unroll
                for (int e = 0; e < 8; ++e) lg[e] = 0.f;
#pragma unroll
                for (int j = 0; j < 4; ++j)
#pragma unroll
                    for (int k = 0; k < 4; ++k) { const int c = 4 * F.lane + 256 * j + k; const f32x4 w0 = *(const f32x4*)(router + (size_t)c * 8), w1 = *(const f32x4*)(router + (size_t)c * 8 + 4); const float xv = v[j][k];
                        lg[0] += xv * w0.x; lg[1] += xv * w0.y; lg[2] += xv * w0.z; lg[3] += xv * w0.w; lg[4] += xv * w1.x; lg[5] += xv * w1.y; lg[6] += xv * w1.z; lg[7] += xv * w1.w; }
#pragma unroll
                for (int e = 0; e < 8; ++e) lg[e] = wave_sum(lg[e]);
                int e0 = 0; float v0 = lg[0];
#pragma unroll
                for (int e = 1; e < 8; ++e) if (lg[e] > v0) { v0 = lg[e]; e0 = e; }
                int e1 = -1; float v1 = -3.0e38f;
#pragma unroll
                for (int e = 0; e < 8; ++e) if (e != e0 && lg[e] > v1) { v1 = lg[e]; e1 = e; }
                const float g0 = 1.0f / (1.0f + __expf(v1 - v0)), g1 = 1.0f - g0;
                if (F.lane == 2 * rr) { myE = e0; myG = g0; }
                if (F.lane == 2 * rr + 1) { myE = e1; myG = g1; }
            }
        }
        if constexpr (ROUTE) {
            gu32* cnt = F.ctl + CW_MOECNT; int* list = (int*)(F.ws + WS_LIST); int* info = (int*)(F.ws + WS_TOKINFO);
            const bool act = F.lane < 16; int myrank = 0;
#pragma unroll
            for (int e = 0; e < 8; ++e) {
                const unsigned long long mk = __ballot(act && myE == e);
                const int c = __popcll(mk); unsigned base = 0;
                if (c > 0) { if (F.lane == 0) base = __hip_atomic_fetch_add(cnt + 64 * e, (unsigned)c, RLX_AGENT); base = __builtin_amdgcn_readfirstlane(base); }
                if (act && myE == e) myrank = (int)base + __popcll(mk & ((1ull << F.lane) - 1ull));
            }
            if (act) { const int tok = r0 + (F.lane >> 1); list[myE * 16384 + myrank] = tok; int* ip = info + ((size_t)tok * 2 + (F.lane & 1)) * 4; ip[0] = myE; ip[1] = myrank; ip[2] = __float_as_int(myG); ip[3] = 0; }
        }
    }
}

__device__ __forceinline__ void phase_qknorm(Frame& F, const float* qk_gain  ) {
    bf16* P = (bf16*)(F.ws + WS_PROJ); const float* rc = (const float*)(F.ws + WS_ROPE_C); const float* rs = (const float*)(F.ws + WS_ROPE_S);
    for (int it = blockIdx.x * (NWAVES * 64) + F.tid; it < M * 24; it += F.G * NWAVES * 64) {
        const int tok = it / 24, s = it % 24; int col, gi; bool rope;
        if (s < 4) { col = C_NSAQ + 64 * s; gi = 0; rope = false; }
        else if (s == 4) { col = C_KC; gi = 1; rope = false; }
        else if (s == 5) { col = C_KSL; gi = 2; rope = true; }
        else if (s == 6) { col = C_KW; gi = 3; rope = true; }
        else if (s < 11) { col = C_BQ + 64 * (s - 7); gi = 4; rope = true; }
        else if (s < 15) { col = C_BK + 64 * (s - 11); gi = 5; rope = true; }
        else if (s < 19) { col = C_DQ + 64 * (s - 15); gi = 6; rope = false; }
        else if (s < 23) { col = C_DK + 64 * (s - 19); gi = 7; rope = false; }
        else continue;
        bf16* p = P + (size_t)tok * NP + col; float v[64]; load64(p, v);
        float ss = 0.f;
#pragma unroll
        for (int d = 0; d < 64; ++d) ss += v[d] * v[d];
        const float r = 1.0f / sqrtf(ss * (1.f / 64.f) + EPS); const float* g = qk_gain + gi * 64;
#pragma unroll
        for (int d = 0; d < 64; ++d) v[d] = v[d] * r * g[d];
        if (rope) {
#pragma unroll
            for (int i = 0; i < 8; ++i) { const float c = rc[(size_t)tok * 8 + i], sn = rs[(size_t)tok * 8 + i]; const float x1 = v[i], x2 = v[8 + i]; v[i] = x1 * c - x2 * sn; v[8 + i] = x2 * c + x1 * sn; }
        }
        store64(p, v);
    }
}

__device__ __forceinline__ void phase_compress(Frame& F, const float* pe_k, const float* pe_v, const float* k1, const float* k2, const float* v1, const float* v2) {
    const bf16* P = (const bf16*)(F.ws + WS_PROJ);
    LAS float* Ain = (LAS float*)(F.lds + F.wave * 9216);
    LAS float* hid = Ain + 2048;
    for (int it = F.gw; it < 2 * 2 * 511; it += F.NGW) {
        const int which = it / 1022, r = it % 1022, b = r / 511, c = r % 511;
        const float* pe = which ? pe_v : pe_k; const float* w1 = which ? v1 : k1; const float* w2 = which ? v2 : k2; const int col = which ? C_VC : C_KC;
        for (int i = F.lane; i < 2048; i += 64) { const int l = i >> 6, d = i & 63; Ain[i] = bf2f(P[(size_t)(b * SEQ + 16 * c + l) * NP + col + d]) + pe[i]; }
        LDS_WAIT(); asm volatile("" ::: "memory");
        float h0 = 0.f, h1 = 0.f;
#pragma unroll 8
        for (int i = 0; i < 2048; ++i) { const float av = Ain[i]; h0 += av * w1[(size_t)i * 128 + F.lane]; h1 += av * w1[(size_t)i * 128 + 64 + F.lane]; }
        hid[F.lane] = gelu_tanh(h0); hid[64 + F.lane] = gelu_tanh(h1);
        LDS_WAIT(); asm volatile("" ::: "memory");
        float o = 0.f;
#pragma unroll 8
        for (int j = 0; j < 128; ++j) o += hid[j] * w2[j * 64 + F.lane];
        bf16* dst = (bf16*)(F.ws + (which ? WS_VCMP : WS_KCMP)) + ((size_t)b * 512 + c) * 64;
        dst[F.lane] = (bf16)f2bf(o);
        LDS_WAIT(); asm volatile("" ::: "memory");
    }
}

__device__ __forceinline__ void attn_nsa_item(Frame& F, int item) {
    const bf16* P = (const bf16*)(F.ws + WS_PROJ); float* OACC = (float*)(F.ws + WS_GACC); bf16* O = (bf16*)(F.ws + WS_O);
    const bf16* KC = (const bf16*)(F.ws + WS_KCMP); const bf16* VC = (const bf16*)(F.ws + WS_VCMP);
    const float* rc = (const float*)(F.ws + WS_ROPE_C); const float* rs = (const float*)(F.ws + WS_ROPE_S);
    LAS float* imp = (LAS float*)(F.lds + F.wave * 9216);
    LAS int* sel = (LAS int*)(F.lds + F.wave * 9216 + 8192);
    const int tt = F.lane >> 2, h = F.lane & 3, tg = item * 16 + tt, b = tg >> 13, t = tg & (SEQ - 1);
    const bf16* prow = P + (size_t)tg * NP;
    float g3[3];
#pragma unroll
    for (int i = 0; i < 3; ++i) g3[i] = pg8::sigmoid_f(bf2f(prow[C_AG + 3 * h + i]));
    float q[64]; load64(prow + C_NSAQ + 64 * h, q);
    float o[64]; float m_run, l_run;
    for (int i = F.lane; i < 16 * 128; i += 64) imp[i] = 0.f;
    LDS_WAIT(); asm volatile("" ::: "memory");
    const int cmax = (t >= 31) ? ((t - 31) >> 4) : -1;
    m_run = -3.0e38f; l_run = 0.f;
#pragma unroll
    for (int d = 0; d < 64; ++d) o[d] = 0.f;
#pragma unroll 1
    for (int c = 0; c <= cmax; ++c) { const float s = dot64(KC + ((size_t)b * 512 + c) * 64, q) * 0.125f; SOFTMAX_STEP(s, VC + ((size_t)b * 512 + c) * 64); }
    const float inv_l = (cmax >= 0) ? 1.0f / l_run : 0.f;
    float* oacc = OACC + (size_t)tg * 256 + 64 * h;
#pragma unroll
    for (int d = 0; d < 64; ++d) oacc[d] = g3[0] * o[d] * inv_l;
    { float accj = 0.f, carry = 0.f;
#pragma unroll 1
      for (int c = 0; c <= cmax; ++c) {
          const float s = dot64(KC + ((size_t)b * 512 + c) * 64, q) * 0.125f; float p = __expf(s - m_run) * inv_l;
          p += swz_xor<1>(p); p += swz_xor<2>(p);
          accj += p;
          if ((c & 3) == 3) { if (h == 0) imp[tt * 128 + (c >> 2)] = carry + accj; carry = p; accj = 0.f; }
      }
      if (cmax >= 0 && h == 0) { if ((cmax & 3) != 3) imp[tt * 128 + (cmax >> 2)] = carry + accj; else if (((cmax + 1) >> 2) < 128) imp[tt * 128 + ((cmax + 1) >> 2)] = carry; }
    }
    LDS_WAIT(); asm volatile("" ::: "memory");
    const int cur = t >> 6; const int n_pick = (cur + 1 < 16) ? cur + 1 : 16;
    int nsel = 0;
    if (h == 0) { sel[tt * 16 + 0] = 0; }
    nsel = 1;
    if (cur >= 1) { if (h == 0) sel[tt * 16 + nsel] = cur; ++nsel; }
    if (cur >= 2) { if (h == 0) sel[tt * 16 + nsel] = cur - 1; ++nsel; }
    for (; nsel < n_pick; ++nsel) {
        float bv = -2.0f; int bi = 1 << 20;
        for (int j = 1 + h; j <= cur - 2; j += 4) { const float v = imp[tt * 128 + j]; if (v > bv) { bv = v; bi = j; } }
        { const float ov = swz_xor<1>(bv); const int oi = swz_xor_i<1>(bi); if (ov > bv || (ov == bv && oi < bi)) { bv = ov; bi = oi; } }
        { const float ov = swz_xor<2>(bv); const int oi = swz_xor_i<2>(bi); if (ov > bv || (ov == bv && oi < bi)) { bv = ov; bi = oi; } }
        if (h == 0) { sel[tt * 16 + nsel] = bi; imp[tt * 128 + bi] = -1.0f; }
        LDS_WAIT(); asm volatile("" ::: "memory");
    }
    LDS_WAIT(); asm volatile("" ::: "memory");
#pragma unroll
    for (int i = 0; i < 8; ++i) { const float c = rc[(size_t)tg * 8 + i], sn = rs[(size_t)tg * 8 + i]; const float x1 = q[i], x2 = q[8 + i]; q[i] = x1 * c - x2 * sn; q[8 + i] = x2 * c + x1 * sn; }
    m_run = -3.0e38f; l_run = 0.f;
#pragma unroll
    for (int d = 0; d < 64; ++d) o[d] = 0.f;
#pragma unroll 1
    for (int i = 0; i < n_pick; ++i) { const int jb = sel[tt * 16 + i];
#pragma unroll 1
        for (int l2 = 0; l2 < 64; ++l2) { const int kp = 64 * jb + l2; if (kp > t) break;
            const bf16* kr = P + (size_t)(b * SEQ + kp) * NP; const float s = dot64(kr + C_KSL, q) * 0.125f; SOFTMAX_STEP(s, kr + C_VSL); } }
    { const float il = 1.0f / l_run;
#pragma unroll
      for (int d = 0; d < 64; ++d) oacc[d] += g3[1] * o[d] * il; }
    m_run = -3.0e38f; l_run = 0.f;
#pragma unroll
    for (int d = 0; d < 64; ++d) o[d] = 0.f;
#pragma unroll 1
    for (int kp = (t >= 511 ? t - 511 : 0); kp <= t; ++kp) { const bf16* kr = P + (size_t)(b * SEQ + kp) * NP; const float s = dot64(kr + C_KW, q) * 0.125f; SOFTMAX_STEP(s, kr + C_VW); }
    { const float il = 1.0f / l_run;
#pragma unroll
      for (int d = 0; d < 64; ++d) o[d] = oacc[d] + g3[2] * o[d] * il; }
    store64(O + (size_t)tg * 1024 + 0 + 64 * h, o);
    LDS_WAIT(); asm volatile("" ::: "memory");
}
__device__ __forceinline__ void attn_dilated_item(Frame& F, int item) {
    const bf16* P = (const bf16*)(F.ws + WS_PROJ); bf16* O = (bf16*)(F.ws + WS_O);
    const int h = item & 3, tg = (item >> 2) * 64 + F.lane, b = tg >> 13, t = tg & (SEQ - 1);
    float q[64]; load64(P + (size_t)tg * NP + C_BQ + 64 * h, q);
    float o[64]; float m_run = -3.0e38f, l_run = 0.f;
#pragma unroll
    for (int d = 0; d < 64; ++d) o[d] = 0.f;
#pragma unroll 1
    for (int gi = 0; gi < 3; ++gi) { const int dl = (gi == 0) ? 1 : (gi == 1 ? 4 : 16);
#pragma unroll 1
        for (int mm = 0; mm <= 128; ++mm) { const int kp = t - mm * dl; if (kp < 0) break;
            const bf16* kr = P + (size_t)(b * SEQ + kp) * NP; const float s = dot64(kr + C_BK + 64 * h, q) * 0.125f; SOFTMAX_STEP(s, kr + C_BV + 64 * h); } }
    const float il = 1.0f / l_run;
#pragma unroll
    for (int d = 0; d < 64; ++d) o[d] *= il;
    store64(O + (size_t)tg * 1024 + 256 + 64 * h, o);
}
__device__ __forceinline__ void attn_stickbreak_item(Frame& F, int item) {
    const bf16* P = (const bf16*)(F.ws + WS_PROJ); bf16* O = (bf16*)(F.ws + WS_O);
    const int h = item & 3, tg = (item >> 2) * 64 + F.lane, b = tg >> 13, t = tg & (SEQ - 1);
    float q[64]; load64(P + (size_t)tg * NP + C_CQ + 64 * h, q);
    float o[64]; float R = 0.f;
#pragma unroll
    for (int d = 0; d < 64; ++d) o[d] = 0.f;
#pragma unroll 1
    for (int kp = t - 1; kp >= 0; --kp) {
        const bf16* kr = P + (size_t)(b * SEQ + kp) * NP; const float z = dot64(kr + C_CK + 64 * h, q) * 0.125f;
        const float w = __expf(log_sigmoid(z) + R); axpy64(kr + C_CV + 64 * h, w, o);
        R += log_sigmoid(-z);
        if (R < -SKIP_THR) break;
    }
    store64(O + (size_t)tg * 1024 + 512 + 64 * h, o);
}
__device__ __forceinline__ void attn_fox_item(Frame& F, int item, const float* fox_b, const float* gk  ) {
    const bf16* P = (const bf16*)(F.ws + WS_PROJ); bf16* O = (bf16*)(F.ws + WS_O);
    const int h = item & 3, tg = (item >> 2) * 64 + F.lane, b = tg >> 13, t = tg & (SEQ - 1);
    float q[64]; load64(P + (size_t)tg * NP + C_DQ + 64 * h, q);
    float qn = 0.f, gmax = 0.f;
#pragma unroll
    for (int d = 0; d < 64; ++d) { qn += q[d] * q[d]; gmax = fmaxf(gmax, fabsf(gk[d])); }
    const float qkmax = sqrtf(qn) * (8.0f * gmax) * 0.125f * 1.02f;
    const float fb = fox_b[h];
    float o[64]; float m_run = -3.0e38f, l_run = 0.f, bias = 0.f;
#pragma unroll
    for (int d = 0; d < 64; ++d) o[d] = 0.f;
#pragma unroll 1
    for (int kp = t; kp >= 0; --kp) {
        const bf16* kr = P + (size_t)(b * SEQ + kp) * NP; const float s = dot64(kr + C_DK + 64 * h, q) * 0.125f + bias; SOFTMAX_STEP(s, kr + C_DV + 64 * h);
        bias += log_sigmoid(bf2f(kr[C_DF + h]) + fb);
        if (qkmax + bias - m_run < -SKIP_THR) break;
    }
    const float il = 1.0f / l_run;
#pragma unroll
    for (int d = 0; d < 64; ++d) o[d] *= il;
    store64(O + (size_t)tg * 1024 + 768 + 64 * h, o);
}
__device__ __forceinline__ void phase_attention(Frame& F, const float* fox_b, const float* qk_gain) {
    for (int it = F.gw; it < 4096; it += F.NGW) {
        const int ty = it >> 10, sub = it & 1023;
        if (ty == 0) attn_nsa_item(F, sub);
        else if (ty == 1) attn_fox_item(F, sub, fox_b, qk_gain + 7 * 64);
        else if (ty == 2) attn_dilated_item(F, sub);
        else attn_stickbreak_item(F, sub);
    }
}

__device__ __forceinline__ void phase_combine(Frame& F, float* out, const float* gate) {
    const bf16* Y = (const bf16*)(F.ws + WS_Y); const int* info = (const int*)(F.ws + WS_TOKINFO);
    int pre[8]; { int p = 0;
#pragma unroll
        for (int e = 0; e < 8; ++e) { int n = (int)__hip_atomic_load(F.ctl + CW_MOECNT + 64 * e, RLX_AGENT); if (n > 16384) n = 16384; pre[e] = p; p += (n + 255) >> 8; } }
    for (int m = F.gw; m < M; m += F.NGW) {
        const int b = m >> 13; const int* ip = info + (size_t)m * 8;
        const int e0 = ip[0], r0 = ip[1], e1 = ip[4], r1 = ip[5]; const float g0 = __int_as_float(ip[2]), g1 = __int_as_float(ip[6]);
        int p0 = 0, p1 = 0;
#pragma unroll
        for (int e = 0; e < 8; ++e) { if (e == e0) p0 = pre[e]; if (e == e1) p1 = pre[e]; }
        const bf16* y0 = Y + ((size_t)p0 * 256 + r0) * 1024; const bf16* y1 = Y + ((size_t)p1 * 256 + r1) * 1024;
#pragma unroll
        for (int j = 0; j < 4; ++j) { const int c = 4 * F.lane + 256 * j;
            const uint2 a0 = *(const uint2*)(y0 + c), a1 = *(const uint2*)(y1 + c); const f32x4 gv = *(const f32x4*)(gate + (size_t)b * 6144 + c); f32x4 xv = *(const f32x4*)(out + (size_t)m * D + c);
            xv.x += gv.x * (g0 * __uint_as_float(a0.x << 16) + g1 * __uint_as_float(a1.x << 16));
            xv.y += gv.y * (g0 * __uint_as_float(a0.x & 0xffff0000u) + g1 * __uint_as_float(a1.x & 0xffff0000u));
            xv.z += gv.z * (g0 * __uint_as_float(a0.y << 16) + g1 * __uint_as_float(a1.y << 16));
            xv.w += gv.w * (g0 * __uint_as_float(a0.y & 0xffff0000u) + g1 * __uint_as_float(a1.y & 0xffff0000u));
            *(f32x4*)(out + (size_t)m * D + c) = xv; }
    }
}

constexpr int PH_PER_LAYER = 11, N_PHASES = 1 + 2 * PH_PER_LAYER;
extern __shared__ __attribute__((aligned(16))) unsigned char lds_dyn[];
#define SITE_PROLOGUE() Frame F; ArgsP ap = (ArgsP)__builtin_amdgcn_kernarg_segment_ptr(); asm volatile("" : "+s"(ap)); l = __builtin_amdgcn_readfirstlane(l); \
    F.lds = (LAS unsigned char*)lds_dyn; F.lane = lane_id_fresh(); F.wave = wave0; F.tid = F.wave * 64 + F.lane; \
    F.G = gridDim.x; F.gw = blockIdx.x * NWAVES + F.wave; F.NGW = F.G * NWAVES; F.ws = ap->ws; F.ctl = (gu32*)(F.ws + WS_CTL); \
    float* const out = ap->out; const float* const modl = (const float*)(F.ws + WS_MOD) + (size_t)l * 2 * 6144; (void)out; (void)modl
static __device__ __forceinline__ void site_prologue(int l, int wave0) { SITE_PROLOGUE(); phase_prologue(F, ap); }
static __device__ __forceinline__ void site_norm_mix(int l, int wave0) { SITE_PROLOGUE(); const float* xin = (l == 0) ? (const float*)ap->in[0] : (const float*)out;
    phase_norm<false>(F, xin, (const float*)ap->in[5] + l * 1024, modl + 0, modl + 1024, nullptr); }
static __device__ __forceinline__ void site_gemm_in(int l, int wave0) { SITE_PROLOGUE();
    pg8::Gemm g{(const bf16*)(F.ws + WS_H), (const bf16*)(F.ws + WS_WIN) + (size_t)l * NP * 1024, 1024, 1024}; pg8::StaticOrder S; S.init(M, NP, F.G, (int)blockIdx.x);
    pg8::EpiStore E{(bf16*)(F.ws + WS_PROJ), NP};
    pg8::gemm_phase<pg8::EpiStore, pg8::StaticOrder, true, false>(F.lds, g, S, E, F.tid); }
static __device__ __forceinline__ void site_qknorm(int l, int wave0) { SITE_PROLOGUE(); phase_qknorm(F, (const float*)ap->in[8] + l * 512); }
static __device__ __forceinline__ void site_compress(int l, int wave0) { SITE_PROLOGUE(); phase_compress(F, (const float*)ap->in[9] + l * 2048, (const float*)ap->in[10] + l * 2048, (const float*)ap->in[11] + (size_t)l * 2048 * 128, (const float*)ap->in[12] + l * 128 * 64,
                                       (const float*)ap->in[13] + (size_t)l * 2048 * 128, (const float*)ap->in[14] + l * 128 * 64); }
static __device__ __forceinline__ void site_attention(int l, int wave0) { SITE_PROLOGUE(); phase_attention(F, (const float*)ap->in[15] + l * 4, (const float*)ap->in[8] + l * 512); }
static __device__ __forceinline__ void site_gemm_branch(int l, int wave0) { SITE_PROLOGUE();
    pg8::Gemm g{(const bf16*)(F.ws + WS_O), (const bf16*)(F.ws + WS_WBR) + (size_t)l * 4 * 1024 * 256, 1024, 256}; pg8::BranchOrder S; S.init(M, 1024, F.G, (int)blockIdx.x);
    pg8::EpiGate E{(const bf16*)(F.ws + WS_PROJ), NP, C_MG, (float*)(F.ws + WS_GACC), (bf16*)(F.ws + WS_H)};
    pg8::gemm_phase<pg8::EpiGate, pg8::BranchOrder, false, false>(F.lds, g, S, E, F.tid); }
static __device__ __forceinline__ void site_gemm_out(int l, int wave0) { SITE_PROLOGUE(); const float* xin = (l == 0) ? (const float*)ap->in[0] : (const float*)out;
    pg8::Gemm g{(const bf16*)(F.ws + WS_H), (const bf16*)(F.ws + WS_WOUT) + (size_t)l * 1024 * 1024, 1024, 1024}; pg8::StaticOrder S; S.init(M, 1024, F.G, (int)blockIdx.x);
    pg8::EpiResid E{xin, out, modl + 2048, 6144};
    pg8::gemm_phase<pg8::EpiResid, pg8::StaticOrder, false, false>(F.lds, g, S, E, F.tid); }
static __device__ __forceinline__ void site_norm_ffn(int l, int wave0) { SITE_PROLOGUE();
    if (l == 0) phase_norm<false>(F, out, (const float*)ap->in[6] + l * 1024, modl + 3 * 1024, modl + 4 * 1024, nullptr);
    else { phase_norm<true>(F, out, (const float*)ap->in[6] + l * 1024, modl + 3 * 1024, modl + 4 * 1024, (const float*)ap->in[21]); phase_moe_weights(F, ap); } }
static __device__ __forceinline__ void site_gemm_up_dense(int l, int wave0) { SITE_PROLOGUE();
    pg8::Gemm g{(const bf16*)(F.ws + WS_H), (const bf16*)(F.ws + WS_W13), 1024, 1024}; pg8::StaticOrder S; S.init(M, 2 * DFF, F.G, (int)blockIdx.x);
    pg8::EpiSwiglu E{(bf16*)(F.ws + WS_HMID), DFF};
    pg8::gemm_phase<pg8::EpiSwiglu, pg8::StaticOrder, true, false>(F.lds, g, S, E, F.tid); }
static __device__ __forceinline__ void site_gemm_up_moe(int l, int wave0) { SITE_PROLOGUE();
    pg8::Gemm g{(const bf16*)(F.ws + WS_H), (const bf16*)(F.ws + WS_MOEW13), 1024, 1024}; pg8::MoeOrder S; S.init((unsigned*)(F.ctl + CW_MOECNT), (const int*)(F.ws + WS_LIST), 2 * DFF / 256, (size_t)2 * DFF * 1024, F.G, (int)blockIdx.x);
    pg8::EpiSwiglu E{(bf16*)(F.ws + WS_HMID_MOE), DFF};
    pg8::gemm_phase<pg8::EpiSwiglu, pg8::MoeOrder, true, true>(F.lds, g, S, E, F.tid); }
static __device__ __forceinline__ void site_gemm_down_dense(int l, int wave0) { SITE_PROLOGUE();
    pg8::Gemm g{(const bf16*)(F.ws + WS_HMID), (const bf16*)(F.ws + WS_W2), DFF, DFF}; pg8::StaticOrder S; S.init(M, 1024, F.G, (int)blockIdx.x);
    pg8::EpiResid E{out, out, modl + 5 * 1024, 6144};
    pg8::gemm_phase<pg8::EpiResid, pg8::StaticOrder, false, false>(F.lds, g, S, E, F.tid); }
static __device__ __forceinline__ void site_gemm_down_moe(int l, int wave0) { SITE_PROLOGUE();
    pg8::Gemm g{(const bf16*)(F.ws + WS_HMID_MOE), (const bf16*)(F.ws + WS_MOEW2), DFF, DFF}; pg8::MoeOrder S; S.init((unsigned*)(F.ctl + CW_MOECNT), (const int*)(F.ws + WS_LIST), 4, (size_t)1024 * DFF, F.G, (int)blockIdx.x);
    pg8::EpiStore E{(bf16*)(F.ws + WS_Y), 1024};
    pg8::gemm_phase<pg8::EpiStore, pg8::MoeOrder, true, false>(F.lds, g, S, E, F.tid); }
static __device__ __forceinline__ void site_combine(int l, int wave0) { SITE_PROLOGUE(); phase_combine(F, out, modl + 5 * 1024); }

__global__ void __launch_bounds__(NWAVES * 64, 2) fwd_kernel(Args args_unused) {
    (void)args_unused;
    const ArgsP ap0 = (ArgsP)__builtin_amdgcn_kernarg_segment_ptr();
    const int wave0 = __builtin_amdgcn_readfirstlane((int)threadIdx.x >> 6);
    LAS unsigned char* lds = (LAS unsigned char*)lds_dyn;
    volatile LAS unsigned* MISC = (volatile LAS unsigned*)(lds + MISC_OFF);
    for (int u = wave0 * 64 + lane_id_fresh(); u < (LDS_BYTES - RING_BYTES) / 4; u += NWAVES * 64) ((LAS unsigned*)(lds + RING_BYTES))[u] = 0u;
    __syncthreads();
    const int lo = ap0->ph_lo, hi = ap0->ph_hi;
    unsigned* barw = (unsigned*)(ap0->ws + WS_CTL) + CW_BAR;
    XcdBarrier bar; bar.bar = barw; bar.x = 0; bar.st = nullptr;
#define LEADER() (wave0 == 0 && lane_id_fresh() == 0)
    if (hi - lo > 1) bar = xcd_barrier_post(barw, MISC + 8, LEADER());
#define IN(k) (lo <= (k) && (k) < hi)
#define SEAM(k) do { if (IN(k) && IN((k) + 1)) xcd_barrier(bar, LEADER()); } while (0)
    if (PHON(0) && IN(0)) site_prologue(0, wave0);
    SEAM(0);
    for (int l = 0; l < 2; ++l) {
        const int pb = 1 + l * PH_PER_LAYER;
        if (PHON(1) && IN(pb + 0)) site_norm_mix(l, wave0);
        SEAM(pb + 0);
        if (PHON(2) && IN(pb + 1)) site_gemm_in(l, wave0);
        SEAM(pb + 1);
        if (PHON(3) && IN(pb + 2)) site_qknorm(l, wave0);
        SEAM(pb + 2);
        if (PHON(4) && IN(pb + 3)) site_compress(l, wave0);
        SEAM(pb + 3);
        if (PHON(5) && IN(pb + 4)) site_attention(l, wave0);
        SEAM(pb + 4);
        if (PHON(6) && IN(pb + 5)) site_gemm_branch(l, wave0);
        SEAM(pb + 5);
        if (PHON(7) && IN(pb + 6)) site_gemm_out(l, wave0);
        SEAM(pb + 6);
        if (PHON(8) && IN(pb + 7)) site_norm_ffn(l, wave0);
        SEAM(pb + 7);
        if (PHON(9) && IN(pb + 8)) { if (l == 0) site_gemm_up_dense(l, wave0); else site_gemm_up_moe(l, wave0); }
        SEAM(pb + 8);
        if (PHON(10) && IN(pb + 9)) { if (l == 0) site_gemm_down_dense(l, wave0); else site_gemm_down_moe(l, wave0); }
        SEAM(pb + 9);
        if (PHON(11) && IN(pb + 10)) { if (l == 1) site_combine(l, wave0); }
    }
#undef IN
#undef SEAM
}

extern "C" void kernel_launch(void* const* d_in, const int* in_sizes, int n_in, void* d_out, int out_size, void* d_ws, size_t ws_size, hipStream_t stream) {
    static int grid = 0;
    if (grid == 0) {
        if (n_in != 25 || out_size != M * D || ws_size < WS_END) { fprintf(stderr, "kernel_launch: unexpected problem (n_in %d, out %d, ws %zu < %zu)\n", n_in, out_size, ws_size, (size_t)WS_END); grid = -1; return; }
        int dev = 0, cus = 0, per_cu = 0;
        if (hipGetDevice(&dev) != hipSuccess || hipDeviceGetAttribute(&cus, hipDeviceAttributeMultiprocessorCount, dev) != hipSuccess) { grid = -1; return; }
        if (hipFuncSetAttribute((const void*)fwd_kernel, hipFuncAttributeMaxDynamicSharedMemorySize, LDS_BYTES) != hipSuccess) { fprintf(stderr, "kernel_launch: hipFuncSetAttribute failed\n"); grid = -1; return; }
        if (hipOccupancyMaxActiveBlocksPerMultiprocessor(&per_cu, (const void*)fwd_kernel, NWAVES * 64, LDS_BYTES) != hipSuccess || per_cu < 1) fprintf(stderr, "kernel_launch: occupancy query reports %d\n", per_cu);
        (void)hipGetLastError();
        grid = cus;
    }
    if (grid < 0) return;
    if (hipMemsetAsync((char*)d_ws + WS_CTL, 0, CTL_ZERO_BYTES, stream) != hipSuccess) return;
    Args a{};
    for (int i = 0; i < 25; ++i) a.in[i] = d_in[i];
    a.out = (float*)d_out; a.ws = (unsigned char*)d_ws;
#if MK_ONE_LAUNCH
    a.ph_lo = 0; a.ph_hi = N_PHASES;
    hipLaunchKernelGGL(fwd_kernel, dim3(grid), dim3(NWAVES * 64), LDS_BYTES, stream, a);
#else
    for (int p = 0; p < N_PHASES; ++p) {
        if (p == 1 + 10) continue;
        a.ph_lo = p; a.ph_hi = p + 1;
        hipLaunchKernelGGL(fwd_kernel, dim3(grid), dim3(NWAVES * 64), LDS_BYTES, stream, a);
    }
#endif
}
```

```cpp
#include <hip/hip_runtime.h>
#include <cstdio>
#include <cstdint>

#ifndef MK_ONE_LAUNCH
#define MK_ONE_LAUNCH 1
#endif
#ifndef PHMASK
#define PHMASK 0xFFFFu
#endif
#define PHON(k) (((PHMASK) >> (k)) & 1u)

namespace pg8 {
#define PG8_LAS __attribute__((address_space(3)))
typedef unsigned short bf16_t;
typedef short bf16x8 __attribute__((ext_vector_type(8)));
typedef float f32x4 __attribute__((ext_vector_type(4)));
typedef unsigned u32x4 __attribute__((ext_vector_type(4)));
constexpr int BM = 256, BK = 64, HALF = 128, HTB = HALF * BK * 2, STAGE_BYTES = 8 * HTB, NXCD = 8, WGM = 8;

__host__ __device__ __forceinline__ int lds_byte(int r, int c) { const int st = (r >> 4) * 2 + (c >> 5), rr = r & 15, cc = c & 31, ob = rr * 64 + cc * 2; return st * 1024 + (ob ^ (((ob >> 9) & 1) << 5)); }
__host__ __device__ __forceinline__ void stage_rc(int b, int& R, int& C) { const int st = b / 1024, sb = b % 1024, swz = sb ^ (((sb >> 9) & 1) << 5); R = (st >> 1) * 16 + swz / 64; C = (st & 1) * 32 + (swz % 64) / 2; }
__host__ __device__ __forceinline__ int perm32(int rho) { const int n = rho >> 4, i = rho & 15; return 8 * (i >> 2) + 4 * n + (i & 3); }

struct Unit { int pm, pn, z; };
struct Gemm { const bf16_t* A; const bf16_t* Bt; int lda; int K; };

__host__ __device__ __forceinline__ void tile_pmpn(int wgid, int nM, int nN, int& pm, int& pn) {
    const int nwg = nM * nN;
    { const int q = nwg / NXCD, r = nwg % NXCD, xcd = wgid % NXCD, off = wgid / NXCD; wgid = (xcd < r ? xcd * (q + 1) : r * (q + 1) + (xcd - r) * q) + off; }
    const int nig = WGM * nN, gid = wgid / nig, fm = gid * WGM, gsz = (nM - fm) < WGM ? (nM - fm) : WGM;
    pm = fm + ((wgid % nig) % gsz); pn = (wgid % nig) / gsz;
}
struct StaticOrder {
    int nM, nN, nwg, G, c;
    __device__ void init(int M, int N, int G_, int c_) { nM = M / BM; nN = N / BM; nwg = nM * nN; G = G_; c = c_; }
    __device__ bool next(int i, Unit& u) const { const long L = (long)i * G + c; if (L >= nwg) return false; tile_pmpn((int)L, nM, nN, u.pm, u.pn); u.z = 0; return true; }
    __device__ const char* a_base(const Gemm& g, const Unit& u) const { return (const char*)g.A + (size_t)u.pm * BM * g.lda * 2; }
    __device__ const char* b_base(const Gemm& g, const Unit& u) const { return (const char*)g.Bt + (size_t)u.pn * BM * g.K * 2; }
    __device__ int row_tok(const Unit&, int) const { return 0; }
};
struct BranchOrder {
    int nM, nN, nwg, G, c;
    __device__ void init(int M, int N, int G_, int c_) { nM = M / BM; nN = N / BM; nwg = nM * nN; G = G_; c = c_; }
    __device__ bool next(int i, Unit& u) const { const long L = (long)(i >> 2) * G + c; if (L >= nwg) return false; tile_pmpn((int)L, nM, nN, u.pm, u.pn); u.z = i & 3; return true; }
    __device__ const char* a_base(const Gemm& g, const Unit& u) const { return (const char*)g.A + ((size_t)u.pm * BM * g.lda + (size_t)u.z * 256) * 2; }
    __device__ const char* b_base(const Gemm& g, const Unit& u) const { return (const char*)g.Bt + ((size_t)u.z * 1024 * 256 + (size_t)u.pn * BM * g.K) * 2; }
    __device__ int row_tok(const Unit&, int) const { return 0; }
};
struct MoeOrder {
    int G, c, nN; int pre[9]; const int* list; int cnt[8]; size_t zstrideB;
    __device__ void init(unsigned* counts, const int* list_, int nN_, size_t zstrideB_, int G_, int c_) {
        G = G_; c = c_; nN = nN_; list = list_; zstrideB = zstrideB_; int p = 0;
#pragma unroll
        for (int e = 0; e < 8; ++e) { int n = __builtin_amdgcn_readfirstlane((int)__hip_atomic_load(counts + 64 * e, __ATOMIC_RELAXED, __HIP_MEMORY_SCOPE_AGENT)); if (n > 16384) n = 16384; cnt[e] = n; pre[e] = p; p += (n + 255) >> 8; }
        pre[8] = p;
    }
    __device__ bool next(int i, Unit& u) const {
        const long L = (long)i * G + c; if (L >= (long)pre[8] * nN) return false;
        const int rt = (int)(L / nN); u.pn = (int)(L % nN); u.pm = rt; int e = 0;
#pragma unroll
        for (int k = 1; k < 8; ++k) e += (rt >= pre[k]) ? 1 : 0;
        u.z = e; return true;
    }
    __device__ const char* a_base(const Gemm& g, const Unit& u) const { return (const char*)g.A + (size_t)u.pm * BM * g.lda * 2; }
    __device__ const char* b_base(const Gemm& g, const Unit& u) const { return (const char*)g.Bt + ((size_t)u.z * zstrideB + (size_t)u.pn * BM * g.K) * 2; }
    __device__ int row_tok(const Unit& u, int r) const {
        int e = 0, c0 = 0, p0 = 0;
#pragma unroll
        for (int k = 0; k < 8; ++k) if (k == u.z) { c0 = cnt[k]; p0 = pre[k]; }
        const int idx = (u.pm - p0) * 256 + r; (void)e;
        return idx < c0 ? list[u.z * 16384 + idx] : 0;
    }
};

__device__ __forceinline__ int lane_id_fresh_pg8() { int l; asm volatile("v_mbcnt_lo_u32_b32 %0, -1, 0\n\tv_mbcnt_hi_u32_b32 %0, -1, %0" : "=v"(l)); return l; }
__device__ __forceinline__ unsigned cvt_pk_bf16(float lo, float hi) { unsigned r; asm volatile("v_cvt_pk_bf16_f32 %0, %1, %2" : "=v"(r) : "v"(lo), "v"(hi)); return r; }

struct EpiStore {
    static constexpr bool PERM = true;
    bf16_t* O; int ldc;
    __device__ __forceinline__ void operator()(const f32x4 (&acc)[2][2][4][2], const Unit& u, int wr, int wc, int fr, int fq) const {
        const unsigned base = ((unsigned)(u.pm * BM + wr * 64 + fr) * (unsigned)ldc + (unsigned)(u.pn * BM + wc * 32 + 8 * fq)) * 2u;
        char* Ob = (char*)O;
#pragma unroll
        for (int ai = 0; ai < 2; ++ai)
#pragma unroll
            for (int m = 0; m < 4; ++m) { const unsigned off = base + (unsigned)((ai * HALF + m * 16) * 2) * (unsigned)ldc;
#pragma unroll
                for (int bj = 0; bj < 2; ++bj) { const f32x4 v0 = acc[ai][bj][m][0], v1 = acc[ai][bj][m][1];
                    u32x4 w; w.x = cvt_pk_bf16(v0[0], v0[1]); w.y = cvt_pk_bf16(v0[2], v0[3]); w.z = cvt_pk_bf16(v1[0], v1[1]); w.w = cvt_pk_bf16(v1[2], v1[3]);
                    *(u32x4*)(Ob + (off + (unsigned)(bj * HALF * 2))) = w; } }
    }
};
__device__ __forceinline__ float silu_f(float a) { return a * __builtin_amdgcn_rcpf(1.0f + __expf(-a)); }
struct EpiSwiglu {
    static constexpr bool PERM = true;
    bf16_t* O; int ldc;
    __device__ __forceinline__ void operator()(const f32x4 (&acc)[2][2][4][2], const Unit& u, int wr, int wc, int fr, int fq) const {
        const unsigned base = ((unsigned)(u.pm * BM + wr * 64 + fr) * (unsigned)ldc + (unsigned)(u.pn * HALF + wc * 32 + 8 * fq)) * 2u;
        char* Ob = (char*)O;
#pragma unroll
        for (int ai = 0; ai < 2; ++ai)
#pragma unroll
            for (int m = 0; m < 4; ++m) { const unsigned off = base + (unsigned)((ai * HALF + m * 16) * 2) * (unsigned)ldc;
                float h[8];
#pragma unroll
                for (int n = 0; n < 2; ++n)
#pragma unroll
                    for (int j = 0; j < 4; ++j) h[n * 4 + j] = silu_f(acc[ai][0][m][n][j]) * acc[ai][1][m][n][j];
                u32x4 w; w.x = cvt_pk_bf16(h[0], h[1]); w.y = cvt_pk_bf16(h[2], h[3]); w.z = cvt_pk_bf16(h[4], h[5]); w.w = cvt_pk_bf16(h[6], h[7]);
                *(u32x4*)(Ob + off) = w; }
    }
};
struct EpiResid {
    static constexpr bool PERM = false;
    const float* xin; float* out; const float* gate; int gate_bstride;
    __device__ __forceinline__ void operator()(const f32x4 (&acc)[2][2][4][2], const Unit& u, int wr, int wc, int fr, int fq) const {
        const int b = (u.pm * BM) >> 13; const int col0 = u.pn * BM + wc * 32 + 4 * fq;
        f32x4 gv[2][2];
#pragma unroll
        for (int bj = 0; bj < 2; ++bj)
#pragma unroll
            for (int n = 0; n < 2; ++n) gv[bj][n] = *(const f32x4*)(gate + (size_t)b * gate_bstride + col0 + bj * HALF + n * 16);
        const unsigned base = ((unsigned)(u.pm * BM + wr * 64 + fr) * 1024u + (unsigned)col0) * 4u;
        const char* xb = (const char*)xin; char* ob = (char*)out;
#pragma unroll
        for (int ai = 0; ai < 2; ++ai)
#pragma unroll
            for (int m = 0; m < 4; ++m) { const unsigned off = base + (unsigned)((ai * HALF + m * 16) * 4096);
#pragma unroll
                for (int bj = 0; bj < 2; ++bj)
#pragma unroll
                    for (int n = 0; n < 2; ++n) { const unsigned o2 = off + (unsigned)((bj * HALF + n * 16) * 4); const f32x4 xi = *(const f32x4*)(xb + o2); *(f32x4*)(ob + o2) = xi + gv[bj][n] * acc[ai][bj][m][n]; }
                if (m & 1) asm volatile("" ::: "memory"); }
    }
};
__device__ __forceinline__ float sigmoid_f(float a) { return __builtin_amdgcn_rcpf(1.0f + __expf(-a)); }
struct EpiGate {
    static constexpr bool PERM = true;
    const bf16_t* proj; int ldp; int cmg; float* G; bf16_t* gated;
    __device__ __forceinline__ void operator()(const f32x4 (&acc)[2][2][4][2], const Unit& u, int wr, int wc, int fr, int fq) const {
        const unsigned row0 = (unsigned)(u.pm * BM + wr * 64 + fr), col0 = (unsigned)(u.pn * BM + wc * 32 + 8 * fq);
        const unsigned pbase = (row0 * (unsigned)ldp + (unsigned)(cmg + u.z * 1024) + col0) * 2u, gbase = (row0 * 1024u + col0) * 4u;
        const char* pb = (const char*)proj; char* gb = (char*)G; char* ob = (char*)gated;
#pragma unroll
        for (int ai = 0; ai < 2; ++ai)
#pragma unroll
            for (int m = 0; m < 4; ++m) { const unsigned rr = (unsigned)(ai * HALF + m * 16);
#pragma unroll
                for (int bj = 0; bj < 2; ++bj) {
                    const u32x4 mg = *(const u32x4*)(pb + (pbase + rr * (unsigned)(ldp * 2) + (unsigned)(bj * HALF * 2)));
                    const unsigned go = gbase + rr * 4096u + (unsigned)(bj * HALF * 4);
                    float v[8];
#pragma unroll
                    for (int k = 0; k < 4; ++k) { const unsigned w = mg[k]; const float l0 = __uint_as_float(w << 16), l1 = __uint_as_float(w & 0xffff0000u);
                        v[2 * k] = sigmoid_f(l0) * acc[ai][bj][m][k >> 1][(2 * k) & 3]; v[2 * k + 1] = sigmoid_f(l1) * acc[ai][bj][m][k >> 1][(2 * k + 1) & 3]; }
                    if (u.z != 0) { const f32x4 g0 = *(const f32x4*)(gb + go), g1 = *(const f32x4*)(gb + go + 16);
#pragma unroll
                        for (int k = 0; k < 4; ++k) { v[k] += g0[k]; v[4 + k] += g1[k]; } }
                    if (u.z != 3) { *(f32x4*)(gb + go) = (f32x4){v[0], v[1], v[2], v[3]}; *(f32x4*)(gb + go + 16) = (f32x4){v[4], v[5], v[6], v[7]}; }
                    else { u32x4 w; w.x = cvt_pk_bf16(v[0], v[1]); w.y = cvt_pk_bf16(v[2], v[3]); w.z = cvt_pk_bf16(v[4], v[5]); w.w = cvt_pk_bf16(v[6], v[7]); *(u32x4*)(ob + (go >> 1)) = w; } }
                asm volatile("" ::: "memory"); }
    }
};

template <class Epi, class Sched, bool ALIGN_EPI, bool GATHER>
__device__ __forceinline__ void gemm_phase(PG8_LAS unsigned char* lds, const Gemm g, const Sched& S, const Epi& E, int tid) {
    asm volatile("" : "+v"(tid));
    const int wid = __builtin_amdgcn_readfirstlane(tid >> 6), lane = tid & 63, wr = wid >> 2, wc = wid & 3, fr = lane & 15, fq = lane >> 4;
    int K = g.K; asm volatile("" : "+s"(K));
    const int nt = K / BK;
    unsigned voffA[2], voffB[2]; int RA[2], CA[2];
#pragma unroll
    for (int i = 0; i < 2; ++i) { int R, C; stage_rc(tid * 16 + i * 8192, R, C); const int Rb = Epi::PERM ? ((R & ~31) + perm32(R & 31)) : R;
        RA[i] = R; CA[i] = C; voffA[i] = (unsigned)(R * g.lda + C) * 2u; voffB[i] = (unsigned)(Rb * K + C) * 2u; }
    const size_t kstep = (size_t)(BK * 2);
    const size_t hstepA = (size_t)HALF * g.lda * 2, hstepB = (size_t)HALF * K * 2;
    const unsigned ldsw = (unsigned)wid * 1024u;
    const int aoff = lds_byte(wr * 64 + fr, fq * 8), boff = lds_byte(wc * 32 + fr, fq * 8);
#define PG8_SA(b, h) (((b) * 2 + (h)) * HTB)
#define PG8_SB(b, h) ((4 + (b) * 2 + (h)) * HTB)
#define PG8_STAGE(bufoff, gbase, voff) do { _Pragma("unroll") for (int _i = 0; _i < 2; ++_i) \
        __builtin_amdgcn_global_load_lds((const unsigned*)((const char*)(gbase) + (voff)[_i]), (PG8_LAS unsigned*)(lds + (bufoff) + ldsw + _i * 8192), 16, 0, 0); } while (0)
#define PG8_STAGE_A(bufoff, kbase, h, GV) do { if constexpr (GATHER) { PG8_STAGE(bufoff, kbase, (GV)[h]); } else { PG8_STAGE(bufoff, (kbase) + (h) * hstepA, voffA); } } while (0)
#define PG8_LDA(dst, b, h) do { _Pragma("unroll") for (int m = 0; m < 4; ++m) _Pragma("unroll") for (int k = 0; k < 2; ++k) dst[m][k] = *(const PG8_LAS bf16x8*)(lds + PG8_SA(b, h) + aoff + m * 2048 + k * 1024); } while (0)
#define PG8_LDB(dst, b, h) do { _Pragma("unroll") for (int n = 0; n < 2; ++n) _Pragma("unroll") for (int k = 0; k < 2; ++k) dst[n][k] = *(const PG8_LAS bf16x8*)(lds + PG8_SB(b, h) + boff + n * 2048 + k * 1024); } while (0)
#define PG8_MMA(ai, bj, At, Bt) do { __builtin_amdgcn_s_setprio(1); _Pragma("unroll") for (int m = 0; m < 4; ++m) _Pragma("unroll") for (int n = 0; n < 2; ++n) _Pragma("unroll") for (int k = 0; k < 2; ++k) \
        acc[ai][bj][m][n] = __builtin_amdgcn_mfma_f32_16x16x32_bf16(Bt[n][k], At[m][k], acc[ai][bj][m][n], 0, 0, 0); __builtin_amdgcn_s_setprio(0); } while (0)
#define PG8_WAIT_V(n) asm volatile("s_waitcnt vmcnt(" #n ")" ::: "memory")
#define PG8_WAIT_L(n) asm volatile("s_waitcnt lgkmcnt(" #n ")" ::: "memory")
#define PG8_BAR __builtin_amdgcn_s_barrier()
#define PG8_SCHED __builtin_amdgcn_sched_barrier(0)
#define PG8_GOFFS(dst, un) do { _Pragma("unroll") for (int _h = 0; _h < 2; ++_h) _Pragma("unroll") for (int _i = 0; _i < 2; ++_i) \
        dst[_h][_i] = (unsigned)S.row_tok(un, _h * HALF + RA[_i]) * (unsigned)(g.lda * 2) + (unsigned)(CA[_i] * 2); } while (0)
    Unit cur, nxt; int ui = 0;
    if (!S.next(0, cur)) return;
    f32x4 acc[2][2][4][2];
#pragma unroll
    for (int a = 0; a < 2; ++a)
#pragma unroll
        for (int b = 0; b < 2; ++b)
#pragma unroll
            for (int m = 0; m < 4; ++m)
#pragma unroll
                for (int n = 0; n < 2; ++n) acc[a][b][m][n] = (f32x4){0.f, 0.f, 0.f, 0.f};
    bf16x8 At[4][2], B0[2][2], B1[2][2];
    unsigned gC[2][2] = {{0u, 0u}, {0u, 0u}}, gN[2][2] = {{0u, 0u}, {0u, 0u}};
    const char* cA = GATHER ? (const char*)g.A : S.a_base(g, cur); const char* cB = S.b_base(g, cur);
    if constexpr (GATHER) { PG8_GOFFS(gC, cur); asm volatile("s_waitcnt vmcnt(0)" ::: "memory"); }
    PG8_STAGE(PG8_SB(0, 0), cB, voffB); PG8_STAGE(PG8_SB(0, 1), cB + hstepB, voffB); PG8_STAGE_A(PG8_SA(0, 0), cA, 0, gC); PG8_STAGE_A(PG8_SA(0, 1), cA, 1, gC);
    if (wr == 1) PG8_BAR;
    PG8_WAIT_V(2); PG8_BAR;
    PG8_STAGE(PG8_SB(1, 0), cB + kstep, voffB); PG8_STAGE_A(PG8_SA(1, 0), cA + kstep, 0, gC); PG8_STAGE(PG8_SB(1, 1), cB + hstepB + kstep, voffB);
    PG8_WAIT_V(6); PG8_BAR;
    for (;;) {
        const bool has_next = S.next(ui + 1, nxt);
        const char* nA = GATHER ? (const char*)g.A : (has_next ? S.a_base(g, nxt) : cA); const char* nB = has_next ? S.b_base(g, nxt) : cB;
        if constexpr (GATHER) {
            if (has_next) { PG8_GOFFS(gN, nxt); }
            else {
#pragma unroll
                for (int _h = 0; _h < 2; ++_h)
#pragma unroll
                    for (int _i = 0; _i < 2; ++_i) gN[_h][_i] = gC[_h][_i];
            }
        }
        for (int t = 0; t < nt; t += 2) {
            const bool last = (t == nt - 2);
            const char* a1 = cA + (size_t)(t + 1) * kstep;
            const char* a2 = last ? nA : cA + (size_t)(t + 2) * kstep; const char* b2 = last ? nB : cB + (size_t)(t + 2) * kstep;
            const char* a3 = a2 + kstep; const char* b3 = b2 + kstep;
            unsigned g2[2][2];
            if constexpr (GATHER) {
#pragma unroll
                for (int _h = 0; _h < 2; ++_h)
#pragma unroll
                    for (int _i = 0; _i < 2; ++_i) g2[_h][_i] = last ? gN[_h][_i] : gC[_h][_i];
            }
            PG8_LDB(B0, 0, 0); PG8_LDB(B1, 0, 1); PG8_SCHED; PG8_LDA(At, 0, 0); PG8_STAGE_A(PG8_SA(1, 1), a1, 1, gC);
            PG8_WAIT_V(8); PG8_WAIT_L(0); PG8_BAR; PG8_MMA(0, 0, At, B0); PG8_MMA(0, 1, At, B1); PG8_BAR; PG8_SCHED;
            PG8_LDA(At, 0, 1); PG8_STAGE(PG8_SB(0, 0), b2, voffB); PG8_STAGE(PG8_SB(0, 1), b2 + hstepB, voffB); PG8_STAGE_A(PG8_SA(0, 0), a2, 0, g2);
            PG8_WAIT_V(8); PG8_WAIT_L(0); PG8_BAR; PG8_MMA(1, 0, At, B0); PG8_MMA(1, 1, At, B1); PG8_BAR; PG8_SCHED;
            PG8_LDB(B0, 1, 0); PG8_LDB(B1, 1, 1); PG8_SCHED; PG8_LDA(At, 1, 0); PG8_STAGE_A(PG8_SA(0, 1), a2, 1, g2);
            PG8_WAIT_V(8); PG8_WAIT_L(0); PG8_BAR; PG8_MMA(0, 0, At, B0); PG8_MMA(0, 1, At, B1); PG8_BAR; PG8_SCHED;
            PG8_LDA(At, 1, 1); PG8_STAGE(PG8_SB(1, 0), b3, voffB); PG8_STAGE(PG8_SB(1, 1), b3 + hstepB, voffB); PG8_STAGE_A(PG8_SA(1, 0), a3, 0, g2);
            PG8_WAIT_V(8); PG8_WAIT_L(0); PG8_BAR; PG8_MMA(1, 0, At, B0); PG8_MMA(1, 1, At, B1); PG8_BAR; PG8_SCHED;
        }
        if constexpr (ALIGN_EPI) { if (wr == 0) PG8_BAR; }
        { const int l2_ = lane_id_fresh_pg8();
          E(acc, cur, wr, wc, l2_ & 15, l2_ >> 4); }
        if (!has_next) break;
#pragma unroll
        for (int a = 0; a < 2; ++a)
#pragma unroll
            for (int b = 0; b < 2; ++b)
#pragma unroll
                for (int m = 0; m < 4; ++m)
#pragma unroll
                    for (int n = 0; n < 2; ++n) acc[a][b][m][n] = (f32x4){0.f, 0.f, 0.f, 0.f};
        cur = nxt; cA = nA; cB = nB; ++ui;
        if constexpr (GATHER) {
#pragma unroll
            for (int _h = 0; _h < 2; ++_h)
#pragma unroll
                for (int _i = 0; _i < 2; ++_i) gC[_h][_i] = gN[_h][_i];
        }
        if constexpr (ALIGN_EPI) { if (wr == 1) PG8_BAR; }
    }
    PG8_WAIT_V(0);
    if constexpr (!ALIGN_EPI) { if (wr == 0) PG8_BAR; }
    PG8_BAR;
#undef PG8_SA
#undef PG8_SB
#undef PG8_STAGE
#undef PG8_STAGE_A
#undef PG8_LDA
#undef PG8_LDB
#undef PG8_MMA
#undef PG8_WAIT_V
#undef PG8_WAIT_L
#undef PG8_BAR
#undef PG8_SCHED
#undef PG8_GOFFS
}
}

constexpr int NWAVES = 8;
constexpr int BATCH = 2, SEQ = 8192, D = 1024, M = BATCH * SEQ, NP = 7168, DFF = 2816, NE = 8, INC = 7056;
constexpr int MROWS_MOE = 2 * M + 2048;
constexpr int C_NSAQ = 0, C_KC = 256, C_VC = 320, C_KSL = 384, C_VSL = 448, C_KW = 512, C_VW = 576, C_AG = 640, C_DF = 652,
              C_BQ = 768, C_BK = 1024, C_BV = 1280, C_CQ = 1536, C_CK = 1792, C_CV = 2048, C_DQ = 2304, C_DK = 2560, C_DV = 2816, C_MG = 3072;
constexpr float EPS = 1e-6f;
constexpr float SKIP_THR = 40.0f;

constexpr size_t MiB = 1u << 20;
constexpr size_t WS_CTL = 0, CTL_ZERO_BYTES = 1 * MiB;
constexpr size_t WS_MOD = 1 * MiB;
constexpr size_t WS_LIST = 1 * MiB + 256 * 1024;
constexpr size_t WS_TOKINFO = 2 * MiB;
constexpr size_t WS_Y = 4 * MiB;
constexpr size_t WS_ROPE_C = 4 * MiB, WS_ROPE_S = 5 * MiB;
constexpr size_t WS_KCMP = 6 * MiB, WS_VCMP = 6 * MiB + 256 * 1024;
constexpr size_t WS_WIN = 16 * MiB;
constexpr size_t WS_WBR = 44 * MiB;
constexpr size_t WS_WOUT = 48 * MiB;
constexpr size_t WS_W13 = 52 * MiB;
constexpr size_t WS_W2 = 63 * MiB;
constexpr size_t WS_ARENA = 72 * MiB;
constexpr size_t WS_PROJ = WS_ARENA;
constexpr size_t WS_O = WS_ARENA + 224 * MiB;
constexpr size_t WS_GACC = WS_ARENA + 256 * MiB;
constexpr size_t WS_H = WS_ARENA + 320 * MiB;
constexpr size_t WS_HMID = WS_ARENA;
constexpr size_t WS_MOEW13 = WS_ARENA;
constexpr size_t WS_MOEW2 = WS_ARENA + 88 * MiB;
constexpr size_t WS_HMID_MOE = WS_ARENA + 132 * MiB;
constexpr size_t WS_END = WS_ARENA + 352 * MiB;
static_assert(WS_HMID_MOE + (size_t)MROWS_MOE * DFF * 2 <= WS_H, "moe hmid vs H");
static_assert(WS_Y + (size_t)MROWS_MOE * 1024 * 2 <= WS_ARENA, "Y overlay");
constexpr int CW_BAR = 4096;
constexpr int CW_MOECNT = 1024;

constexpr int RING_BYTES = 131072;
constexpr int MISC_OFF = RING_BYTES + 320;
constexpr int LDS_BYTES = 147456;

#define GAS __attribute__((address_space(1)))
#define LAS __attribute__((address_space(3)))
typedef unsigned short bf16;
typedef unsigned v4u __attribute__((ext_vector_type(4)));
typedef float f32x4 __attribute__((ext_vector_type(4)));
typedef GAS unsigned gu32;
#define RLX_AGENT __ATOMIC_RELAXED, __HIP_MEMORY_SCOPE_AGENT
#define LDS_WAIT() asm volatile("s_waitcnt lgkmcnt(0)" ::: "memory")
__device__ __forceinline__ unsigned f2bf(float f) { unsigned u = __builtin_bit_cast(unsigned, f); return (u + 0x7fffu + ((u >> 16) & 1u)) >> 16; }
__device__ __forceinline__ unsigned pk2(float lo, float hi) { return f2bf(lo) | (f2bf(hi) << 16); }
__device__ __forceinline__ float bf2f(unsigned short v) { return __uint_as_float((unsigned)v << 16); }
__device__ __forceinline__ int lane_id_fresh() { int l; asm volatile("v_mbcnt_lo_u32_b32 %0, -1, 0\n\tv_mbcnt_hi_u32_b32 %0, -1, %0" : "=v"(l)); return l; }

#define XB_TMO      128
#define XB_XCNT(j)  (256  + 64 * (j))
#define XB_XSUB(j)  (1280 + 64 * (j))
#define XB_XGEN(j)  (2304 + 64 * (j))
#define XB_TOP      3328
#define XB_TOPGEN   3392
#define XCD_BAR_WORDS 3456
#define XB_SPIN_CAP (1u << 22)
__device__ __forceinline__ unsigned xb_ld(unsigned* p)              { return __hip_atomic_load(p, __ATOMIC_RELAXED, __HIP_MEMORY_SCOPE_AGENT); }
__device__ __forceinline__ unsigned xb_add(unsigned* p, unsigned v) { return __hip_atomic_fetch_add(p, v, __ATOMIC_RELAXED, __HIP_MEMORY_SCOPE_AGENT); }
__device__ __forceinline__ unsigned xb_xcc_id() { return (unsigned)__builtin_amdgcn_s_getreg((3 << 11) | 20) & 0xFu; }
#define XB_SPIN(cond, bar) do { unsigned _sp = 0; while (cond) { __builtin_amdgcn_s_sleep(1); \
    if ((++_sp & 255u) == 0u) { if (xb_ld(&(bar)[XB_TMO])) break; if (_sp > XB_SPIN_CAP) { atomicAdd(&(bar)[XB_TMO], 1u); break; } } } } while (0)
struct XcdBarrier { unsigned* bar; unsigned x; volatile LAS unsigned* st; };
__device__ __forceinline__ XcdBarrier xcd_barrier_post(unsigned* bar, volatile LAS unsigned* st, bool leader) {
    XcdBarrier b; b.bar = bar; b.x = xb_xcc_id(); b.st = st;
    if (leader) (void)xb_add(&bar[XB_XCNT(b.x)], 1u);
    return b;
}
__device__ __forceinline__ void xcd_barrier_complete(unsigned* bar, unsigned x, unsigned& nloc, unsigned& nx) {
    const unsigned G = gridDim.x * gridDim.y * gridDim.z;
    unsigned sum, cnt, mine, sp = 0u;
    for (;;) {
        sum = 0u; cnt = 0u; mine = 0u;
#pragma unroll
        for (unsigned j = 0; j < 16; ++j) { const unsigned c = xb_ld(&bar[XB_XCNT(j)]); sum += c; cnt += (c > 0u) ? 1u : 0u; mine = (j == x) ? c : mine; }
        if (sum == G) break;
        __builtin_amdgcn_s_sleep(1);
        if ((++sp & 255u) == 0u) { if (xb_ld(&bar[XB_TMO])) break; if (sp > XB_SPIN_CAP) { atomicAdd(&bar[XB_TMO], 1u); break; } }
    }
    nloc = mine > 0u ? mine : 1u; nx = cnt > 0u ? cnt : 1u;
}
__device__ __forceinline__ void xcd_barrier(const XcdBarrier& b, bool leader) {
    asm volatile("s_waitcnt vmcnt(0)" ::: "memory");
    __syncthreads();
    if (leader) {
        unsigned* bar = b.bar;
        __builtin_amdgcn_s_waitcnt(0);
        unsigned nloc = b.st[0], nx = b.st[1];
        if (nloc == 0u) { xcd_barrier_complete(bar, b.x, nloc, nx); b.st[0] = nloc; b.st[1] = nx; }
        const unsigned old = xb_add(&bar[XB_XSUB(b.x)], 1u);
        const unsigned gen = old / nloc;
        if (old + 1u == (gen + 1u) * nloc) {
            __builtin_amdgcn_fence(__ATOMIC_RELEASE, "agent");
            asm volatile("s_waitcnt vmcnt(0)" ::: "memory");
            const unsigned og = xb_add(&bar[XB_TOP], 1u);
            const unsigned tg = og / nx;
            if (og + 1u == (tg + 1u) * nx) xb_add(&bar[XB_TOPGEN], 1u);
            else XB_SPIN(xb_ld(&bar[XB_TOPGEN]) == tg, bar);
            __builtin_amdgcn_fence(__ATOMIC_ACQUIRE, "agent");
            xb_add(&bar[XB_XGEN(b.x)], 1u);
            asm volatile("s_waitcnt vmcnt(0)" ::: "memory");
        } else {
            XB_SPIN(xb_ld(&bar[XB_XGEN(b.x)]) == gen, bar);
            __builtin_amdgcn_fence(__ATOMIC_ACQUIRE, "agent");
            asm volatile("s_waitcnt vmcnt(0)" ::: "memory");
        }
    }
    __syncthreads();
}

struct Args { const void* in[25]; float* out; unsigned char* ws; int ph_lo, ph_hi; };
typedef const __attribute__((address_space(4))) Args* ArgsP;
struct Frame {
    LAS unsigned char* lds;
    int tid, lane, wave, G, gw, NGW;
    unsigned char* ws;
    gu32* ctl;
};

template <int K> __device__ __forceinline__ float swz_xor(float v) { return __int_as_float(__builtin_amdgcn_ds_swizzle(__float_as_int(v), (K << 10) | 0x1f)); }
template <int K> __device__ __forceinline__ int swz_xor_i(int v) { return __builtin_amdgcn_ds_swizzle(v, (K << 10) | 0x1f); }
__device__ __forceinline__ float wave_sum(float v) {
    v += swz_xor<1>(v); v += swz_xor<2>(v); v += swz_xor<4>(v); v += swz_xor<8>(v); v += swz_xor<16>(v);
    const auto r = __builtin_amdgcn_permlane32_swap(__float_as_uint(v), __float_as_uint(v), false, false);
    return __uint_as_float(r[0]) + __uint_as_float(r[1]);
}

struct MapIdent { const float* W; int N; __device__ const float* operator()(int n) const { return W + n; } __device__ int stride() const { return N; } };
struct MapWin {
    const float* W;
    __device__ const float* operator()(int j) const {
        int o;
        if (j < 652) o = j; else if (j < 656) o = 2956 + (j - 652); else if (j < 768) return nullptr; else if (j < 3072) o = 652 + (j - 768); else o = 2960 + (j - 3072);
        return W + o;
    }
    __device__ int stride() const { return INC; }
};
struct MapW13 {
    const float* W1; const float* W3;
    __device__ const float* operator()(int j) const { const int tile = j >> 8, r = j & 255; return (r < 128) ? (W1 + tile * 128 + r) : (W3 + tile * 128 + (r - 128)); }
    __device__ int stride() const { return DFF; }
};
template <class Map>
__device__ __forceinline__ void transpose_item(const Map mp, int K, bf16* WT, LAS float* scr, int kb, int nb, int lane) {
    const int k0 = 64 * kb, n0 = 32 * nb; const float* cp = mp(n0 + (lane & 31)); const int st = mp.stride();
#pragma unroll 8
    for (int i = 0; i < 32; ++i) { const int kk = 2 * i + (lane >> 5); scr[kk * 33 + (lane & 31)] = cp ? cp[(size_t)(k0 + kk) * st] : 0.f; }
    LDS_WAIT(); asm volatile("" ::: "memory");
    const int c = lane & 7;
#pragma unroll
    for (int j = 0; j < 4; ++j) { const int n = (lane >> 3) + 8 * j; const LAS float* s = scr + (8 * c) * 33 + n;
        v4u o; o.x = pk2(s[0 * 33], s[1 * 33]); o.y = pk2(s[2 * 33], s[3 * 33]); o.z = pk2(s[4 * 33], s[5 * 33]); o.w = pk2(s[6 * 33], s[7 * 33]);
        *(GAS v4u*)(WT + (size_t)(n0 + n) * K + k0 + 8 * c) = o; }
    LDS_WAIT(); asm volatile("" ::: "memory");
}
template <class Map>
__device__ __forceinline__ void transpose_all(Frame& F, const Map mp, int K, int Nout, bf16* WT, int& itbase) {
    LAS float* scr = (LAS float*)(F.lds + F.wave * 16384);
    const int nblk = Nout / 32, n = (K / 64) * nblk;
    int first = (F.gw - (itbase % F.NGW) + F.NGW) % F.NGW;
    for (int it = first; it < n; it += F.NGW) transpose_item(mp, K, WT, scr, it / nblk, it % nblk, F.lane);
    itbase += n;
}

__device__ __forceinline__ float gelu_tanh(float x) { const float u = 0.7978845608028654f * (x + 0.044715f * x * x * x); return 0.5f * x * (1.0f + tanhf(u)); }
__device__ __forceinline__ float log_sigmoid(float x) { return fminf(x, 0.f) - log1pf(__expf(-fabsf(x))); }

__device__ __forceinline__ void load64(const bf16* p, float (&v)[64]) {
    const v4u* p4 = (const v4u*)p;
#pragma unroll
    for (int i = 0; i < 8; ++i) { const v4u u = p4[i];
#pragma unroll
        for (int k = 0; k < 4; ++k) { v[8 * i + 2 * k] = __uint_as_float(u[k] << 16); v[8 * i + 2 * k + 1] = __uint_as_float(u[k] & 0xffff0000u); } }
}
__device__ __forceinline__ float dot64(const bf16* p, const float (&q)[64]) {
    const v4u* p4 = (const v4u*)p; float s0 = 0.f, s1 = 0.f;
#pragma unroll
    for (int i = 0; i < 8; ++i) { if (i == 4) asm volatile("" ::: "memory"); const v4u u = p4[i];
#pragma unroll
        for (int k = 0; k < 4; ++k) { s0 += __uint_as_float(u[k] << 16) * q[8 * i + 2 * k]; s1 += __uint_as_float(u[k] & 0xffff0000u) * q[8 * i + 2 * k + 1]; } }
    return s0 + s1;
}
__device__ __forceinline__ void axpy64(const bf16* p, float w, float (&o)[64]) {
    const v4u* p4 = (const v4u*)p;
#pragma unroll
    for (int i = 0; i < 8; ++i) { if (i == 4) asm volatile("" ::: "memory"); const v4u u = p4[i];
#pragma unroll
        for (int k = 0; k < 4; ++k) { o[8 * i + 2 * k] += w * __uint_as_float(u[k] << 16); o[8 * i + 2 * k + 1] += w * __uint_as_float(u[k] & 0xffff0000u); } }
}
__device__ __forceinline__ void store64(bf16* p, const float (&v)[64]) {
    v4u* p4 = (v4u*)p;
#pragma unroll
    for (int i = 0; i < 8; ++i) { v4u u;
#pragma unroll
        for (int k = 0; k < 4; ++k) u[k] = pk2(v[8 * i + 2 * k], v[8 * i + 2 * k + 1]);
        p4[i] = u; }
}
#define SOFTMAX_STEP(s_, vp_) do { const float _s = (s_); if (_s > m_run) { const float _f = __expf(m_run - _s); l_run *= _f; _Pragma("unroll") for (int _d = 0; _d < 64; ++_d) o[_d] *= _f; m_run = _s; } \
    const float _p = __expf(_s - m_run); l_run += _p; axpy64((vp_), _p, o); } while (0)

__device__ __forceinline__ void phase_prologue(Frame& F, ArgsP a) {
    const float* c_in = (const float*)a->in[1]; const int* pos = (const int*)a->in[2];
    const float* w_ada = (const float*)a->in[3]; const float* b_ada = (const float*)a->in[4];
    {
        LAS float* sc = (LAS float*)(F.lds);
        LAS float* part = (LAS float*)(F.lds + 8192);
        for (int i = F.tid; i < 2048; i += NWAVES * 64) { const float v = c_in[i]; sc[i] = v / (1.0f + __expf(-v)); }
        __syncthreads();
        for (int it = blockIdx.x; it < 2 * 96; it += F.G) {
            const int l = it / 96, j0 = (it % 96) * 64; const float* W = w_ada + (size_t)l * 1024 * 6144 + j0 + F.lane;
            float a0 = 0.f, a1 = 0.f;
#pragma unroll 16
            for (int k = 0; k < 128; ++k) { const int kk = F.wave * 128 + k; const float w = W[(size_t)kk * 6144]; a0 += sc[kk] * w; a1 += sc[1024 + kk] * w; }
            part[(F.wave * 2 + 0) * 64 + F.lane] = a0; part[(F.wave * 2 + 1) * 64 + F.lane] = a1;
            __syncthreads();
            if (F.wave < 2) { float s = 0.f;
#pragma unroll
                for (int w = 0; w < 8; ++w) s += part[(w * 2 + F.wave) * 64 + F.lane];
                ((float*)(F.ws + WS_MOD))[((size_t)l * 2 + F.wave) * 6144 + j0 + F.lane] = s + b_ada[(size_t)l * 6144 + j0 + F.lane]; }
            __syncthreads();
        }
    }
    {
        float* rc = (float*)(F.ws + WS_ROPE_C); float* rs = (float*)(F.ws + WS_ROPE_S);
        for (int i = blockIdx.x * (NWAVES * 64) + F.tid; i < M * 8; i += F.G * NWAVES * 64) {
            const int tok = i >> 3, fi = i & 7;
            const float inv = fi == 0 ? 1.0f : fi == 1 ? 0.1939227432012558f : fi == 2 ? 0.03760603070259094f : fi == 3 ? 0.007292664609849453f : fi == 4 ? 0.0014142135623842478f
                            : fi == 5 ? 0.00027424818836152554f : fi == 6 ? 5.318296098266728e-05f : 1.0313386155758053e-05f;
            const float ang = (float)pos[tok] * inv;
            double rev = (double)ang * 0.15915494309189535; rev -= floor(rev);
            const float fr = (float)rev;
            rs[i] = __builtin_amdgcn_sinf(fr); rc[i] = __builtin_amdgcn_cosf(fr);
        }
    }
    {
        int itb = 0;
        const float* w_in = (const float*)a->in[7]; const float* w_br = (const float*)a->in[16]; const float* w_out = (const float*)a->in[17];
        for (int l = 0; l < 2; ++l) {
            transpose_all(F, MapWin{w_in + (size_t)l * 1024 * INC}, 1024, NP, (bf16*)(F.ws + WS_WIN) + (size_t)l * NP * 1024, itb);
            for (int z = 0; z < 4; ++z) transpose_all(F, MapIdent{w_br + ((size_t)l * 4 + z) * 256 * 1024, 1024}, 256, 1024, (bf16*)(F.ws + WS_WBR) + ((size_t)l * 4 + z) * 1024 * 256, itb);
            transpose_all(F, MapIdent{w_out + (size_t)l * 1024 * 1024, 1024}, 1024, 1024, (bf16*)(F.ws + WS_WOUT) + (size_t)l * 1024 * 1024, itb);
        }
        transpose_all(F, MapW13{(const float*)a->in[18], (const float*)a->in[19]}, 1024, 2 * DFF, (bf16*)(F.ws + WS_W13), itb);
        transpose_all(F, MapIdent{(const float*)a->in[20], 1024}, DFF, 1024, (bf16*)(F.ws + WS_W2), itb);
    }
}
__device__ __forceinline__ void phase_moe_weights(Frame& F, ArgsP a) {
    int itb = 0;
    const float* w1 = (const float*)a->in[22]; const float* w3 = (const float*)a->in[23]; const float* w2 = (const float*)a->in[24];
    for (int e = 0; e < NE; ++e) {
        transpose_all(F, MapW13{w1 + (size_t)e * 1024 * DFF, w3 + (size_t)e * 1024 * DFF}, 1024, 2 * DFF, (bf16*)(F.ws + WS_MOEW13) + (size_t)e * 2 * DFF * 1024, itb);
        transpose_all(F, MapIdent{w2 + (size_t)e * DFF * 1024, 1024}, DFF, 1024, (bf16*)(F.ws + WS_MOEW2) + (size_t)e * 1024 * DFF, itb);
    }
}

template <bool ROUTE>
__device__ __forceinline__ void phase_norm(Frame& F, const float* x, const float* nw, const float* sh, const float* sc, const float* router) {
    bf16* H = (bf16*)(F.ws + WS_H);
    const int rows_per = ROUTE ? 8 : 1;
    for (int r0 = F.gw * rows_per; r0 < M; r0 += F.NGW * rows_per) {
        const int b = r0 >> 13;
        f32x4 A[4], Bv[4];
#pragma unroll
        for (int j = 0; j < 4; ++j) { const int c = 4 * F.lane + 256 * j; const f32x4 w = *(const f32x4*)(nw + c), s = *(const f32x4*)(sc + (size_t)b * 6144 + c); A[j] = w * (s + 1.0f); Bv[j] = *(const f32x4*)(sh + (size_t)b * 6144 + c); }
        int myE = 0; float myG = 0.f;
        for (int rr = 0; rr < rows_per; ++rr) {
            const int m = r0 + rr;
            const GAS f32x4* xr = (const GAS f32x4*)(x + (size_t)m * D) + F.lane;
            f32x4 v[4]; float s2 = 0.f;
#pragma unroll
            for (int j = 0; j < 4; ++j) { v[j] = xr[64 * j]; s2 += (v[j].x * v[j].x + v[j].y * v[j].y) + (v[j].z * v[j].z + v[j].w * v[j].w); }
            const float rstd = 1.0f / sqrtf(wave_sum(s2) * (1.f / D) + EPS);
#pragma unroll
            for (int j = 0; j < 4; ++j) v[j] = (v[j] * rstd) * A[j] + Bv[j];
            GAS unsigned long long* o8 = (GAS unsigned long long*)(H + (size_t)m * D) + F.lane;
#pragma unroll
            for (int j = 0; j < 4; ++j) o8[64 * j] = (unsigned long long)pk2(v[j].x, v[j].y) | ((unsigned long long)pk2(v[j].z, v[j].w) << 32);
            if constexpr (ROUTE) {
                float lg[8];
#pragma unroll
                for (int e = 0; e < 8; ++e) lg[e] = 0.f;
#pragma unroll
                for (int j = 0; j < 4; ++j)
#pragma unroll
                    for (int k = 0; k < 4; ++k) { const int c = 4 * F.lane + 256 * j + k; const f32x4 w0 = *(const f32x4*)(router + (size_t)c * 8), w1 = *(const f32x4*)(router + (size_t)c * 8 + 4); const float xv = v[j][k];
                        lg[0] += xv * w0.x; lg[1] += xv * w0.y; lg[2] += xv * w0.z; lg[3] += xv * w0.w; lg[4] += xv * w1.x; lg[5] += xv * w1.y; lg[6] += xv * w1.z; lg[7] += xv * w1.w; }
#pragma unroll
                for (int e = 0; e < 8; ++e) lg[e] = wave_sum(lg[e]);
                int e0 = 0; float v0 = lg[0];
#pragma unroll
                for (int e = 1; e < 8; ++e) if (lg[e] > v0) { v0 = lg[e]; e0 = e; }
                int e1 = -1; float v1 = -3.0e38f;
#pragma unroll
                for (int e = 0; e < 8; ++e) if (e != e0 && lg[e] > v1) { v1 = lg[e]; e1 = e; }
                const float g0 = 1.0f / (1.0f + __expf(v1 - v0)), g1 = 1.0f - g0;
                if (F.lane == 2 * rr) { myE = e0; myG = g0; }
                if (F.lane == 2 * rr + 1) { myE = e1; myG = g1; }
            }
        }
        if constexpr (ROUTE) {
            gu32* cnt = F.ctl + CW_MOECNT; int* list = (int*)(F.ws + WS_LIST); int* info = (int*)(F.ws + WS_TOKINFO);
            const bool act = F.lane < 16; int myrank = 0;
#pragma unroll
            for (int e = 0; e < 8; ++e) {
                const unsigned long long mk = __ballot(act && myE == e);
                const int c = __popcll(mk); unsigned base = 0;
                if (c > 0) { if (F.lane == 0) base = __hip_atomic_fetch_add(cnt + 64 * e, (unsigned)c, RLX_AGENT); base = __builtin_amdgcn_readfirstlane(base); }
                if (act && myE == e) myrank = (int)base + __popcll(mk & ((1ull << F.lane) - 1ull));
            }
            if (act) { const int tok = r0 + (F.lane >> 1); list[myE * 16384 + myrank] = tok; int* ip = info + ((size_t)tok * 2 + (F.lane & 1)) * 4; ip[0] = myE; ip[1] = myrank; ip[2] = __float_as_int(myG); ip[3] = 0; }
        }
    }
}

__device__ __forceinline__ void phase_qknorm(Frame& F, const float* qk_gain  ) {
    bf16* P = (bf16*)(F.ws + WS_PROJ); const float* rc = (const float*)(F.ws + WS_ROPE_C); const float* rs = (const float*)(F.ws + WS_ROPE_S);
    for (int it = blockIdx.x * (NWAVES * 64) + F.tid; it < M * 24; it += F.G * NWAVES * 64) {
        const int tok = it / 24, s = it % 24; int col, gi; bool rope;
        if (s < 4) { col = C_NSAQ + 64 * s; gi = 0; rope = false; }
        else if (s == 4) { col = C_KC; gi = 1; rope = false; }
        else if (s == 5) { col = C_KSL; gi = 2; rope = true; }
        else if (s == 6) { col = C_KW; gi = 3; rope = true; }
        else if (s < 11) { col = C_BQ + 64 * (s - 7); gi = 4; rope = true; }
        else if (s < 15) { col = C_BK + 64 * (s - 11); gi = 5; rope = true; }
        else if (s < 19) { col = C_DQ + 64 * (s - 15); gi = 6; rope = false; }
        else if (s < 23) { col = C_DK + 64 * (s - 19); gi = 7; rope = false; }
        else continue;
        bf16* p = P + (size_t)tok * NP + col; float v[64]; load64(p, v);
        float ss = 0.f;
#pragma unroll
        for (int d = 0; d < 64; ++d) ss += v[d] * v[d];
        const float r = 1.0f / sqrtf(ss * (1.f / 64.f) + EPS); const float* g = qk_gain + gi * 64;
#pragma unroll
        for (int d = 0; d < 64; ++d) v[d] = v[d] * r * g[d];
        if (rope) {
#pragma unroll
            for (int i = 0; i < 8; ++i) { const float c = rc[(size_t)tok * 8 + i], sn = rs[(size_t)tok * 8 + i]; const float x1 = v[i], x2 = v[8 + i]; v[i] = x1 * c - x2 * sn; v[8 + i] = x2 * c + x1 * sn; }
        }
        store64(p, v);
    }
}

__device__ __forceinline__ void phase_compress(Frame& F, const float* pe_k, const float* pe_v, const float* k1, const float* k2, const float* v1, const float* v2) {
    const bf16* P = (const bf16*)(F.ws + WS_PROJ);
    LAS float* Ain = (LAS float*)(F.lds + F.wave * 9216);
    LAS float* hid = Ain + 2048;
    for (int it = F.gw; it < 2 * 2 * 511; it += F.NGW) {
        const int which = it / 1022, r = it % 1022, b = r / 511, c = r % 511;
        const float* pe = which ? pe_v : pe_k; const float* w1 = which ? v1 : k1; const float* w2 = which ? v2 : k2; const int col = which ? C_VC : C_KC;
        for (int i = F.lane; i < 2048; i += 64) { const int l = i >> 6, d = i & 63; Ain[i] = bf2f(P[(size_t)(b * SEQ + 16 * c + l) * NP + col + d]) + pe[i]; }
        LDS_WAIT(); asm volatile("" ::: "memory");
        float h0 = 0.f, h1 = 0.f;
#pragma unroll 8
        for (int i = 0; i < 2048; ++i) { const float av = Ain[i]; h0 += av * w1[(size_t)i * 128 + F.lane]; h1 += av * w1[(size_t)i * 128 + 64 + F.lane]; }
        hid[F.lane] = gelu_tanh(h0); hid[64 + F.lane] = gelu_tanh(h1);
        LDS_WAIT(); asm volatile("" ::: "memory");
        float o = 0.f;
#pragma unroll 8
        for (int j = 0; j < 128; ++j) o += hid[j] * w2[j * 64 + F.lane];
        bf16* dst = (bf16*)(F.ws + (which ? WS_VCMP : WS_KCMP)) + ((size_t)b * 512 + c) * 64;
        dst[F.lane] = (bf16)f2bf(o);
        LDS_WAIT(); asm volatile("" ::: "memory");
    }
}

__device__ __forceinline__ void attn_nsa_item(Frame& F, int item) {
    const bf16* P = (const bf16*)(F.ws + WS_PROJ); float* OACC = (float*)(F.ws + WS_GACC); bf16* O = (bf16*)(F.ws + WS_O);
    const bf16* KC = (const bf16*)(F.ws + WS_KCMP); const bf16* VC = (const bf16*)(F.ws + WS_VCMP);
    const float* rc = (const float*)(F.ws + WS_ROPE_C); const float* rs = (const float*)(F.ws + WS_ROPE_S);
    LAS float* imp = (LAS float*)(F.lds + F.wave * 9216);
    LAS int* sel = (LAS int*)(F.lds + F.wave * 9216 + 8192);
    const int tt = F.lane >> 2, h = F.lane & 3, tg = item * 16 + tt, b = tg >> 13, t = tg & (SEQ - 1);
    const bf16* prow = P + (size_t)tg * NP;
    float g3[3];
#pragma unroll
    for (int i = 0; i < 3; ++i) g3[i] = pg8::sigmoid_f(bf2f(prow[C_AG + 3 * h + i]));
    float q[64]; load64(prow + C_NSAQ + 64 * h, q);
    float o[64]; float m_run, l_run;
    for (int i = F.lane; i < 16 * 128; i += 64) imp[i] = 0.f;
    LDS_WAIT(); asm volatile("" ::: "memory");
    const int cmax = (t >= 31) ? ((t - 31) >> 4) : -1;
    m_run = -3.0e38f; l_run = 0.f;
#pragma unroll
    for (int d = 0; d < 64; ++d) o[d] = 0.f;
#pragma unroll 1
    for (int c = 0; c <= cmax; ++c) { const float s = dot64(KC + ((size_t)b * 512 + c) * 64, q) * 0.125f; SOFTMAX_STEP(s, VC + ((size_t)b * 512 + c) * 64); }
    const float inv_l = (cmax >= 0) ? 1.0f / l_run : 0.f;
    float* oacc = OACC + (size_t)tg * 256 + 64 * h;
#pragma unroll
    for (int d = 0; d < 64; ++d) oacc[d] = g3[0] * o[d] * inv_l;
    { float accj = 0.f, carry = 0.f;
#pragma unroll 1
      for (int c = 0; c <= cmax; ++c) {
          const float s = dot64(KC + ((size_t)b * 512 + c) * 64, q) * 0.125f; float p = __expf(s - m_run) * inv_l;
          p += swz_xor<1>(p); p += swz_xor<2>(p);
          accj += p;
          if ((c & 3) == 3) { if (h == 0) imp[tt * 128 + (c >> 2)] = carry + accj; carry = p; accj = 0.f; }
      }
      if (cmax >= 0 && h == 0) { if ((cmax & 3) != 3) imp[tt * 128 + (cmax >> 2)] = carry + accj; else if (((cmax + 1) >> 2) < 128) imp[tt * 128 + ((cmax + 1) >> 2)] = carry; }
    }
    LDS_WAIT(); asm volatile("" ::: "memory");
    const int cur = t >> 6; const int n_pick = (cur + 1 < 16) ? cur + 1 : 16;
    int nsel = 0;
    if (h == 0) { sel[tt * 16 + 0] = 0; }
    nsel = 1;
    if (cur >= 1) { if (h == 0) sel[tt * 16 + nsel] = cur; ++nsel; }
    if (cur >= 2) { if (h == 0) sel[tt * 16 + nsel] = cur - 1; ++nsel; }
    for (; nsel < n_pick; ++nsel) {
        float bv = -2.0f; int bi = 1 << 20;
        for (int j = 1 + h; j <= cur - 2; j += 4) { const float v = imp[tt * 128 + j]; if (v > bv) { bv = v; bi = j; } }
        { const float ov = swz_xor<1>(bv); const int oi = swz_xor_i<1>(bi); if (ov > bv || (ov == bv && oi < bi)) { bv = ov; bi = oi; } }
        { const float ov = swz_xor<2>(bv); const int oi = swz_xor_i<2>(bi); if (ov > bv || (ov == bv && oi < bi)) { bv = ov; bi = oi; } }
        if (h == 0) { sel[tt * 16 + nsel] = bi; imp[tt * 128 + bi] = -1.0f; }
        LDS_WAIT(); asm volatile("" ::: "memory");
    }
    LDS_WAIT(); asm volatile("" ::: "memory");
#pragma unroll
    for (int i = 0; i < 8; ++i) { const float c = rc[(size_t)tg * 8 + i], sn = rs[(size_t)tg * 8 + i]; const float x1 = q[i], x2 = q[8 + i]; q[i] = x1 * c - x2 * sn; q[8 + i] = x2 * c + x1 * sn; }
    m_run = -3.0e38f; l_run = 0.f;
#pragma unroll
    for (int d = 0; d < 64; ++d) o[d] = 0.f;
#pragma unroll 1
    for (int i = 0; i < n_pick; ++i) { const int jb = sel[tt * 16 + i];
#pragma unroll 1
        for (int l2 = 0; l2 < 64; ++l2) { const int kp = 64 * jb + l2; if (kp > t) break;
            const bf16* kr = P + (size_t)(b * SEQ + kp) * NP; const float s = dot64(kr + C_KSL, q) * 0.125f; SOFTMAX_STEP(s, kr + C_VSL); } }
    { const float il = 1.0f / l_run;
#pragma unroll
      for (int d = 0; d < 64; ++d) oacc[d] += g3[1] * o[d] * il; }
    m_run = -3.0e38f; l_run = 0.f;
#pragma unroll
    for (int d = 0; d < 64; ++d) o[d] = 0.f;
#pragma unroll 1
    for (int kp = (t >= 511 ? t - 511 : 0); kp <= t; ++kp) { const bf16* kr = P + (size_t)(b * SEQ + kp) * NP; const float s = dot64(kr + C_KW, q) * 0.125f; SOFTMAX_STEP(s, kr + C_VW); }
    { const float il = 1.0f / l_run;
#pragma unroll
      for (int d = 0; d < 64; ++d) o[d] = oacc[d] + g3[2] * o[d] * il; }
    store64(O + (size_t)tg * 1024 + 0 + 64 * h, o);
    LDS_WAIT(); asm volatile("" ::: "memory");
}
__device__ __forceinline__ void attn_dilated_item(Frame& F, int item) {
    const bf16* P = (const bf16*)(F.ws + WS_PROJ); bf16* O = (bf16*)(F.ws + WS_O);
    const int h = item & 3, tg = (item >> 2) * 64 + F.lane, b = tg >> 13, t = tg & (SEQ - 1);
    float q[64]; load64(P + (size_t)tg * NP + C_BQ + 64 * h, q);
    float o[64]; float m_run = -3.0e38f, l_run = 0.f;
#pragma unroll
    for (int d = 0; d < 64; ++d) o[d] = 0.f;
#pragma unroll 1
    for (int gi = 0; gi < 3; ++gi) { const int dl = (gi == 0) ? 1 : (gi == 1 ? 4 : 16);
#pragma unroll 1
        for (int mm = 0; mm <= 128; ++mm) { const int kp = t - mm * dl; if (kp < 0) break;
            const bf16* kr = P + (size_t)(b * SEQ + kp) * NP; const float s = dot64(kr + C_BK + 64 * h, q) * 0.125f; SOFTMAX_STEP(s, kr + C_BV + 64 * h); } }
    const float il = 1.0f / l_run;
#pragma unroll
    for (int d = 0; d < 64; ++d) o[d] *= il;
    store64(O + (size_t)tg * 1024 + 256 + 64 * h, o);
}
__device__ __forceinline__ void attn_stickbreak_item(Frame& F, int item) {
    const bf16* P = (const bf16*)(F.ws + WS_PROJ); bf16* O = (bf16*)(F.ws + WS_O);
    const int h = item & 3, tg = (item >> 2) * 64 + F.lane, b = tg >> 13, t = tg & (SEQ - 1);
    float q[64]; load64(P + (size_t)tg * NP + C_CQ + 64 * h, q);
    float o[64]; float R = 0.f;
#pragma unroll
    for (int d = 0; d < 64; ++d) o[d] = 0.f;
#pragma unroll 1
    for (int kp = t - 1; kp >= 0; --kp) {
        const bf16* kr = P + (size_t)(b * SEQ + kp) * NP; const float z = dot64(kr + C_CK + 64 * h, q) * 0.125f;
        const float w = __expf(log_sigmoid(z) + R); axpy64(kr + C_CV + 64 * h, w, o);
        R += log_sigmoid(-z);
        if (R < -SKIP_THR) break;
    }
    store64(O + (size_t)tg * 1024 + 512 + 64 * h, o);
}
__device__ __forceinline__ void attn_fox_item(Frame& F, int item, const float* fox_b, const float* gk  ) {
    const bf16* P = (const bf16*)(F.ws + WS_PROJ); bf16* O = (bf16*)(F.ws + WS_O);
    const int h = item & 3, tg = (item >> 2) * 64 + F.lane, b = tg >> 13, t = tg & (SEQ - 1);
    float q[64]; load64(P + (size_t)tg * NP + C_DQ + 64 * h, q);
    float qn = 0.f, gmax = 0.f;
#pragma unroll
    for (int d = 0; d < 64; ++d) { qn += q[d] * q[d]; gmax = fmaxf(gmax, fabsf(gk[d])); }
    const float qkmax = sqrtf(qn) * (8.0f * gmax) * 0.125f * 1.02f;
    const float fb = fox_b[h];
    float o[64]; float m_run = -3.0e38f, l_run = 0.f, bias = 0.f;
#pragma unroll
    for (int d = 0; d < 64; ++d) o[d] = 0.f;
#pragma unroll 1
    for (int kp = t; kp >= 0; --kp) {
        const bf16* kr = P + (size_t)(b * SEQ + kp) * NP; const float s = dot64(kr + C_DK + 64 * h, q) * 0.125f + bias; SOFTMAX_STEP(s, kr + C_DV + 64 * h);
        bias += log_sigmoid(bf2f(kr[C_DF + h]) + fb);
        if (qkmax + bias - m_run < -SKIP_THR) break;
    }
    const float il = 1.0f / l_run;
#pragma unroll
    for (int d = 0; d < 64; ++d) o[d] *= il;
    store64(O + (size_t)tg * 1024 + 768 + 64 * h, o);
}
__device__ __forceinline__ void phase_attention(Frame& F, const float* fox_b, const float* qk_gain) {
    for (int it = F.gw; it < 4096; it += F.NGW) {
        const int ty = it >> 10, sub = it & 1023;
        if (ty == 0) attn_nsa_item(F, sub);
        else if (ty == 1) attn_fox_item(F, sub, fox_b, qk_gain + 7 * 64);
        else if (ty == 2) attn_dilated_item(F, sub);
        else attn_stickbreak_item(F, sub);
    }
}

__device__ __forceinline__ void phase_combine(Frame& F, float* out, const float* gate) {
    const bf16* Y = (const bf16*)(F.ws + WS_Y); const int* info = (const int*)(F.ws + WS_TOKINFO);
    int pre[8]; { int p = 0;
#pragma unroll
        for (int e = 0; e < 8; ++e) { int n = (int)__hip_atomic_load(F.ctl + CW_MOECNT + 64 * e, RLX_AGENT); if (n > 16384) n = 16384; pre[e] = p; p += (n + 255) >> 8; } }
    for (int m = F.gw; m < M; m += F.NGW) {
        const int b = m >> 13; const int* ip = info + (size_t)m * 8;
        const int e0 = ip[0], r0 = ip[1], e1 = ip[4], r1 = ip[5]; const float g0 = __int_as_float(ip[2]), g1 = __int_as_float(ip[6]);
        int p0 = 0, p1 = 0;
#pragma unroll
        for (int e = 0; e < 8; ++e) { if (e == e0) p0 = pre[e]; if (e == e1) p1 = pre[e]; }
        const bf16* y0 = Y + ((size_t)p0 * 256 + r0) * 1024; const bf16* y1 = Y + ((size_t)p1 * 256 + r1) * 1024;
#pragma unroll
        for (int j = 0; j < 4; ++j) { const int c = 4 * F.lane + 256 * j;
            const uint2 a0 = *(const uint2*)(y0 + c), a1 = *(const uint2*)(y1 + c); const f32x4 gv = *(const f32x4*)(gate + (size_t)b * 6144 + c); f32x4 xv = *(const f32x4*)(out + (size_t)m * D + c);
            xv.x += gv.x * (g0 * __uint_as_float(a0.x << 16) + g1 * __uint_as_float(a1.x << 16));
            xv.y += gv.y * (g0 * __uint_as_float(a0.x & 0xffff0000u) + g1 * __uint_as_float(a1.x & 0xffff0000u));
            xv.z += gv.z * (g0 * __uint_as_float(a0.y << 16) + g1 * __uint_as_float(a1.y << 16));
            xv.w += gv.w * (g0 * __uint_as_float(a0.y & 0xffff0000u) + g1 * __uint_as_float(a1.y & 0xffff0000u));
            *(f32x4*)(out + (size_t)m * D + c) = xv; }
    }
}

constexpr int PH_PER_LAYER = 11, N_PHASES = 1 + 2 * PH_PER_LAYER;
extern __shared__ __attribute__((aligned(16))) unsigned char lds_dyn[];
#define SITE_PROLOGUE() Frame F; ArgsP ap = (ArgsP)__builtin_amdgcn_kernarg_segment_ptr(); asm volatile("" : "+s"(ap)); l = __builtin_amdgcn_readfirstlane(l); \
    F.lds = (LAS unsigned char*)lds_dyn; F.lane = lane_id_fresh(); F.wave = wave0; F.tid = F.wave * 64 + F.lane; \
    F.G = gridDim.x; F.gw = blockIdx.x * NWAVES + F.wave; F.NGW = F.G * NWAVES; F.ws = ap->ws; F.ctl = (gu32*)(F.ws + WS_CTL); \
    float* const out = ap->out; const float* const modl = (const float*)(F.ws + WS_MOD) + (size_t)l * 2 * 6144; (void)out; (void)modl
static __device__ __forceinline__ void site_prologue(int l, int wave0) { SITE_PROLOGUE(); phase_prologue(F, ap); }
static __device__ __forceinline__ void site_norm_mix(int l, int wave0) { SITE_PROLOGUE(); const float* xin = (l == 0) ? (const float*)ap->in[0] : (const float*)out;
    phase_norm<false>(F, xin, (const float*)ap->in[5] + l * 1024, modl + 0, modl + 1024, nullptr); }
static __device__ __forceinline__ void site_gemm_in(int l, int wave0) { SITE_PROLOGUE();
    pg8::Gemm g{(const bf16*)(F.ws + WS_H), (const bf16*)(F.ws + WS_WIN) + (size_t)l * NP * 1024, 1024, 1024}; pg8::StaticOrder S; S.init(M, NP, F.G, (int)blockIdx.x);
    pg8::EpiStore E{(bf16*)(F.ws + WS_PROJ), NP};
    pg8::gemm_phase<pg8::EpiStore, pg8::StaticOrder, true, false>(F.lds, g, S, E, F.tid); }
static __device__ __forceinline__ void site_qknorm(int l, int wave0) { SITE_PROLOGUE(); phase_qknorm(F, (const float*)ap->in[8] + l * 512); }
static __device__ __forceinline__ void site_compress(int l, int wave0) { SITE_PROLOGUE(); phase_compress(F, (const float*)ap->in[9] + l * 2048, (const float*)ap->in[10] + l * 2048, (const float*)ap->in[11] + (size_t)l * 2048 * 128, (const float*)ap->in[12] + l * 128 * 64,
                                       (const float*)ap->in[13] + (size_t)l * 2048 * 128, (const float*)ap->in[14] + l * 128 * 64); }
static __device__ __forceinline__ void site_attention(int l, int wave0) { SITE_PROLOGUE(); phase_attention(F, (const float*)ap->in[15] + l * 4, (const float*)ap->in[8] + l * 512); }
static __device__ __forceinline__ void site_gemm_branch(int l, int wave0) { SITE_PROLOGUE();
    pg8::Gemm g{(const bf16*)(F.ws + WS_O), (const bf16*)(F.ws + WS_WBR) + (size_t)l * 4 * 1024 * 256, 1024, 256}; pg8::BranchOrder S; S.init(M, 1024, F.G, (int)blockIdx.x);
    pg8::EpiGate E{(const bf16*)(F.ws + WS_PROJ), NP, C_MG, (float*)(F.ws + WS_GACC), (bf16*)(F.ws + WS_H)};
    pg8::gemm_phase<pg8::EpiGate, pg8::BranchOrder, false, false>(F.lds, g, S, E, F.tid); }
static __device__ __forceinline__ void site_gemm_out(int l, int wave0) { SITE_PROLOGUE(); const float* xin = (l == 0) ? (const float*)ap->in[0] : (const float*)out;
    pg8::Gemm g{(const bf16*)(F.ws + WS_H), (const bf16*)(F.ws + WS_WOUT) + (size_t)l * 1024 * 1024, 1024, 1024}; pg8::StaticOrder S; S.init(M, 1024, F.G, (int)blockIdx.x);
    pg8::EpiResid E{xin, out, modl + 2048, 6144};
    pg8::gemm_phase<pg8::EpiResid, pg8::StaticOrder, false, false>(F.lds, g, S, E, F.tid); }
static __device__ __forceinline__ void site_norm_ffn(int l, int wave0) { SITE_PROLOGUE();
    if (l == 0) phase_norm<false>(F, out, (const float*)ap->in[6] + l * 1024, modl + 3 * 1024, modl + 4 * 1024, nullptr);
    else { phase_norm<true>(F, out, (const float*)ap->in[6] + l * 1024, modl + 3 * 1024, modl + 4 * 1024, (const float*)ap->in[21]); phase_moe_weights(F, ap); } }
static __device__ __forceinline__ void site_gemm_up_dense(int l, int wave0) { SITE_PROLOGUE();
    pg8::Gemm g{(const bf16*)(F.ws + WS_H), (const bf16*)(F.ws + WS_W13), 1024, 1024}; pg8::StaticOrder S; S.init(M, 2 * DFF, F.G, (int)blockIdx.x);
    pg8::EpiSwiglu E{(bf16*)(F.ws + WS_HMID), DFF};
    pg8::gemm_phase<pg8::EpiSwiglu, pg8::StaticOrder, true, false>(F.lds, g, S, E, F.tid); }
static __device__ __forceinline__ void site_gemm_up_moe(int l, int wave0) { SITE_PROLOGUE();
    pg8::Gemm g{(const bf16*)(F.ws + WS_H), (const bf16*)(F.ws + WS_MOEW13), 1024, 1024}; pg8::MoeOrder S; S.init((unsigned*)(F.ctl + CW_MOECNT), (const int*)(F.ws + WS_LIST), 2 * DFF / 256, (size_t)2 * DFF * 1024, F.G, (int)blockIdx.x);
    pg8::EpiSwiglu E{(bf16*)(F.ws + WS_HMID_MOE), DFF};
    pg8::gemm_phase<pg8::EpiSwiglu, pg8::MoeOrder, true, true>(F.lds, g, S, E, F.tid); }
static __device__ __forceinline__ void site_gemm_down_dense(int l, int wave0) { SITE_PROLOGUE();
    pg8::Gemm g{(const bf16*)(F.ws + WS_HMID), (const bf16*)(F.ws + WS_W2), DFF, DFF}; pg8::StaticOrder S; S.init(M, 1024, F.G, (int)blockIdx.x);
    pg8::EpiResid E{out, out, modl + 5 * 1024, 6144};
    pg8::gemm_phase<pg8::EpiResid, pg8::StaticOrder, false, false>(F.lds, g, S, E, F.tid); }
static __device__ __forceinline__ void site_gemm_down_moe(int l, int wave0) { SITE_PROLOGUE();
    pg8::Gemm g{(const bf16*)(F.ws + WS_HMID_MOE), (const bf16*)(F.ws + WS_MOEW2), DFF, DFF}; pg8::MoeOrder S; S.init((unsigned*)(F.ctl + CW_MOECNT), (const int*)(F.ws + WS_LIST), 4, (size_t)1024 * DFF, F.G, (int)blockIdx.x);
    pg8::EpiStore E{(bf16*)(F.ws + WS_Y), 1024};
    pg8::gemm_phase<pg8::EpiStore, pg8::MoeOrder, true, false>(F.lds, g, S, E, F.tid); }
static __device__ __forceinline__ void site_combine(int l, int wave0) { SITE_PROLOGUE(); phase_combine(F, out, modl + 5 * 1024); }

__global__ void __launch_bounds__(NWAVES * 64, 2) fwd_kernel(Args args_unused) {
    (void)args_unused;
    const ArgsP ap0 = (ArgsP)__builtin_amdgcn_kernarg_segment_ptr();
    const int wave0 = __builtin_amdgcn_readfirstlane((int)threadIdx.x >> 6);
    LAS unsigned char* lds = (LAS unsigned char*)lds_dyn;
    volatile LAS unsigned* MISC = (volatile LAS unsigned*)(lds + MISC_OFF);
    for (int u = wave0 * 64 + lane_id_fresh(); u < (LDS_BYTES - RING_BYTES) / 4; u += NWAVES * 64) ((LAS unsigned*)(lds + RING_BYTES))[u] = 0u;
    __syncthreads();
    const int lo = ap0->ph_lo, hi = ap0->ph_hi;
    unsigned* barw = (unsigned*)(ap0->ws + WS_CTL) + CW_BAR;
    XcdBarrier bar; bar.bar = barw; bar.x = 0; bar.st = nullptr;
#define LEADER() (wave0 == 0 && lane_id_fresh() == 0)
    if (hi - lo > 1) bar = xcd_barrier_post(barw, MISC + 8, LEADER());
#define IN(k) (lo <= (k) && (k) < hi)
#define SEAM(k) do { if (IN(k) && IN((k) + 1)) xcd_barrier(bar, LEADER()); } while (0)
    if (PHON(0) && IN(0)) site_prologue(0, wave0);
    SEAM(0);
    for (int l = 0; l < 2; ++l) {
        const int pb = 1 + l * PH_PER_LAYER;
        if (PHON(1) && IN(pb + 0)) site_norm_mix(l, wave0);
        SEAM(pb + 0);
        if (PHON(2) && IN(pb + 1)) site_gemm_in(l, wave0);
        SEAM(pb + 1);
        if (PHON(3) && IN(pb + 2)) site_qknorm(l, wave0);
        SEAM(pb + 2);
        if (PHON(4) && IN(pb + 3)) site_compress(l, wave0);
        SEAM(pb + 3);
        if (PHON(5) && IN(pb + 4)) site_attention(l, wave0);
        SEAM(pb + 4);
        if (PHON(6) && IN(pb + 5)) site_gemm_branch(l, wave0);
        SEAM(pb + 5);
        if (PHON(7) && IN(pb + 6)) site_gemm_out(l, wave0);
        SEAM(pb + 6);
        if (PHON(8) && IN(pb + 7)) site_norm_ffn(l, wave0);
        SEAM(pb + 7);
        if (PHON(9) && IN(pb + 8)) { if (l == 0) site_gemm_up_dense(l, wave0); else site_gemm_up_moe(l, wave0); }
        SEAM(pb + 8);
        if (PHON(10) && IN(pb + 9)) { if (l == 0) site_gemm_down_dense(l, wave0); else site_gemm_down_moe(l, wave0); }
        SEAM(pb + 9);
        if (PHON(11) && IN(pb + 10)) { if (l == 1) site_combine(l, wave0); }
    }
#undef IN
#undef SEAM
}

extern "C" void kernel_launch(void* const* d_in, const int* in_sizes, int n_in, void* d_out, int out_size, void* d_ws, size_t ws_size, hipStream_t stream) {
    static int grid = 0;
    if (grid == 0) {
        if (n_in != 25 || out_size != M * D || ws_size < WS_END) { fprintf(stderr, "kernel_launch: unexpected problem (n_in %d, out %d, ws %zu < %zu)\n", n_in, out_size, ws_size, (size_t)WS_END); grid = -1; return; }
        int dev = 0, cus = 0, per_cu = 0;
        if (hipGetDevice(&dev) != hipSuccess || hipDeviceGetAttribute(&cus, hipDeviceAttributeMultiprocessorCount, dev) != hipSuccess) { grid = -1; return; }
        if (hipFuncSetAttribute((const void*)fwd_kernel, hipFuncAttributeMaxDynamicSharedMemorySize, LDS_BYTES) != hipSuccess) { fprintf(stderr, "kernel_launch: hipFuncSetAttribute failed\n"); grid = -1; return; }
        if (hipOccupancyMaxActiveBlocksPerMultiprocessor(&per_cu, (const void*)fwd_kernel, NWAVES * 64, LDS_BYTES) != hipSuccess || per_cu < 1) fprintf(stderr, "kernel_launch: occupancy query reports %d\n", per_cu);
        (void)hipGetLastError();
        grid = cus;
    }
    if (grid < 0) return;
    if (hipMemsetAsync((char*)d_ws + WS_CTL, 0, CTL_ZERO_BYTES, stream) != hipSuccess) return;
    Args a{};
    for (int i = 0; i < 25; ++i) a.in[i] = d_in[i];
    a.out = (float*)d_out; a.ws = (unsigned char*)d_ws;
#if MK_ONE_LAUNCH
    a.ph_lo = 0; a.ph_hi = N_PHASES;
    hipLaunchKernelGGL(fwd_kernel, dim3(grid), dim3(NWAVES * 64), LDS_BYTES, stream, a);
#else
    for (int p = 0; p < N_PHASES; ++p) {
        if (p == 1 + 10) continue;
        a.ph_lo = p; a.ph_hi = p + 1;
        hipLaunchKernelGGL(fwd_kernel, dim3(grid), dim3(NWAVES * 64), LDS_BYTES, stream, a);
    }
#endif
}
```

```cpp
#include <hip/hip_runtime.h>
#include <cstdio>
#include <cstdint>

#ifndef MK_ONE_LAUNCH
#define MK_ONE_LAUNCH 1
#endif
#ifndef PHMASK
#define PHMASK 0xFFFFu
#endif
#define PHON(k) (((PHMASK) >> (k)) & 1u)

namespace pg8 {
#define PG8_LAS __attribute__((address_space(3)))
typedef unsigned short bf16_t;
typedef short bf16x8 __attribute__((ext_vector_type(8)));
typedef float f32x4 __attribute__((ext_vector_type(4)));
typedef unsigned u32x4 __attribute__((ext_vector_type(4)));
constexpr int BM = 256, BK = 64, HALF = 128, HTB = HALF * BK * 2, STAGE_BYTES = 8 * HTB, NXCD = 8, WGM = 8;

__host__ __device__ __forceinline__ int lds_byte(int r, int c) { const int st = (r >> 4) * 2 + (c >> 5), rr = r & 15, cc = c & 31, ob = rr * 64 + cc * 2; return st * 1024 + (ob ^ (((ob >> 9) & 1) << 5)); }
__host__ __device__ __forceinline__ void stage_rc(int b, int& R, int& C) { const int st = b / 1024, sb = b % 1024, swz = sb ^ (((sb >> 9) & 1) << 5); R = (st >> 1) * 16 + swz / 64; C = (st & 1) * 32 + (swz % 64) / 2; }
__host__ __device__ __forceinline__ int perm32(int rho) { const int n = rho >> 4, i = rho & 15; return 8 * (i >> 2) + 4 * n + (i & 3); }

struct Unit { int pm, pn, z; };
struct Gemm { const bf16_t* A; const bf16_t* Bt; int lda; int K; };

__host__ __device__ __forceinline__ void tile_pmpn(int wgid, int nM, int nN, int& pm, int& pn) {
    const int nwg = nM * nN;
    { const int q = nwg / NXCD, r = nwg % NXCD, xcd = wgid % NXCD, off = wgid / NXCD; wgid = (xcd < r ? xcd * (q + 1) : r * (q + 1) + (xcd - r) * q) + off; }
    const int nig = WGM * nN, gid = wgid / nig, fm = gid * WGM, gsz = (nM - fm) < WGM ? (nM - fm) : WGM;
    pm = fm + ((wgid % nig) % gsz); pn = (wgid % nig) / gsz;
}
struct StaticOrder {
    int nM, nN, nwg, G, c;
    __device__ void init(int M, int N, int G_, int c_) { nM = M / BM; nN = N / BM; nwg = nM * nN; G = G_; c = c_; }
    __device__ bool next(int i, Unit& u) const { const long L = (long)i * G + c; if (L >= nwg) return false; tile_pmpn((int)L, nM, nN, u.pm, u.pn); u.z = 0; return true; }
    __device__ const char* a_base(const Gemm& g, const Unit& u) const { return (const char*)g.A + (size_t)u.pm * BM * g.lda * 2; }
    __device__ const char* b_base(const Gemm& g, const Unit& u) const { return (const char*)g.Bt + (size_t)u.pn * BM * g.K * 2; }
    __device__ int row_tok(const Unit&, int) const { return 0; }
};
struct BranchOrder {
    int nM, nN, nwg, G, c;
    __device__ void init(int M, int N, int G_, int c_) { nM = M / BM; nN = N / BM; nwg = nM * nN; G = G_; c = c_; }
    __device__ bool next(int i, Unit& u) const { const long L = (long)(i >> 2) * G + c; if (L >= nwg) return false; tile_pmpn((int)L, nM, nN, u.pm, u.pn); u.z = i & 3; return true; }
    __device__ const char* a_base(const Gemm& g, const Unit& u) const { return (const char*)g.A + ((size_t)u.pm * BM * g.lda + (size_t)u.z * 256) * 2; }
    __device__ const char* b_base(const Gemm& g, const Unit& u) const { return (const char*)g.Bt + ((size_t)u.z * 1024 * 256 + (size_t)u.pn * BM * g.K) * 2; }
    __device__ int row_tok(const Unit&, int) const { return 0; }
};
struct MoeOrder {
    int G, c, nN; int pre[9]; const int* list; int cnt[8]; size_t zstrideB;
    __device__ void init(unsigned* counts, const int* list_, int nN_, size_t zstrideB_, int G_, int c_) {
        G = G_; c = c_; nN = nN_; list = list_; zstrideB = zstrideB_; int p = 0;
#pragma unroll
        for (int e = 0; e < 8; ++e) { int n = __builtin_amdgcn_readfirstlane((int)__hip_atomic_load(counts + 64 * e, __ATOMIC_RELAXED, __HIP_MEMORY_SCOPE_AGENT)); if (n > 16384) n = 16384; cnt[e] = n; pre[e] = p; p += (n + 255) >> 8; }
        pre[8] = p;
    }
    __device__ bool next(int i, Unit& u) const {
        const long L = (long)i * G + c; if (L >= (long)pre[8] * nN) return false;
        const int rt = (int)(L / nN); u.pn = (int)(L % nN); u.pm = rt; int e = 0;
#pragma unroll
        for (int k = 1; k < 8; ++k) e += (rt >= pre[k]) ? 1 : 0;
        u.z = e; return true;
    }
    __device__ const char* a_base(const Gemm& g, const Unit& u) const { return (const char*)g.A + (size_t)u.pm * BM * g.lda * 2; }
    __device__ const char* b_base(const Gemm& g, const Unit& u) const { return (const char*)g.Bt + ((size_t)u.z * zstrideB + (size_t)u.pn * BM * g.K) * 2; }
    __device__ int row_tok(const Unit& u, int r) const {
        int e = 0, c0 = 0, p0 = 0;
#pragma unroll
        for (int k = 0; k < 8; ++k) if (k == u.z) { c0 = cnt[k]; p0 = pre[k]; }
        const int idx = (u.pm - p0) * 256 + r; (void)e;
        return idx < c0 ? list[u.z * 16384 + idx] : 0;
    }
};

__device__ __forceinline__ int lane_id_fresh_pg8() { int l; asm volatile("v_mbcnt_lo_u32_b32 %0, -1, 0\n\tv_mbcnt_hi_u32_b32 %0, -1, %0" : "=v"(l)); return l; }
__device__ __forceinline__ unsigned cvt_pk_bf16(float lo, float hi) { unsigned r; asm volatile("v_cvt_pk_bf16_f32 %0, %1, %2" : "=v"(r) : "v"(lo), "v"(hi)); return r; }

struct EpiStore {
    static constexpr bool PERM = true;
    bf16_t* O; int ldc;
    __device__ __forceinline__ void operator()(const f32x4 (&acc)[2][2][4][2], const Unit& u, int wr, int wc, int fr, int fq) const {
        const unsigned base = ((unsigned)(u.pm * BM + wr * 64 + fr) * (unsigned)ldc + (unsigned)(u.pn * BM + wc * 32 + 8 * fq)) * 2u;
        char* Ob = (char*)O;
#pragma unroll
        for (int ai = 0; ai < 2; ++ai)
#pragma unroll
            for (int m = 0; m < 4; ++m) { const unsigned off = base + (unsigned)((ai * HALF + m * 16) * 2) * (unsigned)ldc;
#pragma unroll
                for (int bj = 0; bj < 2; ++bj) { const f32x4 v0 = acc[ai][bj][m][0], v1 = acc[ai][bj][m][1];
                    u32x4 w; w.x = cvt_pk_bf16(v0[0], v0[1]); w.y = cvt_pk_bf16(v0[2], v0[3]); w.z = cvt_pk_bf16(v1[0], v1[1]); w.w = cvt_pk_bf16(v1[2], v1[3]);
                    *(u32x4*)(Ob + (off + (unsigned)(bj * HALF * 2))) = w; } }
    }
};
__device__ __forceinline__ float silu_f(float a) { return a * __builtin_amdgcn_rcpf(1.0f + __expf(-a)); }
struct EpiSwiglu {
    static constexpr bool PERM = true;
    bf16_t* O; int ldc;
    __device__ __forceinline__ void operator()(const f32x4 (&acc)[2][2][4][2], const Unit& u, int wr, int wc, int fr, int fq) const {
        const unsigned base = ((unsigned)(u.pm * BM + wr * 64 + fr) * (unsigned)ldc + (unsigned)(u.pn * HALF + wc * 32 + 8 * fq)) * 2u;
        char* Ob = (char*)O;
#pragma unroll
        for (int ai = 0; ai < 2; ++ai)
#pragma unroll
            for (int m = 0; m < 4; ++m) { const unsigned off = base + (unsigned)((ai * HALF + m * 16) * 2) * (unsigned)ldc;
                float h[8];
#pragma unroll
                for (int n = 0; n < 2; ++n)
#pragma unroll
                    for (int j = 0; j < 4; ++j) h[n * 4 + j] = silu_f(acc[ai][0][m][n][j]) * acc[ai][1][m][n][j];
                u32x4 w; w.x = cvt_pk_bf16(h[0], h[1]); w.y = cvt_pk_bf16(h[2], h[3]); w.z = cvt_pk_bf16(h[4], h[5]); w.w = cvt_pk_bf16(h[6], h[7]);
                *(u32x4*)(Ob + off) = w; }
    }
};
struct EpiResid {
    static constexpr bool PERM = false;
    const float* xin; float* out; const float* gate; int gate_bstride;
    __device__ __forceinline__ void operator()(const f32x4 (&acc)[2][2][4][2], const Unit& u, int wr, int wc, int fr, int fq) const {
        const int b = (u.pm * BM) >> 13; const int col0 = u.pn * BM + wc * 32 + 4 * fq;
        f32x4 gv[2][2];
#pragma unroll
        for (int bj = 0; bj < 2; ++bj)
#pragma unroll
            for (int n = 0; n < 2; ++n) gv[bj][n] = *(const f32x4*)(gate + (size_t)b * gate_bstride + col0 + bj * HALF + n * 16);
        const unsigned base = ((unsigned)(u.pm * BM + wr * 64 + fr) * 1024u + (unsigned)col0) * 4u;
        const char* xb = (const char*)xin; char* ob = (char*)out;
#pragma unroll
        for (int ai = 0; ai < 2; ++ai)
#pragma unroll
            for (int m = 0; m < 4; ++m) { const unsigned off = base + (unsigned)((ai * HALF + m * 16) * 4096);
#pragma unroll
                for (int bj = 0; bj < 2; ++bj)
#pragma unroll
                    for (int n = 0; n < 2; ++n) { const unsigned o2 = off + (unsigned)((bj * HALF + n * 16) * 4); const f32x4 xi = *(const f32x4*)(xb + o2); *(f32x4*)(ob + o2) = xi + gv[bj][n] * acc[ai][bj][m][n]; }
                if (m & 1) asm volatile("" ::: "memory"); }
    }
};
__device__ __forceinline__ float sigmoid_f(float a) { return __builtin_amdgcn_rcpf(1.0f + __expf(-a)); }
struct EpiGate {
    static constexpr bool PERM = true;
    const bf16_t* proj; int ldp; int cmg; float* G; bf16_t* gated;
    __device__ __forceinline__ void operator()(const f32x4 (&acc)[2][2][4][2], const Unit& u, int wr, int wc, int fr, int fq) const {
        const unsigned row0 = (unsigned)(u.pm * BM + wr * 64 + fr), col0 = (unsigned)(u.pn * BM + wc * 32 + 8 * fq);
        const unsigned pbase = (row0 * (unsigned)ldp + (unsigned)(cmg + u.z * 1024) + col0) * 2u, gbase = (row0 * 1024u + col0) * 4u;
        const char* pb = (const char*)proj; char* gb = (char*)G; char* ob = (char*)gated;
#pragma unroll
        for (int ai = 0; ai < 2; ++ai)
#pragma unroll
            for (int m = 0; m < 4; ++m) { const unsigned rr = (unsigned)(ai * HALF + m * 16);
#pragma unroll
                for (int bj = 0; bj < 2; ++bj) {
                    const u32x4 mg = *(const u32x4*)(pb + (pbase + rr * (unsigned)(ldp * 2) + (unsigned)(bj * HALF * 2)));
                    const unsigned go = gbase + rr * 4096u + (unsigned)(bj * HALF * 4);
                    float v[8];
#pragma unroll
                    for (int k = 0; k < 4; ++k) { const unsigned w = mg[k]; const float l0 = __uint_as_float(w << 16), l1 = __uint_as_float(w & 0xffff0000u);
                        v[2 * k] = sigmoid_f(l0) * acc[ai][bj][m][k >> 1][(2 * k) & 3]; v[2 * k + 1] = sigmoid_f(l1) * acc[ai][bj][m][k >> 1][(2 * k + 1) & 3]; }
                    if (u.z != 0) { const f32x4 g0 = *(const f32x4*)(gb + go), g1 = *(const f32x4*)(gb + go + 16);
#pragma unroll
                        for (int k = 0; k < 4; ++k) { v[k] += g0[k]; v[4 + k] += g1[k]; } }
                    if (u.z != 3) { *(f32x4*)(gb + go) = (f32x4){v[0], v[1], v[2], v[3]}; *(f32x4*)(gb + go + 16) = (f32x4){v[4], v[5], v[6], v[7]}; }
                    else { u32x4 w; w.x = cvt_pk_bf16(v[0], v[1]); w.y = cvt_pk_bf16(v[2], v[3]); w.z = cvt_pk_bf16(v[4], v[5]); w.w = cvt_pk_bf16(v[6], v[7]); *(u32x4*)(ob + (go >> 1)) = w; } }
                asm volatile("" ::: "memory"); }
    }
};

template <class Epi, class Sched, bool ALIGN_EPI, bool GATHER>
__device__ __forceinline__ void gemm_phase(PG8_LAS unsigned char* lds, const Gemm g, const Sched& S, const Epi& E, int tid) {
    asm volatile("" : "+v"(tid));
    const int wid = __builtin_amdgcn_readfirstlane(tid >> 6), lane = tid & 63, wr = wid >> 2, wc = wid & 3, fr = lane & 15, fq = lane >> 4;
    int K = g.K; asm volatile("" : "+s"(K));
    const int nt = K / BK;
    unsigned voffA[2], voffB[2]; int RA[2], CA[2];
#pragma unroll
    for (int i = 0; i < 2; ++i) { int R, C; stage_rc(tid * 16 + i * 8192, R, C); const int Rb = Epi::PERM ? ((R & ~31) + perm32(R & 31)) : R;
        RA[i] = R; CA[i] = C; voffA[i] = (unsigned)(R * g.lda + C) * 2u; voffB[i] = (unsigned)(Rb * K + C) * 2u; }
    const size_t kstep = (size_t)(BK * 2);
    const size_t hstepA = (size_t)HALF * g.lda * 2, hstepB = (size_t)HALF * K * 2;
    const unsigned ldsw = (unsigned)wid * 1024u;
    const int aoff = lds_byte(wr * 64 + fr, fq * 8), boff = lds_byte(wc * 32 + fr, fq * 8);
#define PG8_SA(b, h) (((b) * 2 + (h)) * HTB)
#define PG8_SB(b, h) ((4 + (b) * 2 + (h)) * HTB)
#define PG8_STAGE(bufoff, gbase, voff) do { _Pragma("unroll") for (int _i = 0; _i < 2; ++_i) \
        __builtin_amdgcn_global_load_lds((const unsigned*)((const char*)(gbase) + (voff)[_i]), (PG8_LAS unsigned*)(lds + (bufoff) + ldsw + _i * 8192), 16, 0, 0); } while (0)
#define PG8_STAGE_A(bufoff, kbase, h, GV) do { if constexpr (GATHER) { PG8_STAGE(bufoff, kbase, (GV)[h]); } else { PG8_STAGE(bufoff, (kbase) + (h) * hstepA, voffA); } } while (0)
#define PG8_LDA(dst, b, h) do { _Pragma("unroll") for (int m = 0; m < 4; ++m) _Pragma("unroll") for (int k = 0; k < 2; ++k) dst[m][k] = *(const PG8_LAS bf16x8*)(lds + PG8_SA(b, h) + aoff + m * 2048 + k * 1024); } while (0)
#define PG8_LDB(dst, b, h) do { _Pragma("unroll") for (int n = 0; n < 2; ++n) _Pragma("unroll") for (int k = 0; k < 2; ++k) dst[n][k] = *(const PG8_LAS bf16x8*)(lds + PG8_SB(b, h) + boff + n * 2048 + k * 1024); } while (0)
#define PG8_MMA(ai, bj, At, Bt) do { __builtin_amdgcn_s_setprio(1); _Pragma("unroll") for (int m = 0; m < 4; ++m) _Pragma("unroll") for (int n = 0; n < 2; ++n) _Pragma("unroll") for (int k = 0; k < 2; ++k) \
        acc[ai][bj][m][n] = __builtin_amdgcn_mfma_f32_16x16x32_bf16(Bt[n][k], At[m][k], acc[ai][bj][m][n], 0, 0, 0); __builtin_amdgcn_s_setprio(0); } while (0)
#define PG8_WAIT_V(n) asm volatile("s_waitcnt vmcnt(" #n ")" ::: "memory")
#define PG8_WAIT_L(n) asm volatile("s_waitcnt lgkmcnt(" #n ")" ::: "memory")
#define PG8_BAR __builtin_amdgcn_s_barrier()
#define PG8_SCHED __builtin_amdgcn_sched_barrier(0)
#define PG8_GOFFS(dst, un) do { _Pragma("unroll") for (int _h = 0; _h < 2; ++_h) _Pragma("unroll") for (int _i = 0; _i < 2; ++_i) \
        dst[_h][_i] = (unsigned)S.row_tok(un, _h * HALF + RA[_i]) * (unsigned)(g.lda * 2) + (unsigned)(CA[_i] * 2); } while (0)
    Unit cur, nxt; int ui = 0;
    if (!S.next(0, cur)) return;
    f32x4 acc[2][2][4][2];
#pragma unroll
    for (int a = 0; a < 2; ++a)
#pragma unroll
        for (int b = 0; b < 2; ++b)
#pragma unroll
            for (int m = 0; m < 4; ++m)
#pragma unroll
                for (int n = 0; n < 2; ++n) acc[a][b][m][n] = (f32x4){0.f, 0.f, 0.f, 0.f};
    bf16x8 At[4][2], B0[2][2], B1[2][2];
    unsigned gC[2][2] = {{0u, 0u}, {0u, 0u}}, gN[2][2] = {{0u, 0u}, {0u, 0u}};
    const char* cA = GATHER ? (const char*)g.A : S.a_base(g, cur); const char* cB = S.b_base(g, cur);
    if constexpr (GATHER) { PG8_GOFFS(gC, cur); asm volatile("s_waitcnt vmcnt(0)" ::: "memory"); }
    PG8_STAGE(PG8_SB(0, 0), cB, voffB); PG8_STAGE(PG8_SB(0, 1), cB + hstepB, voffB); PG8_STAGE_A(PG8_SA(0, 0), cA, 0, gC); PG8_STAGE_A(PG8_SA(0, 1), cA, 1, gC);
    if (wr == 1) PG8_BAR;
    PG8_WAIT_V(2); PG8_BAR;
    PG8_STAGE(PG8_SB(1, 0), cB + kstep, voffB); PG8_STAGE_A(PG8_SA(1, 0), cA + kstep, 0, gC); PG8_STAGE(PG8_SB(1, 1), cB + hstepB + kstep, voffB);
    PG8_WAIT_V(6); PG8_BAR;
    for (;;) {
        const bool has_next = S.next(ui + 1, nxt);
        const char* nA = GATHER ? (const char*)g.A : (has_next ? S.a_base(g, nxt) : cA); const char* nB = has_next ? S.b_base(g, nxt) : cB;
        if constexpr (GATHER) {
            if (has_next) { PG8_GOFFS(gN, nxt); }
            else {
#pragma unroll
                for (int _h = 0; _h < 2; ++_h)
#pragma unroll
                    for (int _i = 0; _i < 2; ++_i) gN[_h][_i] = gC[_h][_i];
            }
        }
        for (int t = 0; t < nt; t += 2) {
            const bool last = (t == nt - 2);
            const char* a1 = cA + (size_t)(t + 1) * kstep;
            const char* a2 = last ? nA : cA + (size_t)(t + 2) * kstep; const char* b2 = last ? nB : cB + (size_t)(t + 2) * kstep;
            const char* a3 = a2 + kstep; const char* b3 = b2 + kstep;
            unsigned g2[2][2];
            if constexpr (GATHER) {
#pragma unroll
                for (int _h = 0; _h < 2; ++_h)
#pragma unroll
                    for (int _i = 0; _i < 2; ++_i) g2[_h][_i] = last ? gN[_h][_i] : gC[_h][_i];
            }
            PG8_LDB(B0, 0, 0); PG8_LDB(B1, 0, 1); PG8_SCHED; PG8_LDA(At, 0, 0); PG8_STAGE_A(PG8_SA(1, 1), a1, 1, gC);
            PG8_WAIT_V(8); PG8_WAIT_L(0); PG8_BAR; PG8_MMA(0, 0, At, B0); PG8_MMA(0, 1, At, B1); PG8_BAR; PG8_SCHED;
            PG8_LDA(At, 0, 1); PG8_STAGE(PG8_SB(0, 0), b2, voffB); PG8_STAGE(PG8_SB(0, 1), b2 + hstepB, voffB); PG8_STAGE_A(PG8_SA(0, 0), a2, 0, g2);
            PG8_WAIT_V(8); PG8_WAIT_L(0); PG8_BAR; PG8_MMA(1, 0, At, B0); PG8_MMA(1, 1, At, B1); PG8_BAR; PG8_SCHED;
            PG8_LDB(B0, 1, 0); PG8_LDB(B1, 1, 1); PG8_SCHED; PG8_LDA(At, 1, 0); PG8_STAGE_A(PG8_SA(0, 1), a2, 1, g2);
            PG8_WAIT_V(8); PG8_WAIT_L(0); PG8_BAR; PG8_MMA(0, 0, At, B0); PG8_MMA(0, 1, At, B1); PG8_BAR; PG8_SCHED;
            PG8_LDA(At, 1, 1); PG8_STAGE(PG8_SB(1, 0), b3, voffB); PG8_STAGE(PG8_SB(1, 1), b3 + hstepB, voffB); PG8_STAGE_A(PG8_SA(1, 0), a3, 0, g2);
            PG8_WAIT_V(8); PG8_WAIT_L(0); PG8_BAR; PG8_MMA(1, 0, At, B0); PG8_MMA(1, 1, At, B1); PG8_BAR; PG8_SCHED;
        }
        if constexpr (ALIGN_EPI) { if (wr == 0) PG8_BAR; }
        { const int l2_ = lane_id_fresh_pg8();
          E(acc, cur, wr, wc, l2_ & 15, l2_ >> 4); }
        if (!has_next) break;
#pragma unroll
        for (int a = 0; a < 2; ++a)
#pragma unroll
            for (int b = 0; b < 2; ++b)
#pragma unroll
                for (int m = 0; m < 4; ++m)
#pragma unroll
                    for (int n = 0; n < 2; ++n) acc[a][b][m][n] = (f32x4){0.f, 0.f, 0.f, 0.f};
        cur = nxt; cA = nA; cB = nB; ++ui;
        if constexpr (GATHER) {
#pragma unroll
            for (int _h = 0; _h < 2; ++_h)
#pragma unroll
                for (int _i = 0; _i < 2; ++_i) gC[_h][_i] = gN[_h][_i];
        }
        if constexpr (ALIGN_EPI) { if (wr == 1) PG8_BAR; }
    }
    PG8_WAIT_V(0);
    if constexpr (!ALIGN_EPI) { if (wr == 0) PG8_BAR; }
    PG8_BAR;
#undef PG8_SA
#undef PG8_SB
#undef PG8_STAGE
#undef PG8_STAGE_A
#undef PG8_LDA
#undef PG8_LDB
#undef PG8_MMA
#undef PG8_WAIT_V
#undef PG8_WAIT_L
#undef PG8_BAR
#undef PG8_SCHED
#undef PG8_GOFFS
}
}

constexpr int NWAVES = 8;
constexpr int BATCH = 2, SEQ = 8192, D = 1024, M = BATCH * SEQ, NP = 7168, DFF = 2816, NE = 8, INC = 7056;
constexpr int MROWS_MOE = 2 * M + 2048;
constexpr int C_NSAQ = 0, C_KC = 256, C_VC = 320, C_KSL = 384, C_VSL = 448, C_KW = 512, C_VW = 576, C_AG = 640, C_DF = 652,
              C_BQ = 768, C_BK = 1024, C_BV = 1280, C_CQ = 1536, C_CK = 1792, C_CV = 2048, C_DQ = 2304, C_DK = 2560, C_DV = 2816, C_MG = 3072;
constexpr float EPS = 1e-6f;
constexpr float SKIP_THR = 40.0f;

constexpr size_t MiB = 1u << 20;
constexpr size_t WS_CTL = 0, CTL_ZERO_BYTES = 1 * MiB;
constexpr size_t WS_MOD = 1 * MiB;
constexpr size_t WS_LIST = 1 * MiB + 256 * 1024;
constexpr size_t WS_TOKINFO = 2 * MiB;
constexpr size_t WS_Y = 4 * MiB;
constexpr size_t WS_ROPE_C = 4 * MiB, WS_ROPE_S = 5 * MiB;
constexpr size_t WS_KCMP = 6 * MiB, WS_VCMP = 6 * MiB + 256 * 1024;
constexpr size_t WS_WIN = 16 * MiB;
constexpr size_t WS_WBR = 44 * MiB;
constexpr size_t WS_WOUT = 48 * MiB;
constexpr size_t WS_W13 = 52 * MiB;
constexpr size_t WS_W2 = 63 * MiB;
constexpr size_t WS_ARENA = 72 * MiB;
constexpr size_t WS_PROJ = WS_ARENA;
constexpr size_t WS_O = WS_ARENA + 224 * MiB;
constexpr size_t WS_GACC = WS_ARENA + 256 * MiB;
constexpr size_t WS_H = WS_ARENA + 320 * MiB;
constexpr size_t WS_HMID = WS_ARENA;
constexpr size_t WS_MOEW13 = WS_ARENA;
constexpr size_t WS_MOEW2 = WS_ARENA + 88 * MiB;
constexpr size_t WS_HMID_MOE = WS_ARENA + 132 * MiB;
constexpr size_t WS_TILED = WS_GACC;
constexpr size_t WS_LC = WS_TILED + 88 * MiB;
constexpr size_t WS_TC = WS_LC + 512 * 1024;
constexpr size_t WS_END = WS_ARENA + 352 * MiB;
static_assert(WS_TC + 8192 <= WS_H + 32 * MiB, "tiled region");
static_assert(WS_HMID_MOE + (size_t)MROWS_MOE * DFF * 2 <= WS_H, "moe hmid vs H");
static_assert(WS_Y + (size_t)MROWS_MOE * 1024 * 2 <= WS_ARENA, "Y overlay");
constexpr int CW_BAR = 4096;
constexpr int CW_MOECNT = 1024;

constexpr int RING_BYTES = 131072;
constexpr int MISC_OFF = RING_BYTES + 320;
constexpr int LDS_BYTES = 147456;

#define GAS __attribute__((address_space(1)))
#define LAS __attribute__((address_space(3)))
typedef unsigned short bf16;
typedef unsigned v4u __attribute__((ext_vector_type(4)));
typedef float f32x4 __attribute__((ext_vector_type(4)));
typedef GAS unsigned gu32;
#define RLX_AGENT __ATOMIC_RELAXED, __HIP_MEMORY_SCOPE_AGENT
#define LDS_WAIT() asm volatile("s_waitcnt lgkmcnt(0)" ::: "memory")
__device__ __forceinline__ unsigned f2bf(float f) { unsigned u = __builtin_bit_cast(unsigned, f); return (u + 0x7fffu + ((u >> 16) & 1u)) >> 16; }
__device__ __forceinline__ unsigned pk2(float lo, float hi) { return f2bf(lo) | (f2bf(hi) << 16); }
__device__ __forceinline__ float bf2f(unsigned short v) { return __uint_as_float((unsigned)v << 16); }
__device__ __forceinline__ int lane_id_fresh() { int l; asm volatile("v_mbcnt_lo_u32_b32 %0, -1, 0\n\tv_mbcnt_hi_u32_b32 %0, -1, %0" : "=v"(l)); return l; }

#define XB_TMO      128
#define XB_XCNT(j)  (256  + 64 * (j))
#define XB_XSUB(j)  (1280 + 64 * (j))
#define XB_XGEN(j)  (2304 + 64 * (j))
#define XB_TOP      3328
#define XB_TOPGEN   3392
#define XCD_BAR_WORDS 3456
#define XB_SPIN_CAP (1u << 22)
__device__ __forceinline__ unsigned xb_ld(unsigned* p)              { return __hip_atomic_load(p, __ATOMIC_RELAXED, __HIP_MEMORY_SCOPE_AGENT); }
__device__ __forceinline__ unsigned xb_add(unsigned* p, unsigned v) { return __hip_atomic_fetch_add(p, v, __ATOMIC_RELAXED, __HIP_MEMORY_SCOPE_AGENT); }
__device__ __forceinline__ unsigned xb_xcc_id() { return (unsigned)__builtin_amdgcn_s_getreg((3 << 11) | 20) & 0xFu; }
#define XB_SPIN(cond, bar) do { unsigned _sp = 0; while (cond) { __builtin_amdgcn_s_sleep(1); \
    if ((++_sp & 255u) == 0u) { if (xb_ld(&(bar)[XB_TMO])) break; if (_sp > XB_SPIN_CAP) { atomicAdd(&(bar)[XB_TMO], 1u); break; } } } } while (0)
struct XcdBarrier { unsigned* bar; unsigned x; volatile LAS unsigned* st; };
__device__ __forceinline__ XcdBarrier xcd_barrier_post(unsigned* bar, volatile LAS unsigned* st, bool leader) {
    XcdBarrier b; b.bar = bar; b.x = xb_xcc_id(); b.st = st;
    if (leader) (void)xb_add(&bar[XB_XCNT(b.x)], 1u);
    return b;
}
__device__ __forceinline__ void xcd_barrier_complete(unsigned* bar, unsigned x, unsigned& nloc, unsigned& nx) {
    const unsigned G = gridDim.x * gridDim.y * gridDim.z;
    unsigned sum, cnt, mine, sp = 0u;
    for (;;) {
        sum = 0u; cnt = 0u; mine = 0u;
#pragma unroll
        for (unsigned j = 0; j < 16; ++j) { const unsigned c = xb_ld(&bar[XB_XCNT(j)]); sum += c; cnt += (c > 0u) ? 1u : 0u; mine = (j == x) ? c : mine; }
        if (sum == G) break;
        __builtin_amdgcn_s_sleep(1);
        if ((++sp & 255u) == 0u) { if (xb_ld(&bar[XB_TMO])) break; if (sp > XB_SPIN_CAP) { atomicAdd(&bar[XB_TMO], 1u); break; } }
    }
    nloc = mine > 0u ? mine : 1u; nx = cnt > 0u ? cnt : 1u;
}
__device__ __forceinline__ void xcd_barrier(const XcdBarrier& b, bool leader) {
    asm volatile("s_waitcnt vmcnt(0)" ::: "memory");
    __syncthreads();
    if (leader) {
        unsigned* bar = b.bar;
        __builtin_amdgcn_s_waitcnt(0);
        unsigned nloc = b.st[0], nx = b.st[1];
        if (nloc == 0u) { xcd_barrier_complete(bar, b.x, nloc, nx); b.st[0] = nloc; b.st[1] = nx; }
        const unsigned old = xb_add(&bar[XB_XSUB(b.x)], 1u);
        const unsigned gen = old / nloc;
        if (old + 1u == (gen + 1u) * nloc) {
            __builtin_amdgcn_fence(__ATOMIC_RELEASE, "agent");
            asm volatile("s_waitcnt vmcnt(0)" ::: "memory");
            const unsigned og = xb_add(&bar[XB_TOP], 1u);
            const unsigned tg = og / nx;
            if (og + 1u == (tg + 1u) * nx) xb_add(&bar[XB_TOPGEN], 1u);
            else XB_SPIN(xb_ld(&bar[XB_TOPGEN]) == tg, bar);
            __builtin_amdgcn_fence(__ATOMIC_ACQUIRE, "agent");
            xb_add(&bar[XB_XGEN(b.x)], 1u);
            asm volatile("s_waitcnt vmcnt(0)" ::: "memory");
        } else {
            XB_SPIN(xb_ld(&bar[XB_XGEN(b.x)]) == gen, bar);
            __builtin_amdgcn_fence(__ATOMIC_ACQUIRE, "agent");
            asm volatile("s_waitcnt vmcnt(0)" ::: "memory");
        }
    }
    __syncthreads();
}

struct Args { const void* in[25]; float* out; unsigned char* ws; int ph_lo, ph_hi; };
typedef const __attribute__((address_space(4))) Args* ArgsP;
struct Frame {
    LAS unsigned char* lds;
    int tid, lane, wave, G, gw, NGW;
    unsigned char* ws;
    gu32* ctl;
};

template <int K> __device__ __forceinline__ float swz_xor(float v) { return __int_as_float(__builtin_amdgcn_ds_swizzle(__float_as_int(v), (K << 10) | 0x1f)); }
template <int K> __device__ __forceinline__ int swz_xor_i(int v) { return __builtin_amdgcn_ds_swizzle(v, (K << 10) | 0x1f); }
__device__ __forceinline__ float wave_sum(float v) {
    v += swz_xor<1>(v); v += swz_xor<2>(v); v += swz_xor<4>(v); v += swz_xor<8>(v); v += swz_xor<16>(v);
    const auto r = __builtin_amdgcn_permlane32_swap(__float_as_uint(v), __float_as_uint(v), false, false);
    return __uint_as_float(r[0]) + __uint_as_float(r[1]);
}

struct MapIdent { const float* W; int N; __device__ const float* operator()(int n) const { return W + n; } __device__ int stride() const { return N; } };
struct MapWin {
    const float* W;
    __device__ const float* operator()(int j) const {
        int o;
        if (j < 652) o = j; else if (j < 656) o = 2956 + (j - 652); else if (j < 768) return nullptr; else if (j < 3072) o = 652 + (j - 768); else o = 2960 + (j - 3072);
        return W + o;
    }
    __device__ int stride() const { return INC; }
};
struct MapW13 {
    const float* W1; const float* W3;
    __device__ const float* operator()(int j) const { const int tile = j >> 8, r = j & 255; return (r < 128) ? (W1 + tile * 128 + r) : (W3 + tile * 128 + (r - 128)); }
    __device__ int stride() const { return DFF; }
};
template <class Map>
__device__ __forceinline__ void transpose_item(const Map mp, int K, bf16* WT, LAS float* scr, int kb, int nb, int lane) {
    const int k0 = 64 * kb, n0 = 32 * nb; const float* cp = mp(n0 + (lane & 31)); const int st = mp.stride();
#pragma unroll 8
    for (int i = 0; i < 32; ++i) { const int kk = 2 * i + (lane >> 5); scr[kk * 33 + (lane & 31)] = cp ? cp[(size_t)(k0 + kk) * st] : 0.f; }
    LDS_WAIT(); asm volatile("" ::: "memory");
    const int c = lane & 7;
#pragma unroll
    for (int j = 0; j < 4; ++j) { const int n = (lane >> 3) + 8 * j; const LAS float* s = scr + (8 * c) * 33 + n;
        v4u o; o.x = pk2(s[0 * 33], s[1 * 33]); o.y = pk2(s[2 * 33], s[3 * 33]); o.z = pk2(s[4 * 33], s[5 * 33]); o.w = pk2(s[6 * 33], s[7 * 33]);
        *(GAS v4u*)(WT + (size_t)(n0 + n) * K + k0 + 8 * c) = o; }
    LDS_WAIT(); asm volatile("" ::: "memory");
}
template <class Map>
__device__ __forceinline__ void transpose_all(Frame& F, const Map mp, int K, int Nout, bf16* WT, int& itbase) {
    LAS float* scr = (LAS float*)(F.lds + F.wave * 16384);
    const int nblk = Nout / 32, n = (K / 64) * nblk;
    int first = (F.gw - (itbase % F.NGW) + F.NGW) % F.NGW;
    for (int it = first; it < n; it += F.NGW) transpose_item(mp, K, WT, scr, it / nblk, it % nblk, F.lane);
    itbase += n;
}

__device__ __forceinline__ float gelu_tanh(float x) { const float u = 0.7978845608028654f * (x + 0.044715f * x * x * x); return 0.5f * x * (1.0f + tanhf(u)); }
__device__ __forceinline__ float log_sigmoid(float x) { return fminf(x, 0.f) - log1pf(__expf(-fabsf(x))); }

__device__ __forceinline__ void load64(const bf16* p, float (&v)[64]) {
    const v4u* p4 = (const v4u*)p;
#pragma unroll
    for (int i = 0; i < 8; ++i) { const v4u u = p4[i];
#pragma unroll
        for (int k = 0; k < 4; ++k) { v[8 * i + 2 * k] = __uint_as_float(u[k] << 16); v[8 * i + 2 * k + 1] = __uint_as_float(u[k] & 0xffff0000u); } }
}
__device__ __forceinline__ float dot64(const bf16* p, const float (&q)[64]) {
    const v4u* p4 = (const v4u*)p; float s0 = 0.f, s1 = 0.f;
#pragma unroll
    for (int i = 0; i < 8; ++i) { if (i == 4) asm volatile("" ::: "memory"); const v4u u = p4[i];
#pragma unroll
        for (int k = 0; k < 4; ++k) { s0 += __uint_as_float(u[k] << 16) * q[8 * i + 2 * k]; s1 += __uint_as_float(u[k] & 0xffff0000u) * q[8 * i + 2 * k + 1]; } }
    return s0 + s1;
}
__device__ __forceinline__ void axpy64(const bf16* p, float w, float (&o)[64]) {
    const v4u* p4 = (const v4u*)p;
#pragma unroll
    for (int i = 0; i < 8; ++i) { if (i == 4) asm volatile("" ::: "memory"); const v4u u = p4[i];
#pragma unroll
        for (int k = 0; k < 4; ++k) { o[8 * i + 2 * k] += w * __uint_as_float(u[k] << 16); o[8 * i + 2 * k + 1] += w * __uint_as_float(u[k] & 0xffff0000u); } }
}
__device__ __forceinline__ void store64(bf16* p, const float (&v)[64]) {
    v4u* p4 = (v4u*)p;
#pragma unroll
    for (int i = 0; i < 8; ++i) { v4u u;
#pragma unroll
        for (int k = 0; k < 4; ++k) u[k] = pk2(v[8 * i + 2 * k], v[8 * i + 2 * k + 1]);
        p4[i] = u; }
}
#define SOFTMAX_STEP(s_, vp_) do { const float _s = (s_); if (_s > m_run) { const float _f = __expf(m_run - _s); l_run *= _f; _Pragma("unroll") for (int _d = 0; _d < 64; ++_d) o[_d] *= _f; m_run = _s; } \
    const float _p = __expf(_s - m_run); l_run += _p; axpy64((vp_), _p, o); } while (0)

__device__ __forceinline__ void phase_prologue(Frame& F, ArgsP a) {
    const float* c_in = (const float*)a->in[1]; const int* pos = (const int*)a->in[2];
    const float* w_ada = (const float*)a->in[3]; const float* b_ada = (const float*)a->in[4];
    {
        LAS float* sc = (LAS float*)(F.lds);
        LAS float* part = (LAS float*)(F.lds + 8192);
        for (int i = F.tid; i < 2048; i += NWAVES * 64) { const float v = c_in[i]; sc[i] = v / (1.0f + __expf(-v)); }
        __syncthreads();
        for (int it = blockIdx.x; it < 2 * 96; it += F.G) {
            const int l = it / 96, j0 = (it % 96) * 64; const float* W = w_ada + (size_t)l * 1024 * 6144 + j0 + F.lane;
            float a0 = 0.f, a1 = 0.f;
#pragma unroll 16
            for (int k = 0; k < 128; ++k) { const int kk = F.wave * 128 + k; const float w = W[(size_t)kk * 6144]; a0 += sc[kk] * w; a1 += sc[1024 + kk] * w; }
            part[(F.wave * 2 + 0) * 64 + F.lane] = a0; part[(F.wave * 2 + 1) * 64 + F.lane] = a1;
            __syncthreads();
            if (F.wave < 2) { float s = 0.f;
#pragma unroll
                for (int w = 0; w < 8; ++w) s += part[(w * 2 + F.wave) * 64 + F.lane];
                ((float*)(F.ws + WS_MOD))[((size_t)l * 2 + F.wave) * 6144 + j0 + F.lane] = s + b_ada[(size_t)l * 6144 + j0 + F.lane]; }
            __syncthreads();
        }
    }
    {
        float* rc = (float*)(F.ws + WS_ROPE_C); float* rs = (float*)(F.ws + WS_ROPE_S);
        for (int i = blockIdx.x * (NWAVES * 64) + F.tid; i < M * 8; i += F.G * NWAVES * 64) {
            const int tok = i >> 3, fi = i & 7;
            const float inv = fi == 0 ? 1.0f : fi == 1 ? 0.1939227432012558f : fi == 2 ? 0.03760603070259094f : fi == 3 ? 0.007292664609849453f : fi == 4 ? 0.0014142135623842478f
                            : fi == 5 ? 0.00027424818836152554f : fi == 6 ? 5.318296098266728e-05f : 1.0313386155758053e-05f;
            const float ang = (float)pos[tok] * inv;
            double rev = (double)ang * 0.15915494309189535; rev -= floor(rev);
            const float fr = (float)rev;
            rs[i] = __builtin_amdgcn_sinf(fr); rc[i] = __builtin_amdgcn_cosf(fr);
        }
    }
    {
        int itb = 0;
        const float* w_in = (const float*)a->in[7]; const float* w_br = (const float*)a->in[16]; const float* w_out = (const float*)a->in[17];
        for (int l = 0; l < 2; ++l) {
            transpose_all(F, MapWin{w_in + (size_t)l * 1024 * INC}, 1024, NP, (bf16*)(F.ws + WS_WIN) + (size_t)l * NP * 1024, itb);
            for (int z = 0; z < 4; ++z) transpose_all(F, MapIdent{w_br + ((size_t)l * 4 + z) * 256 * 1024, 1024}, 256, 1024, (bf16*)(F.ws + WS_WBR) + ((size_t)l * 4 + z) * 1024 * 256, itb);
            transpose_all(F, MapIdent{w_out + (size_t)l * 1024 * 1024, 1024}, 1024, 1024, (bf16*)(F.ws + WS_WOUT) + (size_t)l * 1024 * 1024, itb);
        }
        transpose_all(F, MapW13{(const float*)a->in[18], (const float*)a->in[19]}, 1024, 2 * DFF, (bf16*)(F.ws + WS_W13), itb);
        transpose_all(F, MapIdent{(const float*)a->in[20], 1024}, DFF, 1024, (bf16*)(F.ws + WS_W2), itb);
    }
}
__device__ __forceinline__ void phase_moe_weights(Frame& F, ArgsP a) {
    int itb = 0;
    const float* w1 = (const float*)a->in[22]; const float* w3 = (const float*)a->in[23]; const float* w2 = (const float*)a->in[24];
    for (int e = 0; e < NE; ++e) {
        transpose_all(F, MapW13{w1 + (size_t)e * 1024 * DFF, w3 + (size_t)e * 1024 * DFF}, 1024, 2 * DFF, (bf16*)(F.ws + WS_MOEW13) + (size_t)e * 2 * DFF * 1024, itb);
        transpose_all(F, MapIdent{w2 + (size_t)e * DFF * 1024, 1024}, DFF, 1024, (bf16*)(F.ws + WS_MOEW2) + (size_t)e * 1024 * DFF, itb);
    }
}

template <bool ROUTE>
__device__ __forceinline__ void phase_norm(Frame& F, const float* x, const float* nw, const float* sh, const float* sc, const float* router) {
    bf16* H = (bf16*)(F.ws + WS_H);
    const int rows_per = ROUTE ? 8 : 1;
    for (int r0 = F.gw * rows_per; r0 < M; r0 += F.NGW * rows_per) {
        const int b = r0 >> 13;
        f32x4 A[4], Bv[4];
#pragma unroll
        for (int j = 0; j < 4; ++j) { const int c = 4 * F.lane + 256 * j; const f32x4 w = *(const f32x4*)(nw + c), s = *(const f32x4*)(sc + (size_t)b * 6144 + c); A[j] = w * (s + 1.0f); Bv[j] = *(const f32x4*)(sh + (size_t)b * 6144 + c); }
        int myE = 0; float myG = 0.f;
        for (int rr = 0; rr < rows_per; ++rr) {
            const int m = r0 + rr;
            const GAS f32x4* xr = (const GAS f32x4*)(x + (size_t)m * D) + F.lane;
            f32x4 v[4]; float s2 = 0.f;
#pragma unroll
            for (int j = 0; j < 4; ++j) { v[j] = xr[64 * j]; s2 += (v[j].x * v[j].x + v[j].y * v[j].y) + (v[j].z * v[j].z + v[j].w * v[j].w); }
            const float rstd = 1.0f / sqrtf(wave_sum(s2) * (1.f / D) + EPS);
#pragma unroll
            for (int j = 0; j < 4; ++j) v[j] = (v[j] * rstd) * A[j] + Bv[j];
            GAS unsigned long long* o8 = (GAS unsigned long long*)(H + (size_t)m * D) + F.lane;
#pragma unroll
            for (int j = 0; j < 4; ++j) o8[64 * j] = (unsigned long long)pk2(v[j].x, v[j].y) | ((unsigned long long)pk2(v[j].z, v[j].w) << 32);
            if constexpr (ROUTE) {
                float lg[8];
#pragma unroll
                for (int e = 0; e < 8; ++e) lg[e] = 0.f;
#pragma unroll
                for (int j = 0; j < 4; ++j)
#pragma unroll
                    for (int k = 0; k < 4; ++k) { const int c = 4 * F.lane + 256 * j + k; const f32x4 w0 = *(const f32x4*)(router + (size_t)c * 8), w1 = *(const f32x4*)(router + (size_t)c * 8 + 4); const float xv = v[j][k];
                        lg[0] += xv * w0.x; lg[1] += xv * w0.y; lg[2] += xv * w0.z; lg[3] += xv * w0.w; lg[4] += xv * w1.x; lg[5] += xv * w1.y; lg[6] += xv * w1.z; lg[7] += xv * w1.w; }
#pragma unroll
                for (int e = 0; e < 8; ++e) lg[e] = wave_sum(lg[e]);
                int e0 = 0; float v0 = lg[0];
#pragma unroll
                for (int e = 1; e < 8; ++e) if (lg[e] > v0) { v0 = lg[e]; e0 = e; }
                int e1 = -1; float v1 = -3.0e38f;
#pragma unroll
                for (int e = 0; e < 8; ++e) if (e != e0 && lg[e] > v1) { v1 = lg[e]; e1 = e; }
                const float g0 = 1.0f / (1.0f + __expf(v1 - v0)), g1 = 1.0f - g0;
                if (F.lane == 2 * rr) { myE = e0; myG = g0; }
                if (F.lane == 2 * rr + 1) { myE = e1; myG = g1; }
            }
        }
        if constexpr (ROUTE) {
            gu32* cnt = F.ctl + CW_MOECNT; int* list = (int*)(F.ws + WS_LIST); int* info = (int*)(F.ws + WS_TOKINFO);
            const bool act = F.lane < 16; int myrank = 0;
#pragma unroll
            for (int e = 0; e < 8; ++e) {
                const unsigned long long mk = __ballot(act && myE == e);
                const int c = __popcll(mk); unsigned base = 0;
                if (c > 0) { if (F.lane == 0) base = __hip_atomic_fetch_add(cnt + 64 * e, (unsigned)c, RLX_AGENT); base = __builtin_amdgcn_readfirstlane(base); }
                if (act && myE == e) myrank = (int)base + __popcll(mk & ((1ull << F.lane) - 1ull));
            }
            if (act) { const int tok = r0 + (F.lane >> 1); list[myE * 16384 + myrank] = tok; int* ip = info + ((size_t)tok * 2 + (F.lane & 1)) * 4; ip[0] = myE; ip[1] = myrank; ip[2] = __float_as_int(myG); ip[3] = 0; }
        }
    }
}

__device__ __forceinline__ void phase_qknorm(Frame& F, const float* qk_gain  ) {
    bf16* P = (bf16*)(F.ws + WS_PROJ); const float* rc = (const float*)(F.ws + WS_ROPE_C); const float* rs = (const float*)(F.ws + WS_ROPE_S);
    for (int it = blockIdx.x * (NWAVES * 64) + F.tid; it < M * 24; it += F.G * NWAVES * 64) {
        const int tok = it / 24, s = it % 24; int col, gi; bool rope;
        if (s < 4) { col = C_NSAQ + 64 * s; gi = 0; rope = false; }
        else if (s == 4) { col = C_KC; gi = 1; rope = false; }
        else if (s == 5) { col = C_KSL; gi = 2; rope = true; }
        else if (s == 6) { col = C_KW; gi = 3; rope = true; }
        else if (s < 11) { col = C_BQ + 64 * (s - 7); gi = 4; rope = true; }
        else if (s < 15) { col = C_BK + 64 * (s - 11); gi = 5; rope = true; }
        else if (s < 19) { col = C_DQ + 64 * (s - 15); gi = 6; rope = false; }
        else if (s < 23) { col = C_DK + 64 * (s - 19); gi = 7; rope = false; }
        else continue;
        bf16* p = P + (size_t)tok * NP + col; float v[64]; load64(p, v);
        float ss = 0.f;
#pragma unroll
        for (int d = 0; d < 64; ++d) ss += v[d] * v[d];
        const float r = 1.0f / sqrtf(ss * (1.f / 64.f) + EPS); const float* g = qk_gain + gi * 64;
#pragma unroll
        for (int d = 0; d < 64; ++d) v[d] = v[d] * r * g[d];
        if (rope) {
#pragma unroll
            for (int i = 0; i < 8; ++i) { const float c = rc[(size_t)tok * 8 + i], sn = rs[(size_t)tok * 8 + i]; const float x1 = v[i], x2 = v[8 + i]; v[i] = x1 * c - x2 * sn; v[8 + i] = x2 * c + x1 * sn; }
        }
        store64(p, v);
    }
}

__device__ __forceinline__ void phase_compress(Frame& F, const float* pe_k, const float* pe_v, const float* k1, const float* k2, const float* v1, const float* v2) {
    const bf16* P = (const bf16*)(F.ws + WS_PROJ);
    LAS float* Ain = (LAS float*)(F.lds + F.wave * 9216);
    LAS float* hid = Ain + 2048;
    for (int it = F.gw; it < 2 * 2 * 511; it += F.NGW) {
        const int which = it / 1022, r = it % 1022, b = r / 511, c = r % 511;
        const float* pe = which ? pe_v : pe_k; const float* w1 = which ? v1 : k1; const float* w2 = which ? v2 : k2; const int col = which ? C_VC : C_KC;
        for (int i = F.lane; i < 2048; i += 64) { const int l = i >> 6, d = i & 63; Ain[i] = bf2f(P[(size_t)(b * SEQ + 16 * c + l) * NP + col + d]) + pe[i]; }
        LDS_WAIT(); asm volatile("" ::: "memory");
        float h0 = 0.f, h1 = 0.f;
#pragma unroll 8
        for (int i = 0; i < 2048; ++i) { const float av = Ain[i]; h0 += av * w1[(size_t)i * 128 + F.lane]; h1 += av * w1[(size_t)i * 128 + 64 + F.lane]; }
        hid[F.lane] = gelu_tanh(h0); hid[64 + F.lane] = gelu_tanh(h1);
        LDS_WAIT(); asm volatile("" ::: "memory");
        float o = 0.f;
#pragma unroll 8
        for (int j = 0; j < 128; ++j) o += hid[j] * w2[j * 64 + F.lane];
        bf16* dst = (bf16*)(F.ws + (which ? WS_VCMP : WS_KCMP)) + ((size_t)b * 512 + c) * 64;
        dst[F.lane] = (bf16)f2bf(o);
        LDS_WAIT(); asm volatile("" ::: "memory");
    }
}

__device__ __forceinline__ void attn_nsa_item(Frame& F, int item) {
    const bf16* P = (const bf16*)(F.ws + WS_PROJ); float* OACC = (float*)(F.ws + WS_END);        bf16* O = (bf16*)(F.ws + WS_O);
    const bf16* KC = (const bf16*)(F.ws + WS_KCMP); const bf16* VC = (const bf16*)(F.ws + WS_VCMP);
    const float* rc = (const float*)(F.ws + WS_ROPE_C); const float* rs = (const float*)(F.ws + WS_ROPE_S);
    LAS float* imp = (LAS float*)(F.lds + F.wave * 9216);
    LAS int* sel = (LAS int*)(F.lds + F.wave * 9216 + 8192);
    const int tt = F.lane >> 2, h = F.lane & 3, tg = item * 16 + tt, b = tg >> 13, t = tg & (SEQ - 1);
    const bf16* prow = P + (size_t)tg * NP;
    float g3[3];
#pragma unroll
    for (int i = 0; i < 3; ++i) g3[i] = pg8::sigmoid_f(bf2f(prow[C_AG + 3 * h + i]));
    float q[64]; load64(prow + C_NSAQ + 64 * h, q);
    float o[64]; float m_run, l_run;
    for (int i = F.lane; i < 16 * 128; i += 64) imp[i] = 0.f;
    LDS_WAIT(); asm volatile("" ::: "memory");
    const int cmax = (t >= 31) ? ((t - 31) >> 4) : -1;
    m_run = -3.0e38f; l_run = 0.f;
#pragma unroll
    for (int d = 0; d < 64; ++d) o[d] = 0.f;
#pragma unroll 1
    for (int c = 0; c <= cmax; ++c) { const float s = dot64(KC + ((size_t)b * 512 + c) * 64, q) * 0.125f; SOFTMAX_STEP(s, VC + ((size_t)b * 512 + c) * 64); }
    const float inv_l = (cmax >= 0) ? 1.0f / l_run : 0.f;
    float* oacc = OACC + (size_t)tg * 256 + 64 * h;
#pragma unroll
    for (int d = 0; d < 64; ++d) oacc[d] = g3[0] * o[d] * inv_l;
    { float accj = 0.f, carry = 0.f;
#pragma unroll 1
      for (int c = 0; c <= cmax; ++c) {
          const float s = dot64(KC + ((size_t)b * 512 + c) * 64, q) * 0.125f; float p = __expf(s - m_run) * inv_l;
          p += swz_xor<1>(p); p += swz_xor<2>(p);
          accj += p;
          if ((c & 3) == 3) { if (h == 0) imp[tt * 128 + (c >> 2)] = carry + accj; carry = p; accj = 0.f; }
      }
      if (cmax >= 0 && h == 0) { if ((cmax & 3) != 3) imp[tt * 128 + (cmax >> 2)] = carry + accj; else if (((cmax + 1) >> 2) < 128) imp[tt * 128 + ((cmax + 1) >> 2)] = carry; }
    }
    LDS_WAIT(); asm volatile("" ::: "memory");
    const int cur = t >> 6; const int n_pick = (cur + 1 < 16) ? cur + 1 : 16;
    int nsel = 0;
    if (h == 0) { sel[tt * 16 + 0] = 0; }
    nsel = 1;
    if (cur >= 1) { if (h == 0) sel[tt * 16 + nsel] = cur; ++nsel; }
    if (cur >= 2) { if (h == 0) sel[tt * 16 + nsel] = cur - 1; ++nsel; }
    for (; nsel < n_pick; ++nsel) {
        float bv = -2.0f; int bi = 1 << 20;
        for (int j = 1 + h; j <= cur - 2; j += 4) { const float v = imp[tt * 128 + j]; if (v > bv) { bv = v; bi = j; } }
        { const float ov = swz_xor<1>(bv); const int oi = swz_xor_i<1>(bi); if (ov > bv || (ov == bv && oi < bi)) { bv = ov; bi = oi; } }
        { const float ov = swz_xor<2>(bv); const int oi = swz_xor_i<2>(bi); if (ov > bv || (ov == bv && oi < bi)) { bv = ov; bi = oi; } }
        if (h == 0) { sel[tt * 16 + nsel] = bi; imp[tt * 128 + bi] = -1.0f; }
        LDS_WAIT(); asm volatile("" ::: "memory");
    }
    LDS_WAIT(); asm volatile("" ::: "memory");
#pragma unroll
    for (int i = 0; i < 8; ++i) { const float c = rc[(size_t)tg * 8 + i], sn = rs[(size_t)tg * 8 + i]; const float x1 = q[i], x2 = q[8 + i]; q[i] = x1 * c - x2 * sn; q[8 + i] = x2 * c + x1 * sn; }
    m_run = -3.0e38f; l_run = 0.f;
#pragma unroll
    for (int d = 0; d < 64; ++d) o[d] = 0.f;
#pragma unroll 1
    for (int i = 0; i < n_pick; ++i) { const int jb = sel[tt * 16 + i];
#pragma unroll 1
        for (int l2 = 0; l2 < 64; ++l2) { const int kp = 64 * jb + l2; if (kp > t) break;
            const bf16* kr = P + (size_t)(b * SEQ + kp) * NP; const float s = dot64(kr + C_KSL, q) * 0.125f; SOFTMAX_STEP(s, kr + C_VSL); } }
    { const float il = 1.0f / l_run;
#pragma unroll
      for (int d = 0; d < 64; ++d) oacc[d] += g3[1] * o[d] * il; }
    m_run = -3.0e38f; l_run = 0.f;
#pragma unroll
    for (int d = 0; d < 64; ++d) o[d] = 0.f;
#pragma unroll 1
    for (int kp = (t >= 511 ? t - 511 : 0); kp <= t; ++kp) { const bf16* kr = P + (size_t)(b * SEQ + kp) * NP; const float s = dot64(kr + C_KW, q) * 0.125f; SOFTMAX_STEP(s, kr + C_VW); }
    { const float il = 1.0f / l_run;
#pragma unroll
      for (int d = 0; d < 64; ++d) o[d] = oacc[d] + g3[2] * o[d] * il; }
    store64(O + (size_t)tg * 1024 + 0 + 64 * h, o);
    LDS_WAIT(); asm volatile("" ::: "memory");
}
typedef short bf16x8v __attribute__((ext_vector_type(8)));
typedef float f32x16 __attribute__((ext_vector_type(16)));
constexpr float LOG2E = 1.4426950408889634f;
constexpr float QK_C = 0.125f * LOG2E;
constexpr float THR2 = SKIP_THR * LOG2E;
__device__ __forceinline__ const char* stream_tile(const Frame& F, int sid, int b, int tile) { return (const char*)(F.ws + WS_TILED) + (size_t)sid * (2 * MiB) + (size_t)b * MiB + (size_t)tile * 4096; }
__device__ __forceinline__ void load_tile(const char* kt, const char* vt, int lane, bf16x8v (&kf)[4], bf16x8v (&vf)[4]) {
#pragma unroll
    for (int i = 0; i < 4; ++i) { kf[i] = *(const bf16x8v*)(kt + i * 1024 + lane * 16); vf[i] = *(const bf16x8v*)(vt + i * 1024 + lane * 16); }
}
__device__ __forceinline__ f32x16 qk_tile(const bf16x8v (&kf)[4], const bf16x8v (&qf)[4]) {
    f32x16 s = {};
#pragma unroll
    for (int i = 0; i < 4; ++i) s = __builtin_amdgcn_mfma_f32_32x32x16_bf16(kf[i], qf[i], s, 0, 0, 0);
    return s;
}
__device__ __forceinline__ float half_max(float v) { const auto r = __builtin_amdgcn_permlane32_swap(__float_as_uint(v), __float_as_uint(v), false, false); return fmaxf(__uint_as_float(r[0]), __uint_as_float(r[1])); }
__device__ __forceinline__ float half_sum(float v) { const auto r = __builtin_amdgcn_permlane32_swap(__float_as_uint(v), __float_as_uint(v), false, false); return __uint_as_float(r[0]) + __uint_as_float(r[1]); }
__device__ __forceinline__ float half_other(float v, int hi) { const auto r = __builtin_amdgcn_permlane32_swap(__float_as_uint(v), __float_as_uint(v), false, false); return __uint_as_float(hi ? r[0] : r[1]); }
struct SoftSt { f32x16 o0, o1; float m, l; };
__device__ __forceinline__ void soft_init(SoftSt& st) { st.o0 = (f32x16){}; st.o1 = (f32x16){}; st.m = -1.0e30f; st.l = 0.f; }
__device__ __forceinline__ void pv_tile(SoftSt& st, const f32x16& p, const bf16x8v (&vf)[4]) {
    bf16x8v pf[2];
#pragma unroll
    for (int s2 = 0; s2 < 2; ++s2) { v4u w;
#pragma unroll
        for (int k = 0; k < 4; ++k) w[k] = pg8::cvt_pk_bf16(p[8 * s2 + 2 * k], p[8 * s2 + 2 * k + 1]);
        pf[s2] = __builtin_bit_cast(bf16x8v, w); }
    st.o0 = __builtin_amdgcn_mfma_f32_32x32x16_bf16(vf[0], pf[0], st.o0, 0, 0, 0);
    st.o0 = __builtin_amdgcn_mfma_f32_32x32x16_bf16(vf[1], pf[1], st.o0, 0, 0, 0);
    st.o1 = __builtin_amdgcn_mfma_f32_32x32x16_bf16(vf[2], pf[0], st.o1, 0, 0, 0);
    st.o1 = __builtin_amdgcn_mfma_f32_32x32x16_bf16(vf[3], pf[1], st.o1, 0, 0, 0);
}
__device__ __forceinline__ void soft_pv(SoftSt& st, f32x16& s, const bf16x8v (&vf)[4]) {
    float tm = fmaxf(fmaxf(s[0], s[1]), fmaxf(s[2], s[3]));
#pragma unroll
    for (int r = 4; r < 16; r += 4) tm = fmaxf(tm, fmaxf(fmaxf(s[r], s[r + 1]), fmaxf(s[r + 2], s[r + 3])));
    tm = half_max(tm);
    const float mn = fmaxf(st.m, tm);
    if (__any(mn > st.m)) { const float al = __builtin_amdgcn_exp2f(st.m - mn); st.l *= al; st.o0 = st.o0 * al; st.o1 = st.o1 * al; }
    st.m = mn;
    float ls = 0.f;
#pragma unroll
    for (int r = 0; r < 16; ++r) { s[r] = __builtin_amdgcn_exp2f(s[r] - mn); ls += s[r]; }
    st.l += ls;
    pv_tile(st, s, vf);
}
__device__ __forceinline__ void store_ot(bf16* orow, const f32x16& o0, const f32x16& o1, float sc, int hi) {
#pragma unroll
    for (int g = 0; g < 4; ++g) {
        uint2 w0, w1;
        w0.x = pg8::cvt_pk_bf16(o0[4 * g] * sc, o0[4 * g + 1] * sc); w0.y = pg8::cvt_pk_bf16(o0[4 * g + 2] * sc, o0[4 * g + 3] * sc);
        w1.x = pg8::cvt_pk_bf16(o1[4 * g] * sc, o1[4 * g + 1] * sc); w1.y = pg8::cvt_pk_bf16(o1[4 * g + 2] * sc, o1[4 * g + 3] * sc);
        *(uint2*)(orow + 8 * g + 4 * hi) = w0; *(uint2*)(orow + 32 + 8 * g + 4 * hi) = w1;
    }
}
__device__ __forceinline__ void load_q(const bf16* qrow, int hi, bf16x8v (&qf)[4]) {
#pragma unroll
    for (int i = 0; i < 4; ++i) qf[i] = *(const bf16x8v*)(qrow + 16 * i + 8 * hi);
}
#define CROW(r, hi) (((r) & 3) + 8 * ((r) >> 2) + 4 * (hi))

__device__ __forceinline__ void attn_fox_unit(Frame& F, int unit, const float* gk) {
    const int h = unit & 3, qt = (unit >> 2) & 255, b = unit >> 10, r32 = F.lane & 31, hi = F.lane >> 5;
    const bf16* P = (const bf16*)(F.ws + WS_PROJ); bf16* O = (bf16*)(F.ws + WS_O);
    const int tg = b * SEQ + 32 * qt + r32;
    bf16x8v qf[4]; load_q(P + (size_t)tg * NP + C_DQ + 64 * h, hi, qf);
    float qn = 0.f, gmax = 0.f;
#pragma unroll
    for (int i = 0; i < 4; ++i)
#pragma unroll
        for (int j = 0; j < 8; ++j) { const float v = bf2f((unsigned short)qf[i][j]); qn += v * v; }
    qn = half_sum(qn);
    for (int d = 0; d < 64; ++d) gmax = fmaxf(gmax, fabsf(gk[d]));
    const float qkmax2 = sqrtf(qn) * (8.0f * gmax) * QK_C * 1.02f;
    const float* LC = (const float*)(F.ws + WS_LC) + ((size_t)b * 4 + h) * SEQ; const float* TC = (const float*)(F.ws + WS_TC) + ((size_t)b * 4 + h) * 256;
    const float lct = LC[32 * qt + r32];
    SoftSt st; soft_init(st);
    bf16x8v kf[4], vf[4], kn[4], vn[4];
    load_tile(stream_tile(F, 36 + h, b, qt), stream_tile(F, 40 + h, b, qt), F.lane, kf, vf);
    float gacc = 0.f;
    for (int kt = qt; kt >= 0; --kt) {
        if (kt > 0) load_tile(stream_tile(F, 36 + h, b, kt - 1), stream_tile(F, 40 + h, b, kt - 1), F.lane, kn, vn);
        f32x16 s = qk_tile(kf, qf);
        const float base = lct + gacc;
#pragma unroll
        for (int g = 0; g < 4; ++g) { const f32x4 lc = *(const f32x4*)(LC + 32 * kt + 8 * g + 4 * hi);
#pragma unroll
            for (int k = 0; k < 4; ++k) s[4 * g + k] = s[4 * g + k] * QK_C + (base - lc[k]); }
        if (kt == qt) {
#pragma unroll
            for (int r = 0; r < 16; ++r) if (CROW(r, hi) > r32) s[r] = -INFINITY;
        }
        soft_pv(st, s, vf);
        if (__all(qkmax2 + lct + gacc - st.m < -THR2)) break;
        if (kt > 0) { gacc += TC[kt - 1];
#pragma unroll
            for (int i = 0; i < 4; ++i) { kf[i] = kn[i]; vf[i] = vn[i]; } }
    }
    const float lt = half_sum(st.l);
    store_ot(O + (size_t)tg * 1024 + 768 + 64 * h, st.o0, st.o1, 1.0f / lt, hi);
}
__device__ __forceinline__ void attn_sb_unit(Frame& F, int unit) {
    const int h = unit & 3, qt = (unit >> 2) & 255, b = unit >> 10, r32 = F.lane & 31, hi = F.lane >> 5;
    const bf16* P = (const bf16*)(F.ws + WS_PROJ); bf16* O = (bf16*)(F.ws + WS_O);
    const int tg = b * SEQ + 32 * qt + r32;
    bf16x8v qf[4]; load_q(P + (size_t)tg * NP + C_CQ + 64 * h, hi, qf);
    SoftSt st; soft_init(st);
    bf16x8v kf[4], vf[4], kn[4], vn[4];
    load_tile(stream_tile(F, 28 + h, b, qt), stream_tile(F, 32 + h, b, qt), F.lane, kf, vf);
    float R = 0.f;
    for (int kt = qt; kt >= 0; --kt) {
        if (kt > 0) load_tile(stream_tile(F, 28 + h, b, kt - 1), stream_tile(F, 32 + h, b, kt - 1), F.lane, kn, vn);
        f32x16 s = qk_tile(kf, qf);
        float L[16];
#pragma unroll
        for (int r = 0; r < 16; ++r) { const float z2 = s[r] * QK_C; const float sp = fmaxf(z2, 0.f) + __builtin_amdgcn_logf(1.0f + __builtin_amdgcn_exp2f(-fabsf(z2)));
            const bool ok = (kt < qt) || (CROW(r, hi) < r32); L[r] = ok ? -sp : 0.f; s[r] = ok ? (z2 - sp) : -INFINITY; }
        float gt[4], og[4];
#pragma unroll
        for (int g = 0; g < 4; ++g) { gt[g] = (L[4 * g] + L[4 * g + 1]) + (L[4 * g + 2] + L[4 * g + 3]); og[g] = half_other(gt[g], hi); }
        float suf[4];
        { float a = 0.f;
#pragma unroll
          for (int g = 3; g >= 0; --g) { suf[g] = a; a += gt[g]; }
          float bsum = 0.f;
#pragma unroll
          for (int g = 3; g >= 0; --g) { if (hi == 0) { bsum += og[g]; suf[g] += bsum; } else { suf[g] += bsum; bsum += og[g]; } }
        }
#pragma unroll
        for (int g = 0; g < 4; ++g) { const float a3 = R + suf[g], a2 = a3 + L[4 * g + 3], a1 = a2 + L[4 * g + 2], a0 = a1 + L[4 * g + 1];
            s[4 * g + 3] = __builtin_amdgcn_exp2f(s[4 * g + 3] + a3); s[4 * g + 2] = __builtin_amdgcn_exp2f(s[4 * g + 2] + a2);
            s[4 * g + 1] = __builtin_amdgcn_exp2f(s[4 * g + 1] + a1); s[4 * g] = __builtin_amdgcn_exp2f(s[4 * g] + a0); }
        pv_tile(st, s, vf);
        R += ((gt[0] + gt[1]) + (gt[2] + gt[3])) + ((og[0] + og[1]) + (og[2] + og[3]));
        if (__all(R < -THR2)) break;
        if (kt > 0) {
#pragma unroll
            for (int i = 0; i < 4; ++i) { kf[i] = kn[i]; vf[i] = vn[i]; } }
    }
    store_ot(O + (size_t)tg * 1024 + 512 + 64 * h, st.o0, st.o1, 1.0f, hi);
}
__device__ __forceinline__ void attn_dil_unit(Frame& F, int unit) {
    const int h = unit & 3, r16 = (unit >> 2) & 15, blk = (unit >> 6) & 15, b = unit >> 10, r32 = F.lane & 31, hi = F.lane >> 5;
    const bf16* P = (const bf16*)(F.ws + WS_PROJ); bf16* O = (bf16*)(F.ws + WS_O);
    const int t = 512 * blk + r16 + 16 * r32, tg = b * SEQ + t;
    bf16x8v qf[4]; load_q(P + (size_t)tg * NP + C_BQ + 64 * h, hi, qf);
    SoftSt st; soft_init(st);
    bf16x8v kf[4], vf[4];
#pragma unroll 1
    for (int gi = 0; gi < 3; ++gi) {
        int sidk, tile0, ntile, qi, tbase;
        if (gi == 0)      { sidk = 4 + h;  qi = t;      const int lo = 16 * blk - 4;  tile0 = lo < 0 ? 0 : lo; ntile = 16 * blk + 15 - tile0 + 1; tbase = 0; }
        else if (gi == 1) { sidk = 8 + h;  qi = t >> 2; const int lo = 4 * blk - 4;   tile0 = lo < 0 ? 0 : lo; ntile = 4 * blk + 3 - tile0 + 1;   tbase = (r16 & 3) * 64; }
        else              { sidk = 12 + h; qi = t >> 4; const int lo = blk - 4;       tile0 = lo < 0 ? 0 : lo; ntile = blk - tile0 + 1;           tbase = r16 * 16; }
        for (int ti = 0; ti < ntile; ++ti) {
            const int tl = tile0 + ti;
            load_tile(stream_tile(F, sidk, b, tbase + tl), stream_tile(F, sidk + 12, b, tbase + tl), F.lane, kf, vf);
            f32x16 s = qk_tile(kf, qf);
#pragma unroll
            for (int r = 0; r < 16; ++r) { const int kk = 32 * tl + CROW(r, hi); const int df = qi - kk; s[r] = (df >= 0 && df <= 128) ? s[r] * QK_C : -INFINITY; }
            soft_pv(st, s, vf);
        }
    }
    const float lt = half_sum(st.l);
    store_ot(O + (size_t)tg * 1024 + 256 + 64 * h, st.o0, st.o1, 1.0f / lt, hi);
}

__device__ __forceinline__ int pack_tok(int mode, int tile, int i) {
    if (mode == 0) return 32 * tile + i;
    if (mode == 1) return (tile >> 6) + 4 * (32 * (tile & 63) + i);
    return (tile >> 4) + 16 * (32 * (tile & 15) + i);
}
__device__ __forceinline__ void phase_pack(Frame& F, const float* fox_b) {
    const bf16* P = (const bf16*)(F.ws + WS_PROJ);
    LAS unsigned char* vs = F.lds + 73728 + F.wave * 4608;
    for (int it = F.gw; it < 44 * 512; it += F.NGW) {
        const int sid = it >> 9, b = (it >> 8) & 1, tile = it & 255;
        int col, isv, mode;
        if (sid < 4) { col = (sid == 0) ? C_KSL : (sid == 1) ? C_VSL : (sid == 2) ? C_KW : C_VW; isv = sid & 1; mode = 0; }
        else if (sid < 16) { col = C_BK + 64 * (sid & 3); isv = 0; mode = (sid - 4) >> 2; }
        else if (sid < 28) { col = C_BV + 64 * (sid & 3); isv = 1; mode = (sid - 16) >> 2; }
        else if (sid < 32) { col = C_CK + 64 * (sid & 3); isv = 0; mode = 0; }
        else if (sid < 36) { col = C_CV + 64 * (sid & 3); isv = 1; mode = 0; }
        else if (sid < 40) { col = C_DK + 64 * (sid & 3); isv = 0; mode = 0; }
        else { col = C_DV + 64 * (sid & 3); isv = 1; mode = 0; }
        char* dst = (char*)(F.ws + WS_TILED) + (size_t)sid * (2 * MiB) + (size_t)b * MiB + (size_t)tile * 4096;
        if (!isv) {
            const int r32 = F.lane & 31, hi = F.lane >> 5; const bf16* src = P + (size_t)(b * SEQ + pack_tok(mode, tile, r32)) * NP + col + 8 * hi;
#pragma unroll
            for (int d0 = 0; d0 < 4; ++d0) *(v4u*)(dst + d0 * 1024 + F.lane * 16) = *(const v4u*)(src + 16 * d0);
        } else {
            const int key = F.lane >> 1, half = F.lane & 1; const bf16* src = P + (size_t)(b * SEQ + pack_tok(mode, tile, key)) * NP + col + 32 * half;
#pragma unroll
            for (int i = 0; i < 4; ++i) *(LAS v4u*)(vs + key * 144 + half * 64 + i * 16) = *(const v4u*)(src + 8 * i);
            LDS_WAIT(); asm volatile("" ::: "memory");
            const int r32 = F.lane & 31, hi = F.lane >> 5;
#pragma unroll
            for (int f = 0; f < 4; ++f) { const int db = f >> 1, s2 = f & 1; v4u w;
#pragma unroll
                for (int k = 0; k < 4; ++k) { const int j0 = 2 * k, j1 = 2 * k + 1;
                    const int k0 = 16 * s2 + 8 * (j0 >> 2) + 4 * hi + (j0 & 3), k1 = 16 * s2 + 8 * (j1 >> 2) + 4 * hi + (j1 & 3);
                    const unsigned e0 = *(const LAS unsigned short*)(vs + k0 * 144 + (32 * db + r32) * 2), e1 = *(const LAS unsigned short*)(vs + k1 * 144 + (32 * db + r32) * 2);
                    w[k] = e0 | (e1 << 16); }
                *(v4u*)(dst + f * 1024 + F.lane * 16) = w; }
            LDS_WAIT(); asm volatile("" ::: "memory");
        }
    }
    {
        float* LCo = (float*)(F.ws + WS_LC); float* TCo = (float*)(F.ws + WS_TC);
        for (int it = F.gw; it < 2 * 256; it += F.NGW) {
            const int b = it >> 8, ch = it & 255, i = F.lane & 31;
            const bf16* prow = P + (size_t)(b * SEQ + 32 * ch + i) * NP + C_DF;
#pragma unroll
            for (int h = 0; h < 4; ++h) {
                float v = log_sigmoid(bf2f(prow[h]) + fox_b[h]) * LOG2E;
                float acc = v;
#pragma unroll
                for (int sft = 1; sft < 32; sft <<= 1) { const float o = __shfl_up(acc, sft, 32); if (i >= sft) acc += o; }
                if (F.lane < 32) { LCo[((size_t)b * 4 + h) * SEQ + 32 * ch + i] = acc; if (i == 31) TCo[((size_t)b * 4 + h) * 256 + ch] = acc; }
            }
        }
    }
}

__device__ __forceinline__ void phase_attention(Frame& F, const float* fox_b, const float* qk_gain) {
    for (int it = F.gw; it < 1024 + 3 * 2048; it += F.NGW) {
        if (it < 1024) attn_nsa_item(F, it);
        else if (it < 1024 + 2048) attn_fox_unit(F, it - 1024, qk_gain + 7 * 64);
        else if (it < 1024 + 4096) attn_dil_unit(F, it - 1024 - 2048);
        else attn_sb_unit(F, it - 1024 - 4096);
    }
}

__device__ __forceinline__ void phase_combine(Frame& F, float* out, const float* gate) {
    const bf16* Y = (const bf16*)(F.ws + WS_Y); const int* info = (const int*)(F.ws + WS_TOKINFO);
    int pre[8]; { int p = 0;
#pragma unroll
        for (int e = 0; e < 8; ++e) { int n = (int)__hip_atomic_load(F.ctl + CW_MOECNT + 64 * e, RLX_AGENT); if (n > 16384) n = 16384; pre[e] = p; p += (n + 255) >> 8; } }
    for (int m = F.gw; m < M; m += F.NGW) {
        const int b = m >> 13; const int* ip = info + (size_t)m * 8;
        const int e0 = ip[0], r0 = ip[1], e1 = ip[4], r1 = ip[5]; const float g0 = __int_as_float(ip[2]), g1 = __int_as_float(ip[6]);
        int p0 = 0, p1 = 0;
#pragma unroll
        for (int e = 0; e < 8; ++e) { if (e == e0) p0 = pre[e]; if (e == e1) p1 = pre[e]; }
        const bf16* y0 = Y + ((size_t)p0 * 256 + r0) * 1024; const bf16* y1 = Y + ((size_t)p1 * 256 + r1) * 1024;
#pragma unroll
        for (int j = 0; j < 4; ++j) { const int c = 4 * F.lane + 256 * j;
            const uint2 a0 = *(const uint2*)(y0 + c), a1 = *(const uint2*)(y1 + c); const f32x4 gv = *(const f32x4*)(gate + (size_t)b * 6144 + c); f32x4 xv = *(const f32x4*)(out + (size_t)m * D + c);
            xv.x += gv.x * (g0 * __uint_as_float(a0.x << 16) + g1 * __uint_as_float(a1.x << 16));
            xv.y += gv.y * (g0 * __uint_as_float(a0.x & 0xffff0000u) + g1 * __uint_as_float(a1.x & 0xffff0000u));
            xv.z += gv.z * (g0 * __uint_as_float(a0.y << 16) + g1 * __uint_as_float(a1.y << 16));
            xv.w += gv.w * (g0 * __uint_as_float(a0.y & 0xffff0000u) + g1 * __uint_as_float(a1.y & 0xffff0000u));
            *(f32x4*)(out + (size_t)m * D + c) = xv; }
    }
}

constexpr int PH_PER_LAYER = 11, N_PHASES = 1 + 2 * PH_PER_LAYER;
extern __shared__ __attribute__((aligned(16))) unsigned char lds_dyn[];
#define SITE_PROLOGUE() Frame F; ArgsP ap = (ArgsP)__builtin_amdgcn_kernarg_segment_ptr(); asm volatile("" : "+s"(ap)); l = __builtin_amdgcn_readfirstlane(l); \
    F.lds = (LAS unsigned char*)lds_dyn; F.lane = lane_id_fresh(); F.wave = wave0; F.tid = F.wave * 64 + F.lane; \
    F.G = gridDim.x; F.gw = blockIdx.x * NWAVES + F.wave; F.NGW = F.G * NWAVES; F.ws = ap->ws; F.ctl = (gu32*)(F.ws + WS_CTL); \
    float* const out = ap->out; const float* const modl = (const float*)(F.ws + WS_MOD) + (size_t)l * 2 * 6144; (void)out; (void)modl
static __device__ __forceinline__ void site_prologue(int l, int wave0) { SITE_PROLOGUE(); phase_prologue(F, ap); }
static __device__ __forceinline__ void site_norm_mix(int l, int wave0) { SITE_PROLOGUE(); const float* xin = (l == 0) ? (const float*)ap->in[0] : (const float*)out;
    phase_norm<false>(F, xin, (const float*)ap->in[5] + l * 1024, modl + 0, modl + 1024, nullptr); }
static __device__ __forceinline__ void site_gemm_in(int l, int wave0) { SITE_PROLOGUE();
    pg8::Gemm g{(const bf16*)(F.ws + WS_H), (const bf16*)(F.ws + WS_WIN) + (size_t)l * NP * 1024, 1024, 1024}; pg8::StaticOrder S; S.init(M, NP, F.G, (int)blockIdx.x);
    pg8::EpiStore E{(bf16*)(F.ws + WS_PROJ), NP};
    pg8::gemm_phase<pg8::EpiStore, pg8::StaticOrder, true, false>(F.lds, g, S, E, F.tid); }
static __device__ __forceinline__ void site_qknorm(int l, int wave0) { SITE_PROLOGUE(); phase_qknorm(F, (const float*)ap->in[8] + l * 512); }
static __device__ __forceinline__ void site_compress(int l, int wave0) { SITE_PROLOGUE(); phase_compress(F, (const float*)ap->in[9] + l * 2048, (const float*)ap->in[10] + l * 2048, (const float*)ap->in[11] + (size_t)l * 2048 * 128, (const float*)ap->in[12] + l * 128 * 64,
                                       (const float*)ap->in[13] + (size_t)l * 2048 * 128, (const float*)ap->in[14] + l * 128 * 64);
    phase_pack(F, (const float*)ap->in[15] + l * 4); }
static __device__ __forceinline__ void site_attention(int l, int wave0) { SITE_PROLOGUE(); phase_attention(F, (const float*)ap->in[15] + l * 4, (const float*)ap->in[8] + l * 512); }
static __device__ __forceinline__ void site_gemm_branch(int l, int wave0) { SITE_PROLOGUE();
    pg8::Gemm g{(const bf16*)(F.ws + WS_O), (const bf16*)(F.ws + WS_WBR) + (size_t)l * 4 * 1024 * 256, 1024, 256}; pg8::BranchOrder S; S.init(M, 1024, F.G, (int)blockIdx.x);
    pg8::EpiGate E{(const bf16*)(F.ws + WS_PROJ), NP, C_MG, (float*)(F.ws + WS_GACC), (bf16*)(F.ws + WS_H)};
    pg8::gemm_phase<pg8::EpiGate, pg8::BranchOrder, false, false>(F.lds, g, S, E, F.tid); }
static __device__ __forceinline__ void site_gemm_out(int l, int wave0) { SITE_PROLOGUE(); const float* xin = (l == 0) ? (const float*)ap->in[0] : (const float*)out;
    pg8::Gemm g{(const bf16*)(F.ws + WS_H), (const bf16*)(F.ws + WS_WOUT) + (size_t)l * 1024 * 1024, 1024, 1024}; pg8::StaticOrder S; S.init(M, 1024, F.G, (int)blockIdx.x);
    pg8::EpiResid E{xin, out, modl + 2048, 6144};
    pg8::gemm_phase<pg8::EpiResid, pg8::StaticOrder, false, false>(F.lds, g, S, E, F.tid); }
static __device__ __forceinline__ void site_norm_ffn(int l, int wave0) { SITE_PROLOGUE();
    if (l == 0) phase_norm<false>(F, out, (const float*)ap->in[6] + l * 1024, modl + 3 * 1024, modl + 4 * 1024, nullptr);
    else { phase_norm<true>(F, out, (const float*)ap->in[6] + l * 1024, modl + 3 * 1024, modl + 4 * 1024, (const float*)ap->in[21]); phase_moe_weights(F, ap); } }
static __device__ __forceinline__ void site_gemm_up_dense(int l, int wave0) { SITE_PROLOGUE();
    pg8::Gemm g{(const bf16*)(F.ws + WS_H), (const bf16*)(F.ws + WS_W13), 1024, 1024}; pg8::StaticOrder S; S.init(M, 2 * DFF, F.G, (int)blockIdx.x);
    pg8::EpiSwiglu E{(bf16*)(F.ws + WS_HMID), DFF};
    pg8::gemm_phase<pg8::EpiSwiglu, pg8::StaticOrder, true, false>(F.lds, g, S, E, F.tid); }
static __device__ __forceinline__ void site_gemm_up_moe(int l, int wave0) { SITE_PROLOGUE();
    pg8::Gemm g{(const bf16*)(F.ws + WS_H), (const bf16*)(F.ws + WS_MOEW13), 1024, 1024}; pg8::MoeOrder S; S.init((unsigned*)(F.ctl + CW_MOECNT), (const int*)(F.ws + WS_LIST), 2 * DFF / 256, (size_t)2 * DFF * 1024, F.G, (int)blockIdx.x);
    pg8::EpiSwiglu E{(bf16*)(F.ws + WS_HMID_MOE), DFF};
    pg8::gemm_phase<pg8::EpiSwiglu, pg8::MoeOrder, true, true>(F.lds, g, S, E, F.tid); }
static __device__ __forceinline__ void site_gemm_down_dense(int l, int wave0) { SITE_PROLOGUE();
    pg8::Gemm g{(const bf16*)(F.ws + WS_HMID), (const bf16*)(F.ws + WS_W2), DFF, DFF}; pg8::StaticOrder S; S.init(M, 1024, F.G, (int)blockIdx.x);
    pg8::EpiResid E{out, out, modl + 5 * 1024, 6144};
    pg8::gemm_phase<pg8::EpiResid, pg8::StaticOrder, false, false>(F.lds, g, S, E, F.tid); }
static __device__ __forceinline__ void site_gemm_down_moe(int l, int wave0) { SITE_PROLOGUE();
    pg8::Gemm g{(const bf16*)(F.ws + WS_HMID_MOE), (const bf16*)(F.ws + WS_MOEW2), DFF, DFF}; pg8::MoeOrder S; S.init((unsigned*)(F.ctl + CW_MOECNT), (const int*)(F.ws + WS_LIST), 4, (size_t)1024 * DFF, F.G, (int)blockIdx.x);
    pg8::EpiStore E{(bf16*)(F.ws + WS_Y), 1024};
    pg8::gemm_phase<pg8::EpiStore, pg8::MoeOrder, true, false>(F.lds, g, S, E, F.tid); }
static __device__ __forceinline__ void site_combine(int l, int wave0) { SITE_PROLOGUE(); phase_combine(F, out, modl + 5 * 1024); }

__global__ void __launch_bounds__(NWAVES * 64, 2) fwd_kernel(Args args_unused) {
    (void)args_unused;
    const ArgsP ap0 = (ArgsP)__builtin_amdgcn_kernarg_segment_ptr();
    const int wave0 = __builtin_amdgcn_readfirstlane((int)threadIdx.x >> 6);
    LAS unsigned char* lds = (LAS unsigned char*)lds_dyn;
    volatile LAS unsigned* MISC = (volatile LAS unsigned*)(lds + MISC_OFF);
    for (int u = wave0 * 64 + lane_id_fresh(); u < (LDS_BYTES - RING_BYTES) / 4; u += NWAVES * 64) ((LAS unsigned*)(lds + RING_BYTES))[u] = 0u;
    __syncthreads();
    const int lo = ap0->ph_lo, hi = ap0->ph_hi;
    unsigned* barw = (unsigned*)(ap0->ws + WS_CTL) + CW_BAR;
    XcdBarrier bar; bar.bar = barw; bar.x = 0; bar.st = nullptr;
#define LEADER() (wave0 == 0 && lane_id_fresh() == 0)
    if (hi - lo > 1) bar = xcd_barrier_post(barw, MISC + 8, LEADER());
#define IN(k) (lo <= (k) && (k) < hi)
#define SEAM(k) do { if (IN(k) && IN((k) + 1)) xcd_barrier(bar, LEADER()); } while (0)
    if (PHON(0) && IN(0)) site_prologue(0, wave0);
    SEAM(0);
    for (int l = 0; l < 2; ++l) {
        const int pb = 1 + l * PH_PER_LAYER;
        if (PHON(1) && IN(pb + 0)) site_norm_mix(l, wave0);
        SEAM(pb + 0);
        if (PHON(2) && IN(pb + 1)) site_gemm_in(l, wave0);
        SEAM(pb + 1);
        if (PHON(3) && IN(pb + 2)) site_qknorm(l, wave0);
        SEAM(pb + 2);
        if (PHON(4) && IN(pb + 3)) site_compress(l, wave0);
        SEAM(pb + 3);
        if (PHON(5) && IN(pb + 4)) site_attention(l, wave0);
        SEAM(pb + 4);
        if (PHON(6) && IN(pb + 5)) site_gemm_branch(l, wave0);
        SEAM(pb + 5);
        if (PHON(7) && IN(pb + 6)) site_gemm_out(l, wave0);
        SEAM(pb + 6);
        if (PHON(8) && IN(pb + 7)) site_norm_ffn(l, wave0);
        SEAM(pb + 7);
        if (PHON(9) && IN(pb + 8)) { if (l == 0) site_gemm_up_dense(l, wave0); else site_gemm_up_moe(l, wave0); }
        SEAM(pb + 8);
        if (PHON(10) && IN(pb + 9)) { if (l == 0) site_gemm_down_dense(l, wave0); else site_gemm_down_moe(l, wave0); }
        SEAM(pb + 9);
        if (PHON(11) && IN(pb + 10)) { if (l == 1) site_combine(l, wave0); }
    }
#undef IN
#undef SEAM
}

extern "C" void kernel_launch(void* const* d_in, const int* in_sizes, int n_in, void* d_out, int out_size, void* d_ws, size_t ws_size, hipStream_t stream) {
    static int grid = 0;
    if (grid == 0) {
        if (n_in != 25 || out_size != M * D || ws_size < WS_END + 16 * MiB) { fprintf(stderr, "kernel_launch: unexpected problem (n_in %d, out %d, ws %zu < %zu)\n", n_in, out_size, ws_size, (size_t)WS_END); grid = -1; return; }
        int dev = 0, cus = 0, per_cu = 0;
        if (hipGetDevice(&dev) != hipSuccess || hipDeviceGetAttribute(&cus, hipDeviceAttributeMultiprocessorCount, dev) != hipSuccess) { grid = -1; return; }
        if (hipFuncSetAttribute((const void*)fwd_kernel, hipFuncAttributeMaxDynamicSharedMemorySize, LDS_BYTES) != hipSuccess) { fprintf(stderr, "kernel_launch: hipFuncSetAttribute failed\n"); grid = -1; return; }
        if (hipOccupancyMaxActiveBlocksPerMultiprocessor(&per_cu, (const void*)fwd_kernel, NWAVES * 64, LDS_BYTES) != hipSuccess || per_cu < 1) fprintf(stderr, "kernel_launch: occupancy query reports %d\n", per_cu);
        (void)hipGetLastError();
        grid = cus;
    }
    if (grid < 0) return;
    if (hipMemsetAsync((char*)d_ws + WS_CTL, 0, CTL_ZERO_BYTES, stream) != hipSuccess) return;
    Args a{};
    for (int i = 0; i < 25; ++i) a.in[i] = d_in[i];
    a.out = (float*)d_out; a.ws = (unsigned char*)d_ws;
#if MK_ONE_LAUNCH
    a.ph_lo = 0; a.ph_hi = N_PHASES;
    hipLaunchKernelGGL(fwd_kernel, dim3(grid), dim3(NWAVES * 64), LDS_BYTES, stream, a);
#else
    for (int p = 0; p < N_PHASES; ++p) {
        if (p == 1 + 10) continue;
        a.ph_lo = p; a.ph_hi = p + 1;
        hipLaunchKernelGGL(fwd_kernel, dim3(grid), dim3(NWAVES * 64), LDS_BYTES, stream, a);
    }
#endif
}
```

```cpp
#include <hip/hip_runtime.h>
#include <cstdio>
#include <cstdint>

#ifndef MK_ONE_LAUNCH
#define MK_ONE_LAUNCH 1
#endif
#ifndef PHMASK
#define PHMASK 0xFFFFu
#endif
#define PHON(k) (((PHMASK) >> (k)) & 1u)

namespace pg8 {
#define PG8_LAS __attribute__((address_space(3)))
typedef unsigned short bf16_t;
typedef short bf16x8 __attribute__((ext_vector_type(8)));
typedef float f32x4 __attribute__((ext_vector_type(4)));
typedef unsigned u32x4 __attribute__((ext_vector_type(4)));
constexpr int BM = 256, BK = 64, HALF = 128, HTB = HALF * BK * 2, STAGE_BYTES = 8 * HTB, NXCD = 8, WGM = 8;

__host__ __device__ __forceinline__ int lds_byte(int r, int c) { const int st = (r >> 4) * 2 + (c >> 5), rr = r & 15, cc = c & 31, ob = rr * 64 + cc * 2; return st * 1024 + (ob ^ (((ob >> 9) & 1) << 5)); }
__host__ __device__ __forceinline__ void stage_rc(int b, int& R, int& C) { const int st = b / 1024, sb = b % 1024, swz = sb ^ (((sb >> 9) & 1) << 5); R = (st >> 1) * 16 + swz / 64; C = (st & 1) * 32 + (swz % 64) / 2; }
__host__ __device__ __forceinline__ int perm32(int rho) { const int n = rho >> 4, i = rho & 15; return 8 * (i >> 2) + 4 * n + (i & 3); }

struct Unit { int pm, pn, z; };
struct Gemm { const bf16_t* A; const bf16_t* Bt; int lda; int K; };

__host__ __device__ __forceinline__ void tile_pmpn(int wgid, int nM, int nN, int& pm, int& pn) {
    const int nwg = nM * nN;
    { const int q = nwg / NXCD, r = nwg % NXCD, xcd = wgid % NXCD, off = wgid / NXCD; wgid = (xcd < r ? xcd * (q + 1) : r * (q + 1) + (xcd - r) * q) + off; }
    const int nig = WGM * nN, gid = wgid / nig, fm = gid * WGM, gsz = (nM - fm) < WGM ? (nM - fm) : WGM;
    pm = fm + ((wgid % nig) % gsz); pn = (wgid % nig) / gsz;
}
struct StaticOrder {
    int nM, nN, nwg, G, c;
    __device__ void init(int M, int N, int G_, int c_) { nM = M / BM; nN = N / BM; nwg = nM * nN; G = G_; c = c_; }
    __device__ bool next(int i, Unit& u) const { const long L = (long)i * G + c; if (L >= nwg) return false; tile_pmpn((int)L, nM, nN, u.pm, u.pn); u.z = 0; return true; }
    __device__ const char* a_base(const Gemm& g, const Unit& u) const { return (const char*)g.A + (size_t)u.pm * BM * g.lda * 2; }
    __device__ const char* b_base(const Gemm& g, const Unit& u) const { return (const char*)g.Bt + (size_t)u.pn * BM * g.K * 2; }
    __device__ int row_tok(const Unit&, int) const { return 0; }
};
struct BranchOrder {
    int nM, nN, nwg, G, c;
    __device__ void init(int M, int N, int G_, int c_) { nM = M / BM; nN = N / BM; nwg = nM * nN; G = G_; c = c_; }
    __device__ bool next(int i, Unit& u) const { const long L = (long)(i >> 2) * G + c; if (L >= nwg) return false; tile_pmpn((int)L, nM, nN, u.pm, u.pn); u.z = i & 3; return true; }
    __device__ const char* a_base(const Gemm& g, const Unit& u) const { return (const char*)g.A + ((size_t)u.pm * BM * g.lda + (size_t)u.z * 256) * 2; }
    __device__ const char* b_base(const Gemm& g, const Unit& u) const { return (const char*)g.Bt + ((size_t)u.z * 1024 * 256 + (size_t)u.pn * BM * g.K) * 2; }
    __device__ int row_tok(const Unit&, int) const { return 0; }
};
struct MoeOrder {
    int G, c, nN; int pre[9]; const int* list; int cnt[8]; size_t zstrideB;
    __device__ void init(unsigned* counts, const int* list_, int nN_, size_t zstrideB_, int G_, int c_) {
        G = G_; c = c_; nN = nN_; list = list_; zstrideB = zstrideB_; int p = 0;
#pragma unroll
        for (int e = 0; e < 8; ++e) { int n = __builtin_amdgcn_readfirstlane((int)__hip_atomic_load(counts + 64 * e, __ATOMIC_RELAXED, __HIP_MEMORY_SCOPE_AGENT)); if (n > 16384) n = 16384; cnt[e] = n; pre[e] = p; p += (n + 255) >> 8; }
        pre[8] = p;
    }
    __device__ bool next(int i, Unit& u) const {
        const long L = (long)i * G + c; if (L >= (long)pre[8] * nN) return false;
        const int rt = (int)(L / nN); u.pn = (int)(L % nN); u.pm = rt; int e = 0;
#pragma unroll
        for (int k = 1; k < 8; ++k) e += (rt >= pre[k]) ? 1 : 0;
        u.z = e; return true;
    }
    __device__ const char* a_base(const Gemm& g, const Unit& u) const { return (const char*)g.A + (size_t)u.pm * BM * g.lda * 2; }
    __device__ const char* b_base(const Gemm& g, const Unit& u) const { return (const char*)g.Bt + ((size_t)u.z * zstrideB + (size_t)u.pn * BM * g.K) * 2; }
    __device__ int row_tok(const Unit& u, int r) const {
        int e = 0, c0 = 0, p0 = 0;
#pragma unroll
        for (int k = 0; k < 8; ++k) if (k == u.z) { c0 = cnt[k]; p0 = pre[k]; }
        const int idx = (u.pm - p0) * 256 + r; (void)e;
        return idx < c0 ? list[u.z * 16384 + idx] : 0;
    }
};

__device__ __forceinline__ int lane_id_fresh_pg8() { int l; asm volatile("v_mbcnt_lo_u32_b32 %0, -1, 0\n\tv_mbcnt_hi_u32_b32 %0, -1, %0" : "=v"(l)); return l; }
__device__ __forceinline__ unsigned cvt_pk_bf16(float lo, float hi) { unsigned r; asm volatile("v_cvt_pk_bf16_f32 %0, %1, %2" : "=v"(r) : "v"(lo), "v"(hi)); return r; }

struct EpiStore {
    static constexpr bool PERM = true;
    bf16_t* O; int ldc;
    __device__ __forceinline__ void operator()(const f32x4 (&acc)[2][2][4][2], const Unit& u, int wr, int wc, int fr, int fq) const {
        const unsigned base = ((unsigned)(u.pm * BM + wr * 64 + fr) * (unsigned)ldc + (unsigned)(u.pn * BM + wc * 32 + 8 * fq)) * 2u;
        char* Ob = (char*)O;
#pragma unroll
        for (int ai = 0; ai < 2; ++ai)
#pragma unroll
            for (int m = 0; m < 4; ++m) { const unsigned off = base + (unsigned)((ai * HALF + m * 16) * 2) * (unsigned)ldc;
#pragma unroll
                for (int bj = 0; bj < 2; ++bj) { const f32x4 v0 = acc[ai][bj][m][0], v1 = acc[ai][bj][m][1];
                    u32x4 w; w.x = cvt_pk_bf16(v0[0], v0[1]); w.y = cvt_pk_bf16(v0[2], v0[3]); w.z = cvt_pk_bf16(v1[0], v1[1]); w.w = cvt_pk_bf16(v1[2], v1[3]);
                    *(u32x4*)(Ob + (off + (unsigned)(bj * HALF * 2))) = w; } }
    }
};
__device__ __forceinline__ float silu_f(float a) { return a * __builtin_amdgcn_rcpf(1.0f + __expf(-a)); }
struct EpiSwiglu {
    static constexpr bool PERM = true;
    bf16_t* O; int ldc;
    __device__ __forceinline__ void operator()(const f32x4 (&acc)[2][2][4][2], const Unit& u, int wr, int wc, int fr, int fq) const {
        const unsigned base = ((unsigned)(u.pm * BM + wr * 64 + fr) * (unsigned)ldc + (unsigned)(u.pn * HALF + wc * 32 + 8 * fq)) * 2u;
        char* Ob = (char*)O;
#pragma unroll
        for (int ai = 0; ai < 2; ++ai)
#pragma unroll
            for (int m = 0; m < 4; ++m) { const unsigned off = base + (unsigned)((ai * HALF + m * 16) * 2) * (unsigned)ldc;
                float h[8];
#pragma unroll
                for (int n = 0; n < 2; ++n)
#pragma unroll
                    for (int j = 0; j < 4; ++j) h[n * 4 + j] = silu_f(acc[ai][0][m][n][j]) * acc[ai][1][m][n][j];
                u32x4 w; w.x = cvt_pk_bf16(h[0], h[1]); w.y = cvt_pk_bf16(h[2], h[3]); w.z = cvt_pk_bf16(h[4], h[5]); w.w = cvt_pk_bf16(h[6], h[7]);
                *(u32x4*)(Ob + off) = w; }
    }
};
struct EpiResid {
    static constexpr bool PERM = false;
    const float* xin; float* out; const float* gate; int gate_bstride;
    __device__ __forceinline__ void operator()(const f32x4 (&acc)[2][2][4][2], const Unit& u, int wr, int wc, int fr, int fq) const {
        const int b = (u.pm * BM) >> 13; const int col0 = u.pn * BM + wc * 32 + 4 * fq;
        f32x4 gv[2][2];
#pragma unroll
        for (int bj = 0; bj < 2; ++bj)
#pragma unroll
            for (int n = 0; n < 2; ++n) gv[bj][n] = *(const f32x4*)(gate + (size_t)b * gate_bstride + col0 + bj * HALF + n * 16);
        const unsigned base = ((unsigned)(u.pm * BM + wr * 64 + fr) * 1024u + (unsigned)col0) * 4u;
        const char* xb = (const char*)xin; char* ob = (char*)out;
#pragma unroll
        for (int ai = 0; ai < 2; ++ai)
#pragma unroll
            for (int m = 0; m < 4; ++m) { const unsigned off = base + (unsigned)((ai * HALF + m * 16) * 4096);
#pragma unroll
                for (int bj = 0; bj < 2; ++bj)
#pragma unroll
                    for (int n = 0; n < 2; ++n) { const unsigned o2 = off + (unsigned)((bj * HALF + n * 16) * 4); const f32x4 xi = *(const f32x4*)(xb + o2); *(f32x4*)(ob + o2) = xi + gv[bj][n] * acc[ai][bj][m][n]; }
                if (m & 1) asm volatile("" ::: "memory"); }
    }
};
__device__ __forceinline__ float sigmoid_f(float a) { return __builtin_amdgcn_rcpf(1.0f + __expf(-a)); }
struct EpiGate {
    static constexpr bool PERM = true;
    const bf16_t* proj; int ldp; int cmg; float* G; bf16_t* gated;
    __device__ __forceinline__ void operator()(const f32x4 (&acc)[2][2][4][2], const Unit& u, int wr, int wc, int fr, int fq) const {
        const unsigned row0 = (unsigned)(u.pm * BM + wr * 64 + fr), col0 = (unsigned)(u.pn * BM + wc * 32 + 8 * fq);
        const unsigned pbase = (row0 * (unsigned)ldp + (unsigned)(cmg + u.z * 1024) + col0) * 2u, gbase = (row0 * 1024u + col0) * 4u;
        const char* pb = (const char*)proj; char* gb = (char*)G; char* ob = (char*)gated;
#pragma unroll
        for (int ai = 0; ai < 2; ++ai)
#pragma unroll
            for (int m = 0; m < 4; ++m) { const unsigned rr = (unsigned)(ai * HALF + m * 16);
#pragma unroll
                for (int bj = 0; bj < 2; ++bj) {
                    const u32x4 mg = *(const u32x4*)(pb + (pbase + rr * (unsigned)(ldp * 2) + (unsigned)(bj * HALF * 2)));
                    const unsigned go = gbase + rr * 4096u + (unsigned)(bj * HALF * 4);
                    float v[8];
#pragma unroll
                    for (int k = 0; k < 4; ++k) { const unsigned w = mg[k]; const float l0 = __uint_as_float(w << 16), l1 = __uint_as_float(w & 0xffff0000u);
                        v[2 * k] = sigmoid_f(l0) * acc[ai][bj][m][k >> 1][(2 * k) & 3]; v[2 * k + 1] = sigmoid_f(l1) * acc[ai][bj][m][k >> 1][(2 * k + 1) & 3]; }
                    if (u.z != 0) { const f32x4 g0 = *(const f32x4*)(gb + go), g1 = *(const f32x4*)(gb + go + 16);
#pragma unroll
                        for (int k = 0; k < 4; ++k) { v[k] += g0[k]; v[4 + k] += g1[k]; } }
                    if (u.z != 3) { *(f32x4*)(gb + go) = (f32x4){v[0], v[1], v[2], v[3]}; *(f32x4*)(gb + go + 16) = (f32x4){v[4], v[5], v[6], v[7]}; }
                    else { u32x4 w; w.x = cvt_pk_bf16(v[0], v[1]); w.y = cvt_pk_bf16(v[2], v[3]); w.z = cvt_pk_bf16(v[4], v[5]); w.w = cvt_pk_bf16(v[6], v[7]); *(u32x4*)(ob + (go >> 1)) = w; } }
                asm volatile("" ::: "memory"); }
    }
};

template <class Epi, class Sched, bool ALIGN_EPI, bool GATHER>
__device__ __forceinline__ void gemm_phase(PG8_LAS unsigned char* lds, const Gemm g, const Sched& S, const Epi& E, int tid) {
    asm volatile("" : "+v"(tid));
    const int wid = __builtin_amdgcn_readfirstlane(tid >> 6), lane = tid & 63, wr = wid >> 2, wc = wid & 3, fr = lane & 15, fq = lane >> 4;
    int K = g.K; asm volatile("" : "+s"(K));
    const int nt = K / BK;
    unsigned voffA[2], voffB[2]; int RA[2], CA[2];
#pragma unroll
    for (int i = 0; i < 2; ++i) { int R, C; stage_rc(tid * 16 + i * 8192, R, C); const int Rb = Epi::PERM ? ((R & ~31) + perm32(R & 31)) : R;
        RA[i] = R; CA[i] = C; voffA[i] = (unsigned)(R * g.lda + C) * 2u; voffB[i] = (unsigned)(Rb * K + C) * 2u; }
    const size_t kstep = (size_t)(BK * 2);
    const size_t hstepA = (size_t)HALF * g.lda * 2, hstepB = (size_t)HALF * K * 2;
    const unsigned ldsw = (unsigned)wid * 1024u;
    const int aoff = lds_byte(wr * 64 + fr, fq * 8), boff = lds_byte(wc * 32 + fr, fq * 8);
#define PG8_SA(b, h) (((b) * 2 + (h)) * HTB)
#define PG8_SB(b, h) ((4 + (b) * 2 + (h)) * HTB)
#define PG8_STAGE(bufoff, gbase, voff) do { _Pragma("unroll") for (int _i = 0; _i < 2; ++_i) \
        __builtin_amdgcn_global_load_lds((const unsigned*)((const char*)(gbase) + (voff)[_i]), (PG8_LAS unsigned*)(lds + (bufoff) + ldsw + _i * 8192), 16, 0, 0); } while (0)
#define PG8_STAGE_A(bufoff, kbase, h, GV) do { if constexpr (GATHER) { PG8_STAGE(bufoff, kbase, (GV)[h]); } else { PG8_STAGE(bufoff, (kbase) + (h) * hstepA, voffA); } } while (0)
#define PG8_LDA(dst, b, h) do { _Pragma("unroll") for (int m = 0; m < 4; ++m) _Pragma("unroll") for (int k = 0; k < 2; ++k) dst[m][k] = *(const PG8_LAS bf16x8*)(lds + PG8_SA(b, h) + aoff + m * 2048 + k * 1024); } while (0)
#define PG8_LDB(dst, b, h) do { _Pragma("unroll") for (int n = 0; n < 2; ++n) _Pragma("unroll") for (int k = 0; k < 2; ++k) dst[n][k] = *(const PG8_LAS bf16x8*)(lds + PG8_SB(b, h) + boff + n * 2048 + k * 1024); } while (0)
#define PG8_MMA(ai, bj, At, Bt) do { __builtin_amdgcn_s_setprio(1); _Pragma("unroll") for (int m = 0; m < 4; ++m) _Pragma("unroll") for (int n = 0; n < 2; ++n) _Pragma("unroll") for (int k = 0; k < 2; ++k) \
        acc[ai][bj][m][n] = __builtin_amdgcn_mfma_f32_16x16x32_bf16(Bt[n][k], At[m][k], acc[ai][bj][m][n], 0, 0, 0); __builtin_amdgcn_s_setprio(0); } while (0)
#define PG8_WAIT_V(n) asm volatile("s_waitcnt vmcnt(" #n ")" ::: "memory")
#define PG8_WAIT_L(n) asm volatile("s_waitcnt lgkmcnt(" #n ")" ::: "memory")
#define PG8_BAR __builtin_amdgcn_s_barrier()
#define PG8_SCHED __builtin_amdgcn_sched_barrier(0)
#define PG8_GOFFS(dst, un) do { _Pragma("unroll") for (int _h = 0; _h < 2; ++_h) _Pragma("unroll") for (int _i = 0; _i < 2; ++_i) \
        dst[_h][_i] = (unsigned)S.row_tok(un, _h * HALF + RA[_i]) * (unsigned)(g.lda * 2) + (unsigned)(CA[_i] * 2); } while (0)
    Unit cur, nxt; int ui = 0;
    if (!S.next(0, cur)) return;
    f32x4 acc[2][2][4][2];
#pragma unroll
    for (int a = 0; a < 2; ++a)
#pragma unroll
        for (int b = 0; b < 2; ++b)
#pragma unroll
            for (int m = 0; m < 4; ++m)
#pragma unroll
                for (int n = 0; n < 2; ++n) acc[a][b][m][n] = (f32x4){0.f, 0.f, 0.f, 0.f};
    bf16x8 At[4][2], B0[2][2], B1[2][2];
    unsigned gC[2][2] = {{0u, 0u}, {0u, 0u}}, gN[2][2] = {{0u, 0u}, {0u, 0u}};
    const char* cA = GATHER ? (const char*)g.A : S.a_base(g, cur); const char* cB = S.b_base(g, cur);
    if constexpr (GATHER) { PG8_GOFFS(gC, cur); asm volatile("s_waitcnt vmcnt(0)" ::: "memory"); }
    PG8_STAGE(PG8_SB(0, 0), cB, voffB); PG8_STAGE(PG8_SB(0, 1), cB + hstepB, voffB); PG8_STAGE_A(PG8_SA(0, 0), cA, 0, gC); PG8_STAGE_A(PG8_SA(0, 1), cA, 1, gC);
    if (wr == 1) PG8_BAR;
    PG8_WAIT_V(2); PG8_BAR;
    PG8_STAGE(PG8_SB(1, 0), cB + kstep, voffB); PG8_STAGE_A(PG8_SA(1, 0), cA + kstep, 0, gC); PG8_STAGE(PG8_SB(1, 1), cB + hstepB + kstep, voffB);
    PG8_WAIT_V(6); PG8_BAR;
    for (;;) {
        const bool has_next = S.next(ui + 1, nxt);
        const char* nA = GATHER ? (const char*)g.A : (has_next ? S.a_base(g, nxt) : cA); const char* nB = has_next ? S.b_base(g, nxt) : cB;
        if constexpr (GATHER) {
            if (has_next) { PG8_GOFFS(gN, nxt); }
            else {
#pragma unroll
                for (int _h = 0; _h < 2; ++_h)
#pragma unroll
                    for (int _i = 0; _i < 2; ++_i) gN[_h][_i] = gC[_h][_i];
            }
        }
        for (int t = 0; t < nt; t += 2) {
            const bool last = (t == nt - 2);
            const char* a1 = cA + (size_t)(t + 1) * kstep;
            const char* a2 = last ? nA : cA + (size_t)(t + 2) * kstep; const char* b2 = last ? nB : cB + (size_t)(t + 2) * kstep;
            const char* a3 = a2 + kstep; const char* b3 = b2 + kstep;
            unsigned g2[2][2];
            if constexpr (GATHER) {
#pragma unroll
                for (int _h = 0; _h < 2; ++_h)
#pragma unroll
                    for (int _i = 0; _i < 2; ++_i) g2[_h][_i] = last ? gN[_h][_i] : gC[_h][_i];
            }
            PG8_LDB(B0, 0, 0); PG8_LDB(B1, 0, 1); PG8_SCHED; PG8_LDA(At, 0, 0); PG8_STAGE_A(PG8_SA(1, 1), a1, 1, gC);
            PG8_WAIT_V(8); PG8_WAIT_L(0); PG8_BAR; PG8_MMA(0, 0, At, B0); PG8_MMA(0, 1, At, B1); PG8_BAR; PG8_SCHED;
            PG8_LDA(At, 0, 1); PG8_STAGE(PG8_SB(0, 0), b2, voffB); PG8_STAGE(PG8_SB(0, 1), b2 + hstepB, voffB); PG8_STAGE_A(PG8_SA(0, 0), a2, 0, g2);
            PG8_WAIT_V(8); PG8_WAIT_L(0); PG8_BAR; PG8_MMA(1, 0, At, B0); PG8_MMA(1, 1, At, B1); PG8_BAR; PG8_SCHED;
            PG8_LDB(B0, 1, 0); PG8_LDB(B1, 1, 1); PG8_SCHED; PG8_LDA(At, 1, 0); PG8_STAGE_A(PG8_SA(0, 1), a2, 1, g2);
            PG8_WAIT_V(8); PG8_WAIT_L(0); PG8_BAR; PG8_MMA(0, 0, At, B0); PG8_MMA(0, 1, At, B1); PG8_BAR; PG8_SCHED;
            PG8_LDA(At, 1, 1); PG8_STAGE(PG8_SB(1, 0), b3, voffB); PG8_STAGE(PG8_SB(1, 1), b3 + hstepB, voffB); PG8_STAGE_A(PG8_SA(1, 0), a3, 0, g2);
            PG8_WAIT_V(8); PG8_WAIT_L(0); PG8_BAR; PG8_MMA(1, 0, At, B0); PG8_MMA(1, 1, At, B1); PG8_BAR; PG8_SCHED;
        }
        if constexpr (ALIGN_EPI) { if (wr == 0) PG8_BAR; }
        { const int l2_ = lane_id_fresh_pg8();
          E(acc, cur, wr, wc, l2_ & 15, l2_ >> 4); }
        if (!has_next) break;
#pragma unroll
        for (int a = 0; a < 2; ++a)
#pragma unroll
            for (int b = 0; b < 2; ++b)
#pragma unroll
                for (int m = 0; m < 4; ++m)
#pragma unroll
                    for (int n = 0; n < 2; ++n) acc[a][b][m][n] = (f32x4){0.f, 0.f, 0.f, 0.f};
        cur = nxt; cA = nA; cB = nB; ++ui;
        if constexpr (GATHER) {
#pragma unroll
            for (int _h = 0; _h < 2; ++_h)
#pragma unroll
                for (int _i = 0; _i < 2; ++_i) gC[_h][_i] = gN[_h][_i];
        }
        if constexpr (ALIGN_EPI) { if (wr == 1) PG8_BAR; }
    }
    PG8_WAIT_V(0);
    if constexpr (!ALIGN_EPI) { if (wr == 0) PG8_BAR; }
    PG8_BAR;
#undef PG8_SA
#undef PG8_SB
#undef PG8_STAGE
#undef PG8_STAGE_A
#undef PG8_LDA
#undef PG8_LDB
#undef PG8_MMA
#undef PG8_WAIT_V
#undef PG8_WAIT_L
#undef PG8_BAR
#undef PG8_SCHED
#undef PG8_GOFFS
}
}

constexpr int NWAVES = 8;
constexpr int BATCH = 2, SEQ = 8192, D = 1024, M = BATCH * SEQ, NP = 7168, DFF = 2816, NE = 8, INC = 7056;
constexpr int MROWS_MOE = 2 * M + 2048;
constexpr int C_NSAQ = 0, C_KC = 256, C_VC = 320, C_KSL = 384, C_VSL = 448, C_KW = 512, C_VW = 576, C_AG = 640, C_DF = 652,
              C_BQ = 768, C_BK = 1024, C_BV = 1280, C_CQ = 1536, C_CK = 1792, C_CV = 2048, C_DQ = 2304, C_DK = 2560, C_DV = 2816, C_MG = 3072;
constexpr float EPS = 1e-6f;
constexpr float SKIP_THR = 40.0f;

constexpr size_t MiB = 1u << 20;
constexpr size_t WS_CTL = 0, CTL_ZERO_BYTES = 1 * MiB;
constexpr size_t WS_MOD = 1 * MiB;
constexpr size_t WS_LIST = 1 * MiB + 256 * 1024;
constexpr size_t WS_TOKINFO = 2 * MiB;
constexpr size_t WS_Y = 4 * MiB;
constexpr size_t WS_ROPE_C = 4 * MiB, WS_ROPE_S = 5 * MiB;
constexpr size_t WS_KCMP = 6 * MiB, WS_VCMP = 6 * MiB + 256 * 1024;
constexpr size_t WS_WIN = 16 * MiB;
constexpr size_t WS_WBR = 44 * MiB;
constexpr size_t WS_WOUT = 48 * MiB;
constexpr size_t WS_W13 = 52 * MiB;
constexpr size_t WS_W2 = 63 * MiB;
constexpr size_t WS_ARENA = 72 * MiB;
constexpr size_t WS_PROJ = WS_ARENA;
constexpr size_t WS_O = WS_ARENA + 224 * MiB;
constexpr size_t WS_GACC = WS_ARENA + 256 * MiB;
constexpr size_t WS_H = WS_ARENA + 320 * MiB;
constexpr size_t WS_HMID = WS_ARENA;
constexpr size_t WS_MOEW13 = WS_ARENA;
constexpr size_t WS_MOEW2 = WS_ARENA + 88 * MiB;
constexpr size_t WS_HMID_MOE = WS_ARENA + 132 * MiB;
constexpr size_t WS_TILED = WS_GACC;
constexpr size_t WS_LC = WS_TILED + 88 * MiB;
constexpr size_t WS_TC = WS_LC + 512 * 1024;
constexpr size_t WS_END = WS_ARENA + 352 * MiB;
static_assert(WS_TC + 8192 <= WS_H + 32 * MiB, "tiled region");
static_assert(WS_HMID_MOE + (size_t)MROWS_MOE * DFF * 2 <= WS_H, "moe hmid vs H");
static_assert(WS_Y + (size_t)MROWS_MOE * 1024 * 2 <= WS_ARENA, "Y overlay");
constexpr int CW_BAR = 4096;
constexpr int CW_MOECNT = 1024;

constexpr int RING_BYTES = 131072;
constexpr int MISC_OFF = RING_BYTES + 320;
constexpr int LDS_BYTES = 147456;

#define GAS __attribute__((address_space(1)))
#define LAS __attribute__((address_space(3)))
typedef unsigned short bf16;
typedef unsigned v4u __attribute__((ext_vector_type(4)));
typedef float f32x4 __attribute__((ext_vector_type(4)));
typedef GAS unsigned gu32;
#define RLX_AGENT __ATOMIC_RELAXED, __HIP_MEMORY_SCOPE_AGENT
#define LDS_WAIT() asm volatile("s_waitcnt lgkmcnt(0)" ::: "memory")
__device__ __forceinline__ unsigned f2bf(float f) { unsigned u = __builtin_bit_cast(unsigned, f); return (u + 0x7fffu + ((u >> 16) & 1u)) >> 16; }
__device__ __forceinline__ unsigned pk2(float lo, float hi) { return f2bf(lo) | (f2bf(hi) << 16); }
__device__ __forceinline__ float bf2f(unsigned short v) { return __uint_as_float((unsigned)v << 16); }
__device__ __forceinline__ int lane_id_fresh() { int l; asm volatile("v_mbcnt_lo_u32_b32 %0, -1, 0\n\tv_mbcnt_hi_u32_b32 %0, -1, %0" : "=v"(l)); return l; }

#define XB_TMO      128
#define XB_XCNT(j)  (256  + 64 * (j))
#define XB_XSUB(j)  (1280 + 64 * (j))
#define XB_XGEN(j)  (2304 + 64 * (j))
#define XB_TOP      3328
#define XB_TOPGEN   3392
#define XCD_BAR_WORDS 3456
#define XB_SPIN_CAP (1u << 22)
__device__ __forceinline__ unsigned xb_ld(unsigned* p)              { return __hip_atomic_load(p, __ATOMIC_RELAXED, __HIP_MEMORY_SCOPE_AGENT); }
__device__ __forceinline__ unsigned xb_add(unsigned* p, unsigned v) { return __hip_atomic_fetch_add(p, v, __ATOMIC_RELAXED, __HIP_MEMORY_SCOPE_AGENT); }
__device__ __forceinline__ unsigned xb_xcc_id() { return (unsigned)__builtin_amdgcn_s_getreg((3 << 11) | 20) & 0xFu; }
#define XB_SPIN(cond, bar) do { unsigned _sp = 0; while (cond) { __builtin_amdgcn_s_sleep(1); \
    if ((++_sp & 255u) == 0u) { if (xb_ld(&(bar)[XB_TMO])) break; if (_sp > XB_SPIN_CAP) { atomicAdd(&(bar)[XB_TMO], 1u); break; } } } } while (0)
struct XcdBarrier { unsigned* bar; unsigned x; volatile LAS unsigned* st; };
__device__ __forceinline__ XcdBarrier xcd_barrier_post(unsigned* bar, volatile LAS unsigned* st, bool leader) {
    XcdBarrier b; b.bar = bar; b.x = xb_xcc_id(); b.st = st;
    if (leader) (void)xb_add(&bar[XB_XCNT(b.x)], 1u);
    return b;
}
__device__ __forceinline__ void xcd_barrier_complete(unsigned* bar, unsigned x, unsigned& nloc, unsigned& nx) {
    const unsigned G = gridDim.x * gridDim.y * gridDim.z;
    unsigned sum, cnt, mine, sp = 0u;
    for (;;) {
        sum = 0u; cnt = 0u; mine = 0u;
#pragma unroll
        for (unsigned j = 0; j < 16; ++j) { const unsigned c = xb_ld(&bar[XB_XCNT(j)]); sum += c; cnt += (c > 0u) ? 1u : 0u; mine = (j == x) ? c : mine; }
        if (sum == G) break;
        __builtin_amdgcn_s_sleep(1);
        if ((++sp & 255u) == 0u) { if (xb_ld(&bar[XB_TMO])) break; if (sp > XB_SPIN_CAP) { atomicAdd(&bar[XB_TMO], 1u); break; } }
    }
    nloc = mine > 0u ? mine : 1u; nx = cnt > 0u ? cnt : 1u;
}
__device__ __forceinline__ void xcd_barrier(const XcdBarrier& b, bool leader) {
    asm volatile("s_waitcnt vmcnt(0)" ::: "memory");
    __syncthreads();
    if (leader) {
        unsigned* bar = b.bar;
        __builtin_amdgcn_s_waitcnt(0);
        unsigned nloc = b.st[0], nx = b.st[1];
        if (nloc == 0u) { xcd_barrier_complete(bar, b.x, nloc, nx); b.st[0] = nloc; b.st[1] = nx; }
        const unsigned old = xb_add(&bar[XB_XSUB(b.x)], 1u);
        const unsigned gen = old / nloc;
        if (old + 1u == (gen + 1u) * nloc) {
            __builtin_amdgcn_fence(__ATOMIC_RELEASE, "agent");
            asm volatile("s_waitcnt vmcnt(0)" ::: "memory");
            const unsigned og = xb_add(&bar[XB_TOP], 1u);
            const unsigned tg = og / nx;
            if (og + 1u == (tg + 1u) * nx) xb_add(&bar[XB_TOPGEN], 1u);
            else XB_SPIN(xb_ld(&bar[XB_TOPGEN]) == tg, bar);
            __builtin_amdgcn_fence(__ATOMIC_ACQUIRE, "agent");
            xb_add(&bar[XB_XGEN(b.x)], 1u);
            asm volatile("s_waitcnt vmcnt(0)" ::: "memory");
        } else {
            XB_SPIN(xb_ld(&bar[XB_XGEN(b.x)]) == gen, bar);
            __builtin_amdgcn_fence(__ATOMIC_ACQUIRE, "agent");
            asm volatile("s_waitcnt vmcnt(0)" ::: "memory");
        }
    }
    __syncthreads();
}

struct Args { const void* in[25]; float* out; unsigned char* ws; int ph_lo, ph_hi; };
typedef const __attribute__((address_space(4))) Args* ArgsP;
struct Frame {
    LAS unsigned char* lds;
    int tid, lane, wave, G, gw, NGW;
    unsigned char* ws;
    gu32* ctl;
};

template <int K> __device__ __forceinline__ float swz_xor(float v) { return __int_as_float(__builtin_amdgcn_ds_swizzle(__float_as_int(v), (K << 10) | 0x1f)); }
template <int K> __device__ __forceinline__ int swz_xor_i(int v) { return __builtin_amdgcn_ds_swizzle(v, (K << 10) | 0x1f); }
__device__ __forceinline__ float wave_sum(float v) {
    v += swz_xor<1>(v); v += swz_xor<2>(v); v += swz_xor<4>(v); v += swz_xor<8>(v); v += swz_xor<16>(v);
    const auto r = __builtin_amdgcn_permlane32_swap(__float_as_uint(v), __float_as_uint(v), false, false);
    return __uint_as_float(r[0]) + __uint_as_float(r[1]);
}

struct MapIdent { const float* W; int N; __device__ const float* operator()(int n) const { return W + n; } __device__ int stride() const { return N; } };
struct MapWin {
    const float* W;
    __device__ const float* operator()(int j) const {
        int o;
        if (j < 652) o = j; else if (j < 656) o = 2956 + (j - 652); else if (j < 768) return nullptr; else if (j < 3072) o = 652 + (j - 768); else o = 2960 + (j - 3072);
        return W + o;
    }
    __device__ int stride() const { return INC; }
};
struct MapW13 {
    const float* W1; const float* W3;
    __device__ const float* operator()(int j) const { const int tile = j >> 8, r = j & 255; return (r < 128) ? (W1 + tile * 128 + r) : (W3 + tile * 128 + (r - 128)); }
    __device__ int stride() const { return DFF; }
};
template <class Map>
__device__ __forceinline__ void transpose_item(const Map mp, int K, bf16* WT, LAS float* scr, int kb, int nb, int lane) {
    const int k0 = 64 * kb, n0 = 32 * nb; const float* cp = mp(n0 + (lane & 31)); const int st = mp.stride();
#pragma unroll 8
    for (int i = 0; i < 32; ++i) { const int kk = 2 * i + (lane >> 5); scr[kk * 33 + (lane & 31)] = cp ? cp[(size_t)(k0 + kk) * st] : 0.f; }
    LDS_WAIT(); asm volatile("" ::: "memory");
    const int c = lane & 7;
#pragma unroll
    for (int j = 0; j < 4; ++j) { const int n = (lane >> 3) + 8 * j; const LAS float* s = scr + (8 * c) * 33 + n;
        v4u o; o.x = pk2(s[0 * 33], s[1 * 33]); o.y = pk2(s[2 * 33], s[3 * 33]); o.z = pk2(s[4 * 33], s[5 * 33]); o.w = pk2(s[6 * 33], s[7 * 33]);
        *(GAS v4u*)(WT + (size_t)(n0 + n) * K + k0 + 8 * c) = o; }
    LDS_WAIT(); asm volatile("" ::: "memory");
}
template <class Map>
__device__ __forceinline__ void transpose_all(Frame& F, const Map mp, int K, int Nout, bf16* WT, int& itbase) {
    LAS float* scr = (LAS float*)(F.lds + F.wave * 16384);
    const int nblk = Nout / 32, n = (K / 64) * nblk;
    int first = (F.gw - (itbase % F.NGW) + F.NGW) % F.NGW;
    for (int it = first; it < n; it += F.NGW) transpose_item(mp, K, WT, scr, it / nblk, it % nblk, F.lane);
    itbase += n;
}

__device__ __forceinline__ float gelu_tanh(float x) { const float u = 0.7978845608028654f * (x + 0.044715f * x * x * x); return 0.5f * x * (1.0f + tanhf(u)); }
__device__ __forceinline__ float log_sigmoid(float x) { return fminf(x, 0.f) - log1pf(__expf(-fabsf(x))); }

__device__ __forceinline__ void load64(const bf16* p, float (&v)[64]) {
    const v4u* p4 = (const v4u*)p;
#pragma unroll
    for (int i = 0; i < 8; ++i) { const v4u u = p4[i];
#pragma unroll
        for (int k = 0; k < 4; ++k) { v[8 * i + 2 * k] = __uint_as_float(u[k] << 16); v[8 * i + 2 * k + 1] = __uint_as_float(u[k] & 0xffff0000u); } }
}
__device__ __forceinline__ float dot64(const bf16* p, const float (&q)[64]) {
    const v4u* p4 = (const v4u*)p; float s0 = 0.f, s1 = 0.f;
#pragma unroll
    for (int i = 0; i < 8; ++i) { if (i == 4) asm volatile("" ::: "memory"); const v4u u = p4[i];
#pragma unroll
        for (int k = 0; k < 4; ++k) { s0 += __uint_as_float(u[k] << 16) * q[8 * i + 2 * k]; s1 += __uint_as_float(u[k] & 0xffff0000u) * q[8 * i + 2 * k + 1]; } }
    return s0 + s1;
}
__device__ __forceinline__ void axpy64(const bf16* p, float w, float (&o)[64]) {
    const v4u* p4 = (const v4u*)p;
#pragma unroll
    for (int i = 0; i < 8; ++i) { if (i == 4) asm volatile("" ::: "memory"); const v4u u = p4[i];
#pragma unroll
        for (int k = 0; k < 4; ++k) { o[8 * i + 2 * k] += w * __uint_as_float(u[k] << 16); o[8 * i + 2 * k + 1] += w * __uint_as_float(u[k] & 0xffff0000u); } }
}
__device__ __forceinline__ void store64(bf16* p, const float (&v)[64]) {
    v4u* p4 = (v4u*)p;
#pragma unroll
    for (int i = 0; i < 8; ++i) { v4u u;
#pragma unroll
        for (int k = 0; k < 4; ++k) u[k] = pk2(v[8 * i + 2 * k], v[8 * i + 2 * k + 1]);
        p4[i] = u; }
}
#define SOFTMAX_STEP(s_, vp_) do { const float _s = (s_); if (_s > m_run) { const float _f = __expf(m_run - _s); l_run *= _f; _Pragma("unroll") for (int _d = 0; _d < 64; ++_d) o[_d] *= _f; m_run = _s; } \
    const float _p = __expf(_s - m_run); l_run += _p; axpy64((vp_), _p, o); } while (0)

__device__ __forceinline__ void phase_prologue(Frame& F, ArgsP a) {
    const float* c_in = (const float*)a->in[1]; const int* pos = (const int*)a->in[2];
    const float* w_ada = (const float*)a->in[3]; const float* b_ada = (const float*)a->in[4];
    {
        LAS float* sc = (LAS float*)(F.lds);
        LAS float* part = (LAS float*)(F.lds + 8192);
        for (int i = F.tid; i < 2048; i += NWAVES * 64) { const float v = c_in[i]; sc[i] = v / (1.0f + __expf(-v)); }
        __syncthreads();
        for (int it = blockIdx.x; it < 2 * 96; it += F.G) {
            const int l = it / 96, j0 = (it % 96) * 64; const float* W = w_ada + (size_t)l * 1024 * 6144 + j0 + F.lane;
            float a0 = 0.f, a1 = 0.f;
#pragma unroll 16
            for (int k = 0; k < 128; ++k) { const int kk = F.wave * 128 + k; const float w = W[(size_t)kk * 6144]; a0 += sc[kk] * w; a1 += sc[1024 + kk] * w; }
            part[(F.wave * 2 + 0) * 64 + F.lane] = a0; part[(F.wave * 2 + 1) * 64 + F.lane] = a1;
            __syncthreads();
            if (F.wave < 2) { float s = 0.f;
#pragma unroll
                for (int w = 0; w < 8; ++w) s += part[(w * 2 + F.wave) * 64 + F.lane];
                ((float*)(F.ws + WS_MOD))[((size_t)l * 2 + F.wave) * 6144 + j0 + F.lane] = s + b_ada[(size_t)l * 6144 + j0 + F.lane]; }
            __syncthreads();
        }
    }
    {
        float* rc = (float*)(F.ws + WS_ROPE_C); float* rs = (float*)(F.ws + WS_ROPE_S);
        for (int i = blockIdx.x * (NWAVES * 64) + F.tid; i < M * 8; i += F.G * NWAVES * 64) {
            const int tok = i >> 3, fi = i & 7;
            const float inv = fi == 0 ? 1.0f : fi == 1 ? 0.1939227432012558f : fi == 2 ? 0.03760603070259094f : fi == 3 ? 0.007292664609849453f : fi == 4 ? 0.0014142135623842478f
                            : fi == 5 ? 0.00027424818836152554f : fi == 6 ? 5.318296098266728e-05f : 1.0313386155758053e-05f;
            const float ang = (float)pos[tok] * inv;
            double rev = (double)ang * 0.15915494309189535; rev -= floor(rev);
            const float fr = (float)rev;
            rs[i] = __builtin_amdgcn_sinf(fr); rc[i] = __builtin_amdgcn_cosf(fr);
        }
    }
    {
        int itb = 0;
        const float* w_in = (const float*)a->in[7]; const float* w_br = (const float*)a->in[16]; const float* w_out = (const float*)a->in[17];
        for (int l = 0; l < 2; ++l) {
            transpose_all(F, MapWin{w_in + (size_t)l * 1024 * INC}, 1024, NP, (bf16*)(F.ws + WS_WIN) + (size_t)l * NP * 1024, itb);
            for (int z = 0; z < 4; ++z) transpose_all(F, MapIdent{w_br + ((size_t)l * 4 + z) * 256 * 1024, 1024}, 256, 1024, (bf16*)(F.ws + WS_WBR) + ((size_t)l * 4 + z) * 1024 * 256, itb);
            transpose_all(F, MapIdent{w_out + (size_t)l * 1024 * 1024, 1024}, 1024, 1024, (bf16*)(F.ws + WS_WOUT) + (size_t)l * 1024 * 1024, itb);
        }
        transpose_all(F, MapW13{(const float*)a->in[18], (const float*)a->in[19]}, 1024, 2 * DFF, (bf16*)(F.ws + WS_W13), itb);
        transpose_all(F, MapIdent{(const float*)a->in[20], 1024}, DFF, 1024, (bf16*)(F.ws + WS_W2), itb);
    }
}
__device__ __forceinline__ void phase_moe_weights(Frame& F, ArgsP a) {
    int itb = 0;
    const float* w1 = (const float*)a->in[22]; const float* w3 = (const float*)a->in[23]; const float* w2 = (const float*)a->in[24];
    for (int e = 0; e < NE; ++e) {
        transpose_all(F, MapW13{w1 + (size_t)e * 1024 * DFF, w3 + (size_t)e * 1024 * DFF}, 1024, 2 * DFF, (bf16*)(F.ws + WS_MOEW13) + (size_t)e * 2 * DFF * 1024, itb);
        transpose_all(F, MapIdent{w2 + (size_t)e * DFF * 1024, 1024}, DFF, 1024, (bf16*)(F.ws + WS_MOEW2) + (size_t)e * 1024 * DFF, itb);
    }
}

template <bool ROUTE>
__device__ __forceinline__ void phase_norm(Frame& F, const float* x, const float* nw, const float* sh, const float* sc, const float* router) {
    bf16* H = (bf16*)(F.ws + WS_H);
    const int rows_per = ROUTE ? 8 : 1;
    for (int r0 = F.gw * rows_per; r0 < M; r0 += F.NGW * rows_per) {
        const int b = r0 >> 13;
        f32x4 A[4], Bv[4];
#pragma unroll
        for (int j = 0; j < 4; ++j) { const int c = 4 * F.lane + 256 * j; const f32x4 w = *(const f32x4*)(nw + c), s = *(const f32x4*)(sc + (size_t)b * 6144 + c); A[j] = w * (s + 1.0f); Bv[j] = *(const f32x4*)(sh + (size_t)b * 6144 + c); }
        int myE = 0; float myG = 0.f;
        for (int rr = 0; rr < rows_per; ++rr) {
            const int m = r0 + rr;
            const GAS f32x4* xr = (const GAS f32x4*)(x + (size_t)m * D) + F.lane;
            f32x4 v[4]; float s2 = 0.f;
#pragma unroll
            for (int j = 0; j < 4; ++j) { v[j] = xr[64 * j]; s2 += (v[j].x * v[j].x + v[j].y * v[j].y) + (v[j].z * v[j].z + v[j].w * v[j].w); }
            const float rstd = 1.0f / sqrtf(wave_sum(s2) * (1.f / D) + EPS);
#pragma unroll
            for (int j = 0; j < 4; ++j) v[j] = (v[j] * rstd) * A[j] + Bv[j];
            GAS unsigned long long* o8 = (GAS unsigned long long*)(H + (size_t)m * D) + F.lane;
#pragma unroll
            for (int j = 0; j < 4; ++j) o8[64 * j] = (unsigned long long)pk2(v[j].x, v[j].y) | ((unsigned long long)pk2(v[j].z, v[j].w) << 32);
            if constexpr (ROUTE) {
                float lg[8];
#pragma unroll
                for (int e = 0; e < 8; ++e) lg[e] = 0.f;
#pragma unroll
                for (int j = 0; j < 4; ++j)
#pragma unroll
                    for (int k = 0; k < 4; ++k) { const int c = 4 * F.lane + 256 * j + k; const f32x4 w0 = *(const f32x4*)(router + (size_t)c * 8), w1 = *(const f32x4*)(router + (size_t)c * 8 + 4); const float xv = v[j][k];
                        lg[0] += xv * w0.x; lg[1] += xv * w0.y; lg[2] += xv * w0.z; lg[3] += xv * w0.w; lg[4] += xv * w1.x; lg[5] += xv * w1.y; lg[6] += xv * w1.z; lg[7] += xv * w1.w; }
#pragma unroll
                for (int e = 0; e < 8; ++e) lg[e] = wave_sum(lg[e]);
                int e0 = 0; float v0 = lg[0];
#pragma unroll
                for (int e = 1; e < 8; ++e) if (lg[e] > v0) { v0 = lg[e]; e0 = e; }
                int e1 = -1; float v1 = -3.0e38f;
#pragma unroll
                for (int e = 0; e < 8; ++e) if (e != e0 && lg[e] > v1) { v1 = lg[e]; e1 = e; }
                const float g0 = 1.0f / (1.0f + __expf(v1 - v0)), g1 = 1.0f - g0;
                if (F.lane == 2 * rr) { myE = e0; myG = g0; }
                if (F.lane == 2 * rr + 1) { myE = e1; myG = g1; }
            }
        }
        if constexpr (ROUTE) {
            gu32* cnt = F.ctl + CW_MOECNT; int* list = (int*)(F.ws + WS_LIST); int* info = (int*)(F.ws + WS_TOKINFO);
            const bool act = F.lane < 16; int myrank = 0;
#pragma unroll
            for (int e = 0; e < 8; ++e) {
                const unsigned long long mk = __ballot(act && myE == e);
                const int c = __popcll(mk); unsigned base = 0;
                if (c > 0) { if (F.lane == 0) base = __hip_atomic_fetch_add(cnt + 64 * e, (unsigned)c, RLX_AGENT); base = __builtin_amdgcn_readfirstlane(base); }
                if (act && myE == e) myrank = (int)base + __popcll(mk & ((1ull << F.lane) - 1ull));
            }
            if (act) { const int tok = r0 + (F.lane >> 1); list[myE * 16384 + myrank] = tok; int* ip = info + ((size_t)tok * 2 + (F.lane & 1)) * 4; ip[0] = myE; ip[1] = myrank; ip[2] = __float_as_int(myG); ip[3] = 0; }
        }
    }
}

__device__ __forceinline__ void phase_qknorm(Frame& F, const float* qk_gain  ) {
    bf16* P = (bf16*)(F.ws + WS_PROJ); const float* rc = (const float*)(F.ws + WS_ROPE_C); const float* rs = (const float*)(F.ws + WS_ROPE_S);
    for (int it = blockIdx.x * (NWAVES * 64) + F.tid; it < M * 24; it += F.G * NWAVES * 64) {
        const int tok = it / 24, s = it % 24; int col, gi; bool rope;
        if (s < 4) { col = C_NSAQ + 64 * s; gi = 0; rope = false; }
        else if (s == 4) { col = C_KC; gi = 1; rope = false; }
        else if (s == 5) { col = C_KSL; gi = 2; rope = true; }
        else if (s == 6) { col = C_KW; gi = 3; rope = true; }
        else if (s < 11) { col = C_BQ + 64 * (s - 7); gi = 4; rope = true; }
        else if (s < 15) { col = C_BK + 64 * (s - 11); gi = 5; rope = true; }
        else if (s < 19) { col = C_DQ + 64 * (s - 15); gi = 6; rope = false; }
        else if (s < 23) { col = C_DK + 64 * (s - 19); gi = 7; rope = false; }
        else continue;
        bf16* p = P + (size_t)tok * NP + col; float v[64]; load64(p, v);
        float ss = 0.f;
#pragma unroll
        for (int d = 0; d < 64; ++d) ss += v[d] * v[d];
        const float r = 1.0f / sqrtf(ss * (1.f / 64.f) + EPS); const float* g = qk_gain + gi * 64;
#pragma unroll
        for (int d = 0; d < 64; ++d) v[d] = v[d] * r * g[d];
        if (rope) {
#pragma unroll
            for (int i = 0; i < 8; ++i) { const float c = rc[(size_t)tok * 8 + i], sn = rs[(size_t)tok * 8 + i]; const float x1 = v[i], x2 = v[8 + i]; v[i] = x1 * c - x2 * sn; v[8 + i] = x2 * c + x1 * sn; }
        }
        store64(p, v);
    }
}

__device__ __forceinline__ void phase_compress(Frame& F, const float* pe_k, const float* pe_v, const float* k1, const float* k2, const float* v1, const float* v2) {
    const bf16* P = (const bf16*)(F.ws + WS_PROJ);
    LAS float* Ain = (LAS float*)(F.lds + F.wave * 9216);
    LAS float* hid = Ain + 2048;
    for (int it = F.gw; it < 2 * 2 * 511; it += F.NGW) {
        const int which = it / 1022, r = it % 1022, b = r / 511, c = r % 511;
        const float* pe = which ? pe_v : pe_k; const float* w1 = which ? v1 : k1; const float* w2 = which ? v2 : k2; const int col = which ? C_VC : C_KC;
        for (int i = F.lane; i < 2048; i += 64) { const int l = i >> 6, d = i & 63; Ain[i] = bf2f(P[(size_t)(b * SEQ + 16 * c + l) * NP + col + d]) + pe[i]; }
        LDS_WAIT(); asm volatile("" ::: "memory");
        float h0 = 0.f, h1 = 0.f;
#pragma unroll 8
        for (int i = 0; i < 2048; ++i) { const float av = Ain[i]; h0 += av * w1[(size_t)i * 128 + F.lane]; h1 += av * w1[(size_t)i * 128 + 64 + F.lane]; }
        hid[F.lane] = gelu_tanh(h0); hid[64 + F.lane] = gelu_tanh(h1);
        LDS_WAIT(); asm volatile("" ::: "memory");
        float o = 0.f;
#pragma unroll 8
        for (int j = 0; j < 128; ++j) o += hid[j] * w2[j * 64 + F.lane];
        { const int d = F.lane, tile = c >> 5, kk = c & 31; char* base = (char*)(F.ws + (which ? WS_VCMP : WS_KCMP)) + (size_t)b * 65536 + tile * 4096;
          if (!which) *(bf16*)(base + (d >> 4) * 1024 + (kk + 32 * ((d >> 3) & 1)) * 16 + (d & 7) * 2) = (bf16)f2bf(o);
          else { const int s2 = kk >> 4, rem = kk & 15, hh = (rem >> 2) & 1, j = 4 * (rem >> 3) + (rem & 3); *(bf16*)(base + ((d >> 5) * 2 + s2) * 1024 + ((d & 31) + 32 * hh) * 16 + j * 2) = (bf16)f2bf(o); }
          if (c == 510) {
              const int kz = 31;
              if (!which) *(bf16*)(base + (d >> 4) * 1024 + (kz + 32 * ((d >> 3) & 1)) * 16 + (d & 7) * 2) = (bf16)0;
              else { const int s2 = kz >> 4, rem = kz & 15, hh = (rem >> 2) & 1, j = 4 * (rem >> 3) + (rem & 3); *(bf16*)(base + ((d >> 5) * 2 + s2) * 1024 + ((d & 31) + 32 * hh) * 16 + j * 2) = (bf16)0; } } }
        LDS_WAIT(); asm volatile("" ::: "memory");
    }
}

typedef short bf16x8v __attribute__((ext_vector_type(8)));
typedef float f32x16 __attribute__((ext_vector_type(16)));
constexpr float LOG2E = 1.4426950408889634f;
constexpr float QK_C = 0.125f * LOG2E;
constexpr float THR2 = SKIP_THR * LOG2E;
__device__ __forceinline__ const char* stream_tile(const Frame& F, int sid, int b, int tile) { return (const char*)(F.ws + WS_TILED) + (size_t)sid * (2 * MiB) + (size_t)b * MiB + (size_t)tile * 4096; }
__device__ __forceinline__ void load_tile(const char* kt, const char* vt, int lane, bf16x8v (&kf)[4], bf16x8v (&vf)[4]) {
#pragma unroll
    for (int i = 0; i < 4; ++i) { kf[i] = *(const bf16x8v*)(kt + i * 1024 + lane * 16); vf[i] = *(const bf16x8v*)(vt + i * 1024 + lane * 16); }
}
__device__ __forceinline__ f32x16 qk_tile(const bf16x8v (&kf)[4], const bf16x8v (&qf)[4]) {
    f32x16 s = {};
#pragma unroll
    for (int i = 0; i < 4; ++i) s = __builtin_amdgcn_mfma_f32_32x32x16_bf16(kf[i], qf[i], s, 0, 0, 0);
    return s;
}
__device__ __forceinline__ float half_max(float v) { const auto r = __builtin_amdgcn_permlane32_swap(__float_as_uint(v), __float_as_uint(v), false, false); return fmaxf(__uint_as_float(r[0]), __uint_as_float(r[1])); }
__device__ __forceinline__ float half_sum(float v) { const auto r = __builtin_amdgcn_permlane32_swap(__float_as_uint(v), __float_as_uint(v), false, false); return __uint_as_float(r[0]) + __uint_as_float(r[1]); }
__device__ __forceinline__ float half_other(float v, int hi) { const auto r = __builtin_amdgcn_permlane32_swap(__float_as_uint(v), __float_as_uint(v), false, false); return __uint_as_float(hi ? r[0] : r[1]); }
struct SoftSt { f32x16 o0, o1; float m, l; };
__device__ __forceinline__ void soft_init(SoftSt& st) { st.o0 = (f32x16){}; st.o1 = (f32x16){}; st.m = -1.0e30f; st.l = 0.f; }
__device__ __forceinline__ void pv_tile(SoftSt& st, const f32x16& p, const bf16x8v (&vf)[4]) {
    bf16x8v pf[2];
#pragma unroll
    for (int s2 = 0; s2 < 2; ++s2) { v4u w;
#pragma unroll
        for (int k = 0; k < 4; ++k) w[k] = pg8::cvt_pk_bf16(p[8 * s2 + 2 * k], p[8 * s2 + 2 * k + 1]);
        pf[s2] = __builtin_bit_cast(bf16x8v, w); }
    st.o0 = __builtin_amdgcn_mfma_f32_32x32x16_bf16(vf[0], pf[0], st.o0, 0, 0, 0);
    st.o0 = __builtin_amdgcn_mfma_f32_32x32x16_bf16(vf[1], pf[1], st.o0, 0, 0, 0);
    st.o1 = __builtin_amdgcn_mfma_f32_32x32x16_bf16(vf[2], pf[0], st.o1, 0, 0, 0);
    st.o1 = __builtin_amdgcn_mfma_f32_32x32x16_bf16(vf[3], pf[1], st.o1, 0, 0, 0);
}
__device__ __forceinline__ void soft_pv(SoftSt& st, f32x16& s, const bf16x8v (&vf)[4]) {
    float tm = fmaxf(fmaxf(s[0], s[1]), fmaxf(s[2], s[3]));
#pragma unroll
    for (int r = 4; r < 16; r += 4) tm = fmaxf(tm, fmaxf(fmaxf(s[r], s[r + 1]), fmaxf(s[r + 2], s[r + 3])));
    tm = half_max(tm);
    const float mn = fmaxf(st.m, tm);
    if (__any(mn > st.m)) { const float al = __builtin_amdgcn_exp2f(st.m - mn); st.l *= al; st.o0 = st.o0 * al; st.o1 = st.o1 * al; }
    st.m = mn;
    float ls = 0.f;
#pragma unroll
    for (int r = 0; r < 16; ++r) { s[r] = __builtin_amdgcn_exp2f(s[r] - mn); ls += s[r]; }
    st.l += ls;
    pv_tile(st, s, vf);
}
__device__ __forceinline__ void store_ot(bf16* orow, const f32x16& o0, const f32x16& o1, float sc, int hi) {
#pragma unroll
    for (int g = 0; g < 4; ++g) {
        uint2 w0, w1;
        w0.x = pg8::cvt_pk_bf16(o0[4 * g] * sc, o0[4 * g + 1] * sc); w0.y = pg8::cvt_pk_bf16(o0[4 * g + 2] * sc, o0[4 * g + 3] * sc);
        w1.x = pg8::cvt_pk_bf16(o1[4 * g] * sc, o1[4 * g + 1] * sc); w1.y = pg8::cvt_pk_bf16(o1[4 * g + 2] * sc, o1[4 * g + 3] * sc);
        *(uint2*)(orow + 8 * g + 4 * hi) = w0; *(uint2*)(orow + 32 + 8 * g + 4 * hi) = w1;
    }
}
__device__ __forceinline__ void load_q(const bf16* qrow, int hi, bf16x8v (&qf)[4]) {
#pragma unroll
    for (int i = 0; i < 4; ++i) qf[i] = *(const bf16x8v*)(qrow + 16 * i + 8 * hi);
}
#define CROW(r, hi) (((r) & 3) + 8 * ((r) >> 2) + 4 * (hi))

__device__ __forceinline__ void attn_fox_unit(Frame& F, int unit, const float* gk) {
    const int h = unit & 3, qt = (unit >> 2) & 255, b = unit >> 10, r32 = F.lane & 31, hi = F.lane >> 5;
    const bf16* P = (const bf16*)(F.ws + WS_PROJ); bf16* O = (bf16*)(F.ws + WS_O);
    const int tg = b * SEQ + 32 * qt + r32;
    bf16x8v qf[4]; load_q(P + (size_t)tg * NP + C_DQ + 64 * h, hi, qf);
    float qn = 0.f, gmax = 0.f;
#pragma unroll
    for (int i = 0; i < 4; ++i)
#pragma unroll
        for (int j = 0; j < 8; ++j) { const float v = bf2f((unsigned short)qf[i][j]); qn += v * v; }
    qn = half_sum(qn);
    for (int d = 0; d < 64; ++d) gmax = fmaxf(gmax, fabsf(gk[d]));
    const float qkmax2 = sqrtf(qn) * (8.0f * gmax) * QK_C * 1.02f;
    const float* LC = (const float*)(F.ws + WS_LC) + ((size_t)b * 4 + h) * SEQ; const float* TC = (const float*)(F.ws + WS_TC) + ((size_t)b * 4 + h) * 256;
    const float lct = LC[32 * qt + r32];
    SoftSt st; soft_init(st);
    bf16x8v kf[4], vf[4], kn[4], vn[4];
    load_tile(stream_tile(F, 36 + h, b, qt), stream_tile(F, 40 + h, b, qt), F.lane, kf, vf);
    float gacc = 0.f;
    for (int kt = qt; kt >= 0; --kt) {
        if (kt > 0) load_tile(stream_tile(F, 36 + h, b, kt - 1), stream_tile(F, 40 + h, b, kt - 1), F.lane, kn, vn);
        f32x16 s = qk_tile(kf, qf);
        const float base = lct + gacc;
#pragma unroll
        for (int g = 0; g < 4; ++g) { const f32x4 lc = *(const f32x4*)(LC + 32 * kt + 8 * g + 4 * hi);
#pragma unroll
            for (int k = 0; k < 4; ++k) s[4 * g + k] = s[4 * g + k] * QK_C + (base - lc[k]); }
        if (kt == qt) {
#pragma unroll
            for (int r = 0; r < 16; ++r) if (CROW(r, hi) > r32) s[r] = -INFINITY;
        }
        soft_pv(st, s, vf);
        if (__all(qkmax2 + lct + gacc - st.m < -THR2)) break;
        if (kt > 0) { gacc += TC[kt - 1];
#pragma unroll
            for (int i = 0; i < 4; ++i) { kf[i] = kn[i]; vf[i] = vn[i]; } }
    }
    const float lt = half_sum(st.l);
    store_ot(O + (size_t)tg * 1024 + 768 + 64 * h, st.o0, st.o1, 1.0f / lt, hi);
}
__device__ __forceinline__ void attn_sb_unit(Frame& F, int unit) {
    const int h = unit & 3, qt = (unit >> 2) & 255, b = unit >> 10, r32 = F.lane & 31, hi = F.lane >> 5;
    const bf16* P = (const bf16*)(F.ws + WS_PROJ); bf16* O = (bf16*)(F.ws + WS_O);
    const int tg = b * SEQ + 32 * qt + r32;
    bf16x8v qf[4]; load_q(P + (size_t)tg * NP + C_CQ + 64 * h, hi, qf);
    SoftSt st; soft_init(st);
    bf16x8v kf[4], vf[4], kn[4], vn[4];
    load_tile(stream_tile(F, 28 + h, b, qt), stream_tile(F, 32 + h, b, qt), F.lane, kf, vf);
    float R = 0.f;
    for (int kt = qt; kt >= 0; --kt) {
        if (kt > 0) load_tile(stream_tile(F, 28 + h, b, kt - 1), stream_tile(F, 32 + h, b, kt - 1), F.lane, kn, vn);
        f32x16 s = qk_tile(kf, qf);
        float L[16];
#pragma unroll
        for (int r = 0; r < 16; ++r) { const float z2 = s[r] * QK_C; const float sp = fmaxf(z2, 0.f) + __builtin_amdgcn_logf(1.0f + __builtin_amdgcn_exp2f(-fabsf(z2)));
            const bool ok = (kt < qt) || (CROW(r, hi) < r32); L[r] = ok ? -sp : 0.f; s[r] = ok ? (z2 - sp) : -INFINITY; }
        float gt[4], og[4];
#pragma unroll
        for (int g = 0; g < 4; ++g) { gt[g] = (L[4 * g] + L[4 * g + 1]) + (L[4 * g + 2] + L[4 * g + 3]); og[g] = half_other(gt[g], hi); }
        float suf[4];
        { float a = 0.f;
#pragma unroll
          for (int g = 3; g >= 0; --g) { suf[g] = a; a += gt[g]; }
          float bsum = 0.f;
#pragma unroll
          for (int g = 3; g >= 0; --g) { if (hi == 0) { bsum += og[g]; suf[g] += bsum; } else { suf[g] += bsum; bsum += og[g]; } }
        }
#pragma unroll
        for (int g = 0; g < 4; ++g) { const float a3 = R + suf[g], a2 = a3 + L[4 * g + 3], a1 = a2 + L[4 * g + 2], a0 = a1 + L[4 * g + 1];
            s[4 * g + 3] = __builtin_amdgcn_exp2f(s[4 * g + 3] + a3); s[4 * g + 2] = __builtin_amdgcn_exp2f(s[4 * g + 2] + a2);
            s[4 * g + 1] = __builtin_amdgcn_exp2f(s[4 * g + 1] + a1); s[4 * g] = __builtin_amdgcn_exp2f(s[4 * g] + a0); }
        pv_tile(st, s, vf);
        R += ((gt[0] + gt[1]) + (gt[2] + gt[3])) + ((og[0] + og[1]) + (og[2] + og[3]));
        if (__all(R < -THR2)) break;
        if (kt > 0) {
#pragma unroll
            for (int i = 0; i < 4; ++i) { kf[i] = kn[i]; vf[i] = vn[i]; } }
    }
    store_ot(O + (size_t)tg * 1024 + 512 + 64 * h, st.o0, st.o1, 1.0f, hi);
}
__device__ __forceinline__ void attn_dil_unit(Frame& F, int unit) {
    const int h = unit & 3, r16 = (unit >> 2) & 15, blk = (unit >> 6) & 15, b = unit >> 10, r32 = F.lane & 31, hi = F.lane >> 5;
    const bf16* P = (const bf16*)(F.ws + WS_PROJ); bf16* O = (bf16*)(F.ws + WS_O);
    const int t = 512 * blk + r16 + 16 * r32, tg = b * SEQ + t;
    bf16x8v qf[4]; load_q(P + (size_t)tg * NP + C_BQ + 64 * h, hi, qf);
    SoftSt st; soft_init(st);
    bf16x8v kf[4], vf[4];
#pragma unroll 1
    for (int gi = 0; gi < 3; ++gi) {
        int sidk, tile0, ntile, qi, tbase;
        if (gi == 0)      { sidk = 4 + h;  qi = t;      const int lo = 16 * blk - 4;  tile0 = lo < 0 ? 0 : lo; ntile = 16 * blk + 15 - tile0 + 1; tbase = 0; }
        else if (gi == 1) { sidk = 8 + h;  qi = t >> 2; const int lo = 4 * blk - 4;   tile0 = lo < 0 ? 0 : lo; ntile = 4 * blk + 3 - tile0 + 1;   tbase = (r16 & 3) * 64; }
        else              { sidk = 12 + h; qi = t >> 4; const int lo = blk - 4;       tile0 = lo < 0 ? 0 : lo; ntile = blk - tile0 + 1;           tbase = r16 * 16; }
        for (int ti = 0; ti < ntile; ++ti) {
            const int tl = tile0 + ti;
            load_tile(stream_tile(F, sidk, b, tbase + tl), stream_tile(F, sidk + 12, b, tbase + tl), F.lane, kf, vf);
            f32x16 s = qk_tile(kf, qf);
#pragma unroll
            for (int r = 0; r < 16; ++r) { const int kk = 32 * tl + CROW(r, hi); const int df = qi - kk; s[r] = (df >= 0 && df <= 128) ? s[r] * QK_C : -INFINITY; }
            soft_pv(st, s, vf);
        }
    }
    const float lt = half_sum(st.l);
    store_ot(O + (size_t)tg * 1024 + 256 + 64 * h, st.o0, st.o1, 1.0f / lt, hi);
}

__device__ __forceinline__ void attn_nsa_unit(Frame& F, int unit) {
    const int b = unit >> 10, t0 = (unit & 1023) * 8, r32 = F.lane & 31, hi = F.lane >> 5, qi = r32 >> 2, head = r32 & 3;
    const int t = t0 + qi, tg = b * SEQ + t;
    const bf16* P = (const bf16*)(F.ws + WS_PROJ); bf16* O = (bf16*)(F.ws + WS_O);
    LAS float* imp = (LAS float*)(F.lds + F.wave * 5120);
    LAS unsigned* selm = (LAS unsigned*)(F.lds + F.wave * 5120 + 4096);
    const bf16* prow = P + (size_t)tg * NP;
    const float g0 = pg8::sigmoid_f(bf2f(prow[C_AG + 3 * head])), g1 = pg8::sigmoid_f(bf2f(prow[C_AG + 3 * head + 1])), g2 = pg8::sigmoid_f(bf2f(prow[C_AG + 3 * head + 2]));
    bf16x8v qf[4]; load_q(prow + C_NSAQ + 64 * head, hi, qf);
    f32x16 ot0 = {}, ot1 = {};
    SoftSt st; bf16x8v kf[4], vf[4];
    const int cmax = (t >= 31) ? ((t - 31) >> 4) : -1;
    const int cmax_last = (t0 + 7 >= 31) ? ((t0 + 7 - 31) >> 4) : -1;
    const int ntc = (cmax_last >= 0) ? (cmax_last >> 5) + 1 : 0;
    const char* kcb = (const char*)(F.ws + WS_KCMP) + (size_t)b * 65536; const char* vcb = (const char*)(F.ws + WS_VCMP) + (size_t)b * 65536;
    soft_init(st);
    for (int ct = 0; ct < ntc; ++ct) {
        load_tile(kcb + ct * 4096, vcb + ct * 4096, F.lane, kf, vf);
        f32x16 s = qk_tile(kf, qf);
#pragma unroll
        for (int r = 0; r < 16; ++r) s[r] = (32 * ct + CROW(r, hi) <= cmax) ? s[r] * QK_C : -INFINITY;
        soft_pv(st, s, vf);
    }
    float inv;
    { const float lt = half_sum(st.l); inv = lt > 0.f ? 1.0f / lt : 0.f; const float sc = g0 * inv; ot0 = st.o0 * sc; ot1 = st.o1 * sc; }
    const float mfin = st.m;
    for (int i = F.lane; i < 8 * 128; i += 64) imp[i] = 0.f;
    LDS_WAIT(); asm volatile("" ::: "memory");
    { float carry = 0.f;
      for (int ct = 0; ct < ntc; ++ct) {
#pragma unroll
        for (int i = 0; i < 4; ++i) kf[i] = *(const bf16x8v*)(kcb + ct * 4096 + i * 1024 + F.lane * 16);
        f32x16 s = qk_tile(kf, qf);
        float Sg[4], X[4];
#pragma unroll
        for (int r = 0; r < 16; ++r) { float p = (32 * ct + CROW(r, hi) <= cmax) ? __builtin_amdgcn_exp2f(s[r] * QK_C - mfin) * inv : 0.f; p += swz_xor<1>(p); p += swz_xor<2>(p); s[r] = p; }
#pragma unroll
        for (int g = 0; g < 4; ++g) { Sg[g] = (s[4 * g] + s[4 * g + 1]) + (s[4 * g + 2] + s[4 * g + 3]); X[g] = half_other(s[4 * g + 3], hi); }
        if (head == 0) {
#pragma unroll
            for (int g = 0; g < 4; ++g) { const float prev = hi ? X[g] : (g > 0 ? X[g > 0 ? g - 1 : 0] : carry); imp[qi * 128 + 8 * ct + 2 * g + hi] = Sg[g] + prev; }
        }
        carry = X[3];
      }
      if (head == 0 && hi == 0 && 8 * ntc < 128) imp[qi * 128 + 8 * ntc] = carry;
    }
    LDS_WAIT(); asm volatile("" ::: "memory");
    const int cur = t0 >> 6; const int n_pick = (cur + 1 < 16) ? cur + 1 : 16;
    { const int q8 = F.lane >> 3, sub = F.lane & 7;
      unsigned mk0 = 1u, mk1 = 0u, mk2 = 0u, mk3 = 0u; int nsel = 1;
#define NSA_SETBIT(j_) do { const int jj_ = (j_); const unsigned bb_ = 1u << (jj_ & 31); if ((jj_ >> 5) == 0) mk0 |= bb_; else if ((jj_ >> 5) == 1) mk1 |= bb_; else if ((jj_ >> 5) == 2) mk2 |= bb_; else mk3 |= bb_; } while (0)
      if (cur >= 1) { NSA_SETBIT(cur); ++nsel; }
      if (cur >= 2) { NSA_SETBIT(cur - 1); ++nsel; }
      for (; nsel < n_pick; ++nsel) {
          float bv = -2.0f; int bi = 1 << 20;
          for (int j = 1 + sub; j <= cur - 2; j += 8) { const float v = imp[q8 * 128 + j]; if (v > bv) { bv = v; bi = j; } }
          { const float ov = swz_xor<1>(bv); const int oi = swz_xor_i<1>(bi); if (ov > bv || (ov == bv && oi < bi)) { bv = ov; bi = oi; } }
          { const float ov = swz_xor<2>(bv); const int oi = swz_xor_i<2>(bi); if (ov > bv || (ov == bv && oi < bi)) { bv = ov; bi = oi; } }
          { const float ov = swz_xor<4>(bv); const int oi = swz_xor_i<4>(bi); if (ov > bv || (ov == bv && oi < bi)) { bv = ov; bi = oi; } }
          NSA_SETBIT(bi);
          if (sub == 0) imp[q8 * 128 + bi] = -1.0f;
          LDS_WAIT(); asm volatile("" ::: "memory");
      }
#undef NSA_SETBIT
      if (sub == 0) { selm[q8 * 4 + 0] = mk0; selm[q8 * 4 + 1] = mk1; selm[q8 * 4 + 2] = mk2; selm[q8 * 4 + 3] = mk3; }
      LDS_WAIT(); asm volatile("" ::: "memory");
    }
    unsigned mk[4], uni[4];
#pragma unroll
    for (int w = 0; w < 4; ++w) { mk[w] = selm[qi * 4 + w]; unsigned u = mk[w]; u |= (unsigned)swz_xor_i<4>((int)u); u |= (unsigned)swz_xor_i<8>((int)u); u |= (unsigned)swz_xor_i<16>((int)u); uni[w] = (unsigned)__builtin_amdgcn_readfirstlane((int)u); }
    { const float* rc = (const float*)(F.ws + WS_ROPE_C) + (size_t)tg * 8; const float* rs = (const float*)(F.ws + WS_ROPE_S) + (size_t)tg * 8; float nv[8];
#pragma unroll
      for (int j = 0; j < 8; ++j) { const float mine = bf2f((unsigned short)qf[0][j]); const float oth = half_other(mine, hi); const float c = rc[j], sn = rs[j]; nv[j] = hi ? (mine * c + oth * sn) : (mine * c - oth * sn); }
      v4u w;
#pragma unroll
      for (int k = 0; k < 4; ++k) w[k] = pk2(nv[2 * k], nv[2 * k + 1]);
      qf[0] = __builtin_bit_cast(bf16x8v, w); }
    soft_init(st);
#pragma unroll 1
    for (int w = 0; w < 4; ++w) {
        unsigned u = (w == 0) ? uni[0] : (w == 1) ? uni[1] : (w == 2) ? uni[2] : uni[3];
        const unsigned mkw = (w == 0) ? mk[0] : (w == 1) ? mk[1] : (w == 2) ? mk[2] : mk[3];
        while (u) {
            const int j = __builtin_ctz(u); u &= u - 1u; const int jb = 32 * w + j; const bool member = (mkw >> j) & 1u;
#pragma unroll 1
            for (int hf = 0; hf < 2; ++hf) {
                load_tile(stream_tile(F, 0, b, 2 * jb + hf), stream_tile(F, 1, b, 2 * jb + hf), F.lane, kf, vf);
                f32x16 s = qk_tile(kf, qf);
#pragma unroll
                for (int r = 0; r < 16; ++r) s[r] = (member && (64 * jb + 32 * hf + CROW(r, hi) <= t)) ? s[r] * QK_C : -INFINITY;
                soft_pv(st, s, vf);
            }
        }
    }
    { const float lt = half_sum(st.l); const float sc = g1 / lt; ot0 = ot0 + st.o0 * sc; ot1 = ot1 + st.o1 * sc; }
    soft_init(st);
    { const int lo_t = (t0 >= 511 ? t0 - 511 : 0) >> 5, hi_t = (t0 + 7) >> 5;
#pragma unroll 1
      for (int tl = lo_t; tl <= hi_t; ++tl) {
          load_tile(stream_tile(F, 2, b, tl), stream_tile(F, 3, b, tl), F.lane, kf, vf);
          f32x16 s = qk_tile(kf, qf);
#pragma unroll
          for (int r = 0; r < 16; ++r) { const int kp = 32 * tl + CROW(r, hi); s[r] = (kp <= t && kp + 511 >= t) ? s[r] * QK_C : -INFINITY; }
          soft_pv(st, s, vf);
      } }
    { const float lt = half_sum(st.l); const float sc = g2 / lt; ot0 = ot0 + st.o0 * sc; ot1 = ot1 + st.o1 * sc; }
    store_ot(O + (size_t)tg * 1024 + 64 * head, ot0, ot1, 1.0f, hi);
    LDS_WAIT(); asm volatile("" ::: "memory");
}

__device__ __forceinline__ int pack_tok(int mode, int tile, int i) {
    if (mode == 0) return 32 * tile + i;
    if (mode == 1) return (tile >> 6) + 4 * (32 * (tile & 63) + i);
    return (tile >> 4) + 16 * (32 * (tile & 15) + i);
}
__device__ __forceinline__ void phase_pack(Frame& F, const float* fox_b) {
    const bf16* P = (const bf16*)(F.ws + WS_PROJ);
    LAS unsigned char* vs = F.lds + 73728 + F.wave * 4608;
    for (int it = F.gw; it < 44 * 512; it += F.NGW) {
        const int sid = it >> 9, b = (it >> 8) & 1, tile = it & 255;
        int col, isv, mode;
        if (sid < 4) { col = (sid == 0) ? C_KSL : (sid == 1) ? C_VSL : (sid == 2) ? C_KW : C_VW; isv = sid & 1; mode = 0; }
        else if (sid < 16) { col = C_BK + 64 * (sid & 3); isv = 0; mode = (sid - 4) >> 2; }
        else if (sid < 28) { col = C_BV + 64 * (sid & 3); isv = 1; mode = (sid - 16) >> 2; }
        else if (sid < 32) { col = C_CK + 64 * (sid & 3); isv = 0; mode = 0; }
        else if (sid < 36) { col = C_CV + 64 * (sid & 3); isv = 1; mode = 0; }
        else if (sid < 40) { col = C_DK + 64 * (sid & 3); isv = 0; mode = 0; }
        else { col = C_DV + 64 * (sid & 3); isv = 1; mode = 0; }
        char* dst = (char*)(F.ws + WS_TILED) + (size_t)sid * (2 * MiB) + (size_t)b * MiB + (size_t)tile * 4096;
        if (!isv) {
            const int r32 = F.lane & 31, hi = F.lane >> 5; const bf16* src = P + (size_t)(b * SEQ + pack_tok(mode, tile, r32)) * NP + col + 8 * hi;
#pragma unroll
            for (int d0 = 0; d0 < 4; ++d0) *(v4u*)(dst + d0 * 1024 + F.lane * 16) = *(const v4u*)(src + 16 * d0);
        } else {
            const int key = F.lane >> 1, half = F.lane & 1; const bf16* src = P + (size_t)(b * SEQ + pack_tok(mode, tile, key)) * NP + col + 32 * half;
#pragma unroll
            for (int i = 0; i < 4; ++i) *(LAS v4u*)(vs + key * 144 + half * 64 + i * 16) = *(const v4u*)(src + 8 * i);
            LDS_WAIT(); asm volatile("" ::: "memory");
            const int r32 = F.lane & 31, hi = F.lane >> 5;
#pragma unroll
            for (int f = 0; f < 4; ++f) { const int db = f >> 1, s2 = f & 1; v4u w;
#pragma unroll
                for (int k = 0; k < 4; ++k) { const int j0 = 2 * k, j1 = 2 * k + 1;
                    const int k0 = 16 * s2 + 8 * (j0 >> 2) + 4 * hi + (j0 & 3), k1 = 16 * s2 + 8 * (j1 >> 2) + 4 * hi + (j1 & 3);
                    const unsigned e0 = *(const LAS unsigned short*)(vs + k0 * 144 + (32 * db + r32) * 2), e1 = *(const LAS unsigned short*)(vs + k1 * 144 + (32 * db + r32) * 2);
                    w[k] = e0 | (e1 << 16); }
                *(v4u*)(dst + f * 1024 + F.lane * 16) = w; }
            LDS_WAIT(); asm volatile("" ::: "memory");
        }
    }
    {
        float* LCo = (float*)(F.ws + WS_LC); float* TCo = (float*)(F.ws + WS_TC);
        for (int it = F.gw; it < 2 * 256; it += F.NGW) {
            const int b = it >> 8, ch = it & 255, i = F.lane & 31;
            const bf16* prow = P + (size_t)(b * SEQ + 32 * ch + i) * NP + C_DF;
#pragma unroll
            for (int h = 0; h < 4; ++h) {
                float v = log_sigmoid(bf2f(prow[h]) + fox_b[h]) * LOG2E;
                float acc = v;
#pragma unroll
                for (int sft = 1; sft < 32; sft <<= 1) { const float o = __shfl_up(acc, sft, 32); if (i >= sft) acc += o; }
                if (F.lane < 32) { LCo[((size_t)b * 4 + h) * SEQ + 32 * ch + i] = acc; if (i == 31) TCo[((size_t)b * 4 + h) * 256 + ch] = acc; }
            }
        }
    }
}

__device__ __forceinline__ void phase_attention(Frame& F, const float* fox_b, const float* qk_gain) {
    for (int it = F.gw; it < 4 * 2048; it += F.NGW) {
        const int ty = it >> 11, sub = it & 2047;
        if (ty == 0) attn_nsa_unit(F, sub);
        else if (ty == 1) attn_dil_unit(F, sub);
        else if (ty == 2) attn_fox_unit(F, sub, qk_gain + 7 * 64);
        else attn_sb_unit(F, sub);
    }
}

__device__ __forceinline__ void phase_combine(Frame& F, float* out, const float* gate) {
    const bf16* Y = (const bf16*)(F.ws + WS_Y); const int* info = (const int*)(F.ws + WS_TOKINFO);
    int pre[8]; { int p = 0;
#pragma unroll
        for (int e = 0; e < 8; ++e) { int n = (int)__hip_atomic_load(F.ctl + CW_MOECNT + 64 * e, RLX_AGENT); if (n > 16384) n = 16384; pre[e] = p; p += (n + 255) >> 8; } }
    for (int m = F.gw; m < M; m += F.NGW) {
        const int b = m >> 13; const int* ip = info + (size_t)m * 8;
        const int e0 = ip[0], r0 = ip[1], e1 = ip[4], r1 = ip[5]; const float g0 = __int_as_float(ip[2]), g1 = __int_as_float(ip[6]);
        int p0 = 0, p1 = 0;
#pragma unroll
        for (int e = 0; e < 8; ++e) { if (e == e0) p0 = pre[e]; if (e == e1) p1 = pre[e]; }
        const bf16* y0 = Y + ((size_t)p0 * 256 + r0) * 1024; const bf16* y1 = Y + ((size_t)p1 * 256 + r1) * 1024;
#pragma unroll
        for (int j = 0; j < 4; ++j) { const int c = 4 * F.lane + 256 * j;
            const uint2 a0 = *(const uint2*)(y0 + c), a1 = *(const uint2*)(y1 + c); const f32x4 gv = *(const f32x4*)(gate + (size_t)b * 6144 + c); f32x4 xv = *(const f32x4*)(out + (size_t)m * D + c);
            xv.x += gv.x * (g0 * __uint_as_float(a0.x << 16) + g1 * __uint_as_float(a1.x << 16));
            xv.y += gv.y * (g0 * __uint_as_float(a0.x & 0xffff0000u) + g1 * __uint_as_float(a1.x & 0xffff0000u));
            xv.z += gv.z * (g0 * __uint_as_float(a0.y << 16) + g1 * __uint_as_float(a1.y << 16));
            xv.w += gv.w * (g0 * __uint_as_float(a0.y & 0xffff0000u) + g1 * __uint_as_float(a1.y & 0xffff0000u));
            *(f32x4*)(out + (size_t)m * D + c) = xv; }
    }
}

constexpr int PH_PER_LAYER = 11, N_PHASES = 1 + 2 * PH_PER_LAYER;
extern __shared__ __attribute__((aligned(16))) unsigned char lds_dyn[];
#define SITE_PROLOGUE() Frame F; ArgsP ap = (ArgsP)__builtin_amdgcn_kernarg_segment_ptr(); asm volatile("" : "+s"(ap)); l = __builtin_amdgcn_readfirstlane(l); \
    F.lds = (LAS unsigned char*)lds_dyn; F.lane = lane_id_fresh(); F.wave = wave0; F.tid = F.wave * 64 + F.lane; \
    F.G = gridDim.x; F.gw = blockIdx.x * NWAVES + F.wave; F.NGW = F.G * NWAVES; F.ws = ap->ws; F.ctl = (gu32*)(F.ws + WS_CTL); \
    float* const out = ap->out; const float* const modl = (const float*)(F.ws + WS_MOD) + (size_t)l * 2 * 6144; (void)out; (void)modl
static __device__ __forceinline__ void site_prologue(int l, int wave0) { SITE_PROLOGUE(); phase_prologue(F, ap); }
static __device__ __forceinline__ void site_norm_mix(int l, int wave0) { SITE_PROLOGUE(); const float* xin = (l == 0) ? (const float*)ap->in[0] : (const float*)out;
    phase_norm<false>(F, xin, (const float*)ap->in[5] + l * 1024, modl + 0, modl + 1024, nullptr); }
static __device__ __forceinline__ void site_gemm_in(int l, int wave0) { SITE_PROLOGUE();
    pg8::Gemm g{(const bf16*)(F.ws + WS_H), (const bf16*)(F.ws + WS_WIN) + (size_t)l * NP * 1024, 1024, 1024}; pg8::StaticOrder S; S.init(M, NP, F.G, (int)blockIdx.x);
    pg8::EpiStore E{(bf16*)(F.ws + WS_PROJ), NP};
    pg8::gemm_phase<pg8::EpiStore, pg8::StaticOrder, true, false>(F.lds, g, S, E, F.tid); }
static __device__ __forceinline__ void site_qknorm(int l, int wave0) { SITE_PROLOGUE(); phase_qknorm(F, (const float*)ap->in[8] + l * 512); }
static __device__ __forceinline__ void site_compress(int l, int wave0) { SITE_PROLOGUE(); phase_compress(F, (const float*)ap->in[9] + l * 2048, (const float*)ap->in[10] + l * 2048, (const float*)ap->in[11] + (size_t)l * 2048 * 128, (const float*)ap->in[12] + l * 128 * 64,
                                       (const float*)ap->in[13] + (size_t)l * 2048 * 128, (const float*)ap->in[14] + l * 128 * 64);
    phase_pack(F, (const float*)ap->in[15] + l * 4); }
static __device__ __forceinline__ void site_attention(int l, int wave0) { SITE_PROLOGUE(); phase_attention(F, (const float*)ap->in[15] + l * 4, (const float*)ap->in[8] + l * 512); }
static __device__ __forceinline__ void site_gemm_branch(int l, int wave0) { SITE_PROLOGUE();
    pg8::Gemm g{(const bf16*)(F.ws + WS_O), (const bf16*)(F.ws + WS_WBR) + (size_t)l * 4 * 1024 * 256, 1024, 256}; pg8::BranchOrder S; S.init(M, 1024, F.G, (int)blockIdx.x);
    pg8::EpiGate E{(const bf16*)(F.ws + WS_PROJ), NP, C_MG, (float*)(F.ws + WS_GACC), (bf16*)(F.ws + WS_H)};
    pg8::gemm_phase<pg8::EpiGate, pg8::BranchOrder, false, false>(F.lds, g, S, E, F.tid); }
static __device__ __forceinline__ void site_gemm_out(int l, int wave0) { SITE_PROLOGUE(); const float* xin = (l == 0) ? (const float*)ap->in[0] : (const float*)out;
    pg8::Gemm g{(const bf16*)(F.ws + WS_H), (const bf16*)(F.ws + WS_WOUT) + (size_t)l * 1024 * 1024, 1024, 1024}; pg8::StaticOrder S; S.init(M, 1024, F.G, (int)blockIdx.x);
    pg8::EpiResid E{xin, out, modl + 2048, 6144};
    pg8::gemm_phase<pg8::EpiResid, pg8::StaticOrder, false, false>(F.lds, g, S, E, F.tid); }
static __device__ __forceinline__ void site_norm_ffn(int l, int wave0) { SITE_PROLOGUE();
    if (l == 0) phase_norm<false>(F, out, (const float*)ap->in[6] + l * 1024, modl + 3 * 1024, modl + 4 * 1024, nullptr);
    else { phase_norm<true>(F, out, (const float*)ap->in[6] + l * 1024, modl + 3 * 1024, modl + 4 * 1024, (const float*)ap->in[21]); phase_moe_weights(F, ap); } }
static __device__ __forceinline__ void site_gemm_up_dense(int l, int wave0) { SITE_PROLOGUE();
    pg8::Gemm g{(const bf16*)(F.ws + WS_H), (const bf16*)(F.ws + WS_W13), 1024, 1024}; pg8::StaticOrder S; S.init(M, 2 * DFF, F.G, (int)blockIdx.x);
    pg8::EpiSwiglu E{(bf16*)(F.ws + WS_HMID), DFF};
    pg8::gemm_phase<pg8::EpiSwiglu, pg8::StaticOrder, true, false>(F.lds, g, S, E, F.tid); }
static __device__ __forceinline__ void site_gemm_up_moe(int l, int wave0) { SITE_PROLOGUE();
    pg8::Gemm g{(const bf16*)(F.ws + WS_H), (const bf16*)(F.ws + WS_MOEW13), 1024, 1024}; pg8::MoeOrder S; S.init((unsigned*)(F.ctl + CW_MOECNT), (const int*)(F.ws + WS_LIST), 2 * DFF / 256, (size_t)2 * DFF * 1024, F.G, (int)blockIdx.x);
    pg8::EpiSwiglu E{(bf16*)(F.ws + WS_HMID_MOE), DFF};
    pg8::gemm_phase<pg8::EpiSwiglu, pg8::MoeOrder, true, true>(F.lds, g, S, E, F.tid); }
static __device__ __forceinline__ void site_gemm_down_dense(int l, int wave0) { SITE_PROLOGUE();
    pg8::Gemm g{(const bf16*)(F.ws + WS_HMID), (const bf16*)(F.ws + WS_W2), DFF, DFF}; pg8::StaticOrder S; S.init(M, 1024, F.G, (int)blockIdx.x);
    pg8::EpiResid E{out, out, modl + 5 * 1024, 6144};
    pg8::gemm_phase<pg8::EpiResid, pg8::StaticOrder, false, false>(F.lds, g, S, E, F.tid); }
static __device__ __forceinline__ void site_gemm_down_moe(int l, int wave0) { SITE_PROLOGUE();
    pg8::Gemm g{(const bf16*)(F.ws + WS_HMID_MOE), (const bf16*)(F.ws + WS_MOEW2), DFF, DFF}; pg8::MoeOrder S; S.init((unsigned*)(F.ctl + CW_MOECNT), (const int*)(F.ws + WS_LIST), 4, (size_t)1024 * DFF, F.G, (int)blockIdx.x);
    pg8::EpiStore E{(bf16*)(F.ws + WS_Y), 1024};
    pg8::gemm_phase<pg8::EpiStore, pg8::MoeOrder, true, false>(F.lds, g, S, E, F.tid); }
static __device__ __forceinline__ void site_combine(int l, int wave0) { SITE_PROLOGUE(); phase_combine(F, out, modl + 5 * 1024); }

__global__ void __launch_bounds__(NWAVES * 64, 2) fwd_kernel(Args args_unused) {
    (void)args_unused;
    const ArgsP ap0 = (ArgsP)__builtin_amdgcn_kernarg_segment_ptr();
    const int wave0 = __builtin_amdgcn_readfirstlane((int)threadIdx.x >> 6);
    LAS unsigned char* lds = (LAS unsigned char*)lds_dyn;
    volatile LAS unsigned* MISC = (volatile LAS unsigned*)(lds + MISC_OFF);
    for (int u = wave0 * 64 + lane_id_fresh(); u < (LDS_BYTES - RING_BYTES) / 4; u += NWAVES * 64) ((LAS unsigned*)(lds + RING_BYTES))[u] = 0u;
    __syncthreads();
    const int lo = ap0->ph_lo, hi = ap0->ph_hi;
    unsigned* barw = (unsigned*)(ap0->ws + WS_CTL) + CW_BAR;
    XcdBarrier bar; bar.bar = barw; bar.x = 0; bar.st = nullptr;
#define LEADER() (wave0 == 0 && lane_id_fresh() == 0)
    if (hi - lo > 1) bar = xcd_barrier_post(barw, MISC + 8, LEADER());
#define IN(k) (lo <= (k) && (k) < hi)
#define SEAM(k) do { if (IN(k) && IN((k) + 1)) xcd_barrier(bar, LEADER()); } while (0)
    if (PHON(0) && IN(0)) site_prologue(0, wave0);
    SEAM(0);
    for (int l = 0; l < 2; ++l) {
        const int pb = 1 + l * PH_PER_LAYER;
        if (PHON(1) && IN(pb + 0)) site_norm_mix(l, wave0);
        SEAM(pb + 0);
        if (PHON(2) && IN(pb + 1)) site_gemm_in(l, wave0);
        SEAM(pb + 1);
        if (PHON(3) && IN(pb + 2)) site_qknorm(l, wave0);
        SEAM(pb + 2);
        if (PHON(4) && IN(pb + 3)) site_compress(l, wave0);
        SEAM(pb + 3);
        if (PHON(5) && IN(pb + 4)) site_attention(l, wave0);
        SEAM(pb + 4);
        if (PHON(6) && IN(pb + 5)) site_gemm_branch(l, wave0);
        SEAM(pb + 5);
        if (PHON(7) && IN(pb + 6)) site_gemm_out(l, wave0);
        SEAM(pb + 6);
        if (PHON(8) && IN(pb + 7)) site_norm_ffn(l, wave0);
        SEAM(pb + 7);
        if (PHON(9) && IN(pb + 8)) { if (l == 0) site_gemm_up_dense(l, wave0); else site_gemm_up_moe(l, wave0); }
        SEAM(pb + 8);
        if (PHON(10) && IN(pb + 9)) { if (l == 0) site_gemm_down_dense(l, wave0); else site_gemm_down_moe(l, wave0); }
        SEAM(pb + 9);
        if (PHON(11) && IN(pb + 10)) { if (l == 1) site_combine(l, wave0); }
    }
#undef IN
#undef SEAM
}

extern "C" void kernel_launch(void* const* d_in, const int* in_sizes, int n_in, void* d_out, int out_size, void* d_ws, size_t ws_size, hipStream_t stream) {
    static int grid = 0;
    if (grid == 0) {
        if (n_in != 25 || out_size != M * D || ws_size < WS_END) { fprintf(stderr, "kernel_launch: unexpected problem (n_in %d, out %d, ws %zu < %zu)\n", n_in, out_size, ws_size, (size_t)WS_END); grid = -1; return; }
        int dev = 0, cus = 0, per_cu = 0;
        if (hipGetDevice(&dev) != hipSuccess || hipDeviceGetAttribute(&cus, hipDeviceAttributeMultiprocessorCount, dev) != hipSuccess) { grid = -1; return; }
        if (hipFuncSetAttribute((const void*)fwd_kernel, hipFuncAttributeMaxDynamicSharedMemorySize, LDS_BYTES) != hipSuccess) { fprintf(stderr, "kernel_launch: hipFuncSetAttribute failed\n"); grid = -1; return; }
        if (hipOccupancyMaxActiveBlocksPerMultiprocessor(&per_cu, (const void*)fwd_kernel, NWAVES * 64, LDS_BYTES) != hipSuccess || per_cu < 1) fprintf(stderr, "kernel_launch: occupancy query reports %d\n", per_cu);
        (void)hipGetLastError();
        grid = cus;
    }
    if (grid < 0) return;
    if (hipMemsetAsync((char*)d_ws + WS_CTL, 0, CTL_ZERO_BYTES, stream) != hipSuccess) return;
    Args a{};
    for (int i = 0; i < 25; ++i) a.in[i] = d_in[i];
    a.out = (float*)d_out; a.ws = (unsigned char*)d_ws;
#if MK_ONE_LAUNCH
    a.ph_lo = 0; a.ph_hi = N_PHASES;
    hipLaunchKernelGGL(fwd_kernel, dim3(grid), dim3(NWAVES * 64), LDS_BYTES, stream, a);
#else
    for (int p = 0; p < N_PHASES; ++p) {
        if (p == 1 + 10) continue;
        a.ph_lo = p; a.ph_hi = p + 1;
        hipLaunchKernelGGL(fwd_kernel, dim3(grid), dim3(NWAVES * 64), LDS_BYTES, stream, a);
    }
#endif
}
```

```cpp
#include <hip/hip_runtime.h>
#include <cstdio>
#include <cstdint>

#ifndef MK_ONE_LAUNCH
#define MK_ONE_LAUNCH 1
#endif
#ifndef PHMASK
#define PHMASK 0xFFFFu
#endif
#define PHON(k) (((PHMASK) >> (k)) & 1u)
#ifndef DUPMASK
#define DUPMASK 0u
#endif
#define DUP(k) ((dupm >> ((k) + 12 * l)) & 1u)

namespace pg8 {
#define PG8_LAS __attribute__((address_space(3)))
typedef unsigned short bf16_t;
typedef short bf16x8 __attribute__((ext_vector_type(8)));
typedef float f32x4 __attribute__((ext_vector_type(4)));
typedef unsigned u32x4 __attribute__((ext_vector_type(4)));
constexpr int BM = 256, BK = 64, HALF = 128, HTB = HALF * BK * 2, STAGE_BYTES = 8 * HTB, NXCD = 8, WGM = 8;

__host__ __device__ __forceinline__ int lds_byte(int r, int c) { const int st = (r >> 4) * 2 + (c >> 5), rr = r & 15, cc = c & 31, ob = rr * 64 + cc * 2; return st * 1024 + (ob ^ (((ob >> 9) & 1) << 5)); }
__host__ __device__ __forceinline__ void stage_rc(int b, int& R, int& C) { const int st = b / 1024, sb = b % 1024, swz = sb ^ (((sb >> 9) & 1) << 5); R = (st >> 1) * 16 + swz / 64; C = (st & 1) * 32 + (swz % 64) / 2; }
__host__ __device__ __forceinline__ int perm32(int rho) { const int n = rho >> 4, i = rho & 15; return 8 * (i >> 2) + 4 * n + (i & 3); }

struct Unit { int pm, pn, z; };
struct Gemm { const bf16_t* A; const bf16_t* Bt; int lda; int K; };

__host__ __device__ __forceinline__ void tile_pmpn(int wgid, int nM, int nN, int& pm, int& pn) {
    const int nwg = nM * nN;
    { const int q = nwg / NXCD, r = nwg % NXCD, xcd = wgid % NXCD, off = wgid / NXCD; wgid = (xcd < r ? xcd * (q + 1) : r * (q + 1) + (xcd - r) * q) + off; }
    const int nig = WGM * nN, gid = wgid / nig, fm = gid * WGM, gsz = (nM - fm) < WGM ? (nM - fm) : WGM;
    pm = fm + ((wgid % nig) % gsz); pn = (wgid % nig) / gsz;
}
struct StaticOrder {
    int nM, nN, nwg, G, c;
    __device__ void init(int M, int N, int G_, int c_) { nM = M / BM; nN = N / BM; nwg = nM * nN; G = G_; c = c_; }
    __device__ bool next(int i, Unit& u) const { const long L = (long)i * G + c; if (L >= nwg) return false; tile_pmpn((int)L, nM, nN, u.pm, u.pn); u.z = 0; return true; }
    __device__ const char* a_base(const Gemm& g, const Unit& u) const { return (const char*)g.A + (size_t)u.pm * BM * g.lda * 2; }
    __device__ const char* b_base(const Gemm& g, const Unit& u) const { return (const char*)g.Bt + (size_t)u.pn * BM * g.K * 2; }
    __device__ int row_tok(const Unit&, int) const { return 0; }
};
struct MoeOrder {
    int G, c, nN; int pre[9]; const int* list; int cnt[8]; size_t zstrideB;
    __device__ void init(unsigned* counts, const int* list_, int nN_, size_t zstrideB_, int G_, int c_) {
        G = G_; c = c_; nN = nN_; list = list_; zstrideB = zstrideB_; int p = 0;
#pragma unroll
        for (int e = 0; e < 8; ++e) { int n = __builtin_amdgcn_readfirstlane((int)__hip_atomic_load(counts + 64 * e, __ATOMIC_RELAXED, __HIP_MEMORY_SCOPE_AGENT)); if (n > 16384) n = 16384; cnt[e] = n; pre[e] = p; p += (n + 255) >> 8; }
        pre[8] = p;
    }
    __device__ bool next(int i, Unit& u) const {
        const long L = (long)i * G + c; if (L >= (long)pre[8] * nN) return false;
        const int rt = (int)(L / nN); u.pn = (int)(L % nN); u.pm = rt; int e = 0;
#pragma unroll
        for (int k = 1; k < 8; ++k) e += (rt >= pre[k]) ? 1 : 0;
        u.z = e; return true;
    }
    __device__ const char* a_base(const Gemm& g, const Unit& u) const { return (const char*)g.A + (size_t)u.pm * BM * g.lda * 2; }
    __device__ const char* b_base(const Gemm& g, const Unit& u) const { return (const char*)g.Bt + ((size_t)u.z * zstrideB + (size_t)u.pn * BM * g.K) * 2; }
    __device__ int row_tok(const Unit& u, int r) const {
        int e = 0, c0 = 0, p0 = 0;
#pragma unroll
        for (int k = 0; k < 8; ++k) if (k == u.z) { c0 = cnt[k]; p0 = pre[k]; }
        const int idx = (u.pm - p0) * 256 + r; (void)e;
        return idx < c0 ? list[u.z * 16384 + idx] : 0;
    }
};

__device__ __forceinline__ int lane_id_fresh_pg8() { int l; asm volatile("v_mbcnt_lo_u32_b32 %0, -1, 0\n\tv_mbcnt_hi_u32_b32 %0, -1, %0" : "=v"(l)); return l; }
__device__ __forceinline__ unsigned cvt_pk_bf16(float lo, float hi) { unsigned r; asm volatile("v_cvt_pk_bf16_f32 %0, %1, %2" : "=v"(r) : "v"(lo), "v"(hi)); return r; }

struct EpiStore {
    static constexpr bool PERM = true, MID = false;
    bf16_t* O; int ldc;
    __device__ __forceinline__ void operator()(const f32x4 (&acc)[2][2][4][2], const Unit& u, int wr, int wc, int fr, int fq) const {
        const unsigned base = ((unsigned)(u.pm * BM + wr * 64 + fr) * (unsigned)ldc + (unsigned)(u.pn * BM + wc * 32 + 8 * fq)) * 2u;
        char* Ob = (char*)O;
#pragma unroll
        for (int ai = 0; ai < 2; ++ai)
#pragma unroll
            for (int m = 0; m < 4; ++m) { const unsigned off = base + (unsigned)((ai * HALF + m * 16) * 2) * (unsigned)ldc;
#pragma unroll
                for (int bj = 0; bj < 2; ++bj) { const f32x4 v0 = acc[ai][bj][m][0], v1 = acc[ai][bj][m][1];
                    u32x4 w; w.x = cvt_pk_bf16(v0[0], v0[1]); w.y = cvt_pk_bf16(v0[2], v0[3]); w.z = cvt_pk_bf16(v1[0], v1[1]); w.w = cvt_pk_bf16(v1[2], v1[3]);
                    *(u32x4*)(Ob + (off + (unsigned)(bj * HALF * 2))) = w; } }
    }
};
__device__ __forceinline__ float silu_f(float a) { return a * __builtin_amdgcn_rcpf(1.0f + __expf(-a)); }
struct EpiSwiglu {
    static constexpr bool PERM = true, MID = false;
    bf16_t* O; int ldc;
    __device__ __forceinline__ void operator()(const f32x4 (&acc)[2][2][4][2], const Unit& u, int wr, int wc, int fr, int fq) const {
        const unsigned base = ((unsigned)(u.pm * BM + wr * 64 + fr) * (unsigned)ldc + (unsigned)(u.pn * HALF + wc * 32 + 8 * fq)) * 2u;
        char* Ob = (char*)O;
#pragma unroll
        for (int ai = 0; ai < 2; ++ai)
#pragma unroll
            for (int m = 0; m < 4; ++m) { const unsigned off = base + (unsigned)((ai * HALF + m * 16) * 2) * (unsigned)ldc;
                float h[8];
#pragma unroll
                for (int n = 0; n < 2; ++n)
#pragma unroll
                    for (int j = 0; j < 4; ++j) h[n * 4 + j] = silu_f(acc[ai][0][m][n][j]) * acc[ai][1][m][n][j];
                u32x4 w; w.x = cvt_pk_bf16(h[0], h[1]); w.y = cvt_pk_bf16(h[2], h[3]); w.z = cvt_pk_bf16(h[4], h[5]); w.w = cvt_pk_bf16(h[6], h[7]);
                *(u32x4*)(Ob + off) = w; }
    }
};
struct EpiResid {
    static constexpr bool PERM = false, MID = false;
    const float* xin; float* out; const float* gate; int gate_bstride;
    __device__ __forceinline__ void operator()(const f32x4 (&acc)[2][2][4][2], const Unit& u, int wr, int wc, int fr, int fq) const {
        const int b = (u.pm * BM) >> 13; const int col0 = u.pn * BM + wc * 32 + 4 * fq;
        f32x4 gv[2][2];
#pragma unroll
        for (int bj = 0; bj < 2; ++bj)
#pragma unroll
            for (int n = 0; n < 2; ++n) gv[bj][n] = *(const f32x4*)(gate + (size_t)b * gate_bstride + col0 + bj * HALF + n * 16);
        const unsigned base = ((unsigned)(u.pm * BM + wr * 64 + fr) * 1024u + (unsigned)col0) * 4u;
        const char* xb = (const char*)xin; char* ob = (char*)out;
#pragma unroll
        for (int ai = 0; ai < 2; ++ai)
#pragma unroll
            for (int m = 0; m < 4; ++m) { const unsigned off = base + (unsigned)((ai * HALF + m * 16) * 4096);
#pragma unroll
                for (int bj = 0; bj < 2; ++bj)
#pragma unroll
                    for (int n = 0; n < 2; ++n) { const unsigned o2 = off + (unsigned)((bj * HALF + n * 16) * 4); const f32x4 xi = *(const f32x4*)(xb + o2); *(f32x4*)(ob + o2) = xi + gv[bj][n] * acc[ai][bj][m][n]; }
                if (m & 1) asm volatile("" ::: "memory"); }
    }
};
__device__ __forceinline__ float sigmoid_f(float a) { return __builtin_amdgcn_rcpf(1.0f + __expf(-a)); }
struct EpiStoreMG {
    static constexpr bool PERM = true, MID = false;
    bf16_t* O; int ldc;
    __device__ __forceinline__ void operator()(const f32x4 (&acc)[2][2][4][2], const Unit& u, int wr, int wc, int fr, int fq) const {
        const unsigned base = ((unsigned)(u.pm * BM + wr * 64 + fr) * (unsigned)ldc + (unsigned)(u.pn * BM + wc * 32 + 8 * fq)) * 2u;
        char* Ob = (char*)O; const bool mg = u.pn >= 12;
#pragma unroll
        for (int ai = 0; ai < 2; ++ai)
#pragma unroll
            for (int m = 0; m < 4; ++m) { const unsigned off = base + (unsigned)((ai * HALF + m * 16) * 2) * (unsigned)ldc;
#pragma unroll
                for (int bj = 0; bj < 2; ++bj) { f32x4 v0 = acc[ai][bj][m][0], v1 = acc[ai][bj][m][1];
                    if (mg) {
#pragma unroll
                        for (int k = 0; k < 4; ++k) { v0[k] = fminf(1.0f + __expf(-v0[k]), 1.0e18f); v1[k] = fminf(1.0f + __expf(-v1[k]), 1.0e18f); } }
                    u32x4 w; w.x = cvt_pk_bf16(v0[0], v0[1]); w.y = cvt_pk_bf16(v0[2], v0[3]); w.z = cvt_pk_bf16(v1[0], v1[1]); w.w = cvt_pk_bf16(v1[2], v1[3]);
                    *(u32x4*)(Ob + (off + (unsigned)(bj * HALF * 2))) = w; } }
    }
};
struct EpiGateMerge {
    static constexpr bool PERM = true, MID = true;
    const bf16_t* proj; int ldp; int cmg; bf16_t* gated;
    __device__ __forceinline__ void mid(f32x4 (&acc)[2][2][4][2], const Unit& u, int z  , int wr, int wc, int fr, int fq) const {
        const unsigned pbase = ((unsigned)(u.pm * BM + wr * 64 + fr) * (unsigned)ldp + (unsigned)(cmg + (z - 1) * 1024 + u.pn * BM + wc * 32 + 8 * fq)) * 2u;
        const char* pb = (const char*)proj;
#pragma unroll
        for (int ai = 0; ai < 2; ++ai)
#pragma unroll
            for (int m = 0; m < 4; ++m) { const unsigned off = pbase + (unsigned)((ai * HALF + m * 16) * 2) * (unsigned)ldp;
#pragma unroll
                for (int bj = 0; bj < 2; ++bj) {
                    const u32x4 ip = *(const u32x4*)(pb + (off + (unsigned)(bj * HALF * 2))), in = *(const u32x4*)(pb + (off + (unsigned)(bj * HALF * 2) + 2048u));
#pragma unroll
                    for (int k = 0; k < 4; ++k) {
                        const float r0 = __uint_as_float(in[k] << 16) * __builtin_amdgcn_rcpf(__uint_as_float(ip[k] << 16)), r1 = __uint_as_float(in[k] & 0xffff0000u) * __builtin_amdgcn_rcpf(__uint_as_float(ip[k] & 0xffff0000u));
                        acc[ai][bj][m][k >> 1][(2 * k) & 3] *= r0; acc[ai][bj][m][k >> 1][(2 * k + 1) & 3] *= r1; } }
                if (m & 1) asm volatile("" ::: "memory"); }
    }
    __device__ __forceinline__ void operator()(const f32x4 (&acc)[2][2][4][2], const Unit& u, int wr, int wc, int fr, int fq) const {
        const unsigned row0 = (unsigned)(u.pm * BM + wr * 64 + fr), col0 = (unsigned)(u.pn * BM + wc * 32 + 8 * fq);
        const unsigned pbase = (row0 * (unsigned)ldp + (unsigned)(cmg + 3 * 1024) + col0) * 2u, gbase = (row0 * 1024u + col0) * 2u;
        const char* pb = (const char*)proj; char* ob = (char*)gated;
#pragma unroll
        for (int ai = 0; ai < 2; ++ai)
#pragma unroll
            for (int m = 0; m < 4; ++m) { const unsigned rr = (unsigned)(ai * HALF + m * 16);
#pragma unroll
                for (int bj = 0; bj < 2; ++bj) {
                    const u32x4 ig = *(const u32x4*)(pb + (pbase + rr * (unsigned)(ldp * 2) + (unsigned)(bj * HALF * 2)));
                    float v[8];
#pragma unroll
                    for (int k = 0; k < 4; ++k) { v[2 * k] = acc[ai][bj][m][k >> 1][(2 * k) & 3] * __builtin_amdgcn_rcpf(__uint_as_float(ig[k] << 16)); v[2 * k + 1] = acc[ai][bj][m][k >> 1][(2 * k + 1) & 3] * __builtin_amdgcn_rcpf(__uint_as_float(ig[k] & 0xffff0000u)); }
                    u32x4 w; w.x = cvt_pk_bf16(v[0], v[1]); w.y = cvt_pk_bf16(v[2], v[3]); w.z = cvt_pk_bf16(v[4], v[5]); w.w = cvt_pk_bf16(v[6], v[7]);
                    *(u32x4*)(ob + (gbase + rr * 2048u + (unsigned)(bj * HALF * 2))) = w; }
                if (m & 1) asm volatile("" ::: "memory"); }
    }
};

template <class Epi, class Sched, bool ALIGN_EPI, bool GATHER>
__device__ __forceinline__ void gemm_phase(PG8_LAS unsigned char* lds, const Gemm g, const Sched& S, const Epi& E, int tid) {
    asm volatile("" : "+v"(tid));
    const int wid = __builtin_amdgcn_readfirstlane(tid >> 6), lane = tid & 63, wr = wid >> 2, wc = wid & 3, fr = lane & 15, fq = lane >> 4;
    int K = g.K; asm volatile("" : "+s"(K));
    const int nt = K / BK;
    unsigned voffA[2], voffB[2]; int RA[2], CA[2];
#pragma unroll
    for (int i = 0; i < 2; ++i) { int R, C; stage_rc(tid * 16 + i * 8192, R, C); const int Rb = Epi::PERM ? ((R & ~31) + perm32(R & 31)) : R;
        RA[i] = R; CA[i] = C; voffA[i] = (unsigned)(R * g.lda + C) * 2u; voffB[i] = (unsigned)(Rb * K + C) * 2u; }
    const size_t kstep = (size_t)(BK * 2);
    const size_t hstepA = (size_t)HALF * g.lda * 2, hstepB = (size_t)HALF * K * 2;
    const unsigned ldsw = (unsigned)wid * 1024u;
    const int aoff = lds_byte(wr * 64 + fr, fq * 8), boff = lds_byte(wc * 32 + fr, fq * 8);
#define PG8_SA(b, h) (((b) * 2 + (h)) * HTB)
#define PG8_SB(b, h) ((4 + (b) * 2 + (h)) * HTB)
#define PG8_STAGE(bufoff, gbase, voff) do { _Pragma("unroll") for (int _i = 0; _i < 2; ++_i) \
        __builtin_amdgcn_global_load_lds((const unsigned*)((const char*)(gbase) + (voff)[_i]), (PG8_LAS unsigned*)(lds + (bufoff) + ldsw + _i * 8192), 16, 0, 0); } while (0)
#define PG8_STAGE_A(bufoff, kbase, h, GV) do { if constexpr (GATHER) { PG8_STAGE(bufoff, kbase, (GV)[h]); } else { PG8_STAGE(bufoff, (kbase) + (h) * hstepA, voffA); } } while (0)
#define PG8_LDA(dst, b, h) do { _Pragma("unroll") for (int m = 0; m < 4; ++m) _Pragma("unroll") for (int k = 0; k < 2; ++k) dst[m][k] = *(const PG8_LAS bf16x8*)(lds + PG8_SA(b, h) + aoff + m * 2048 + k * 1024); } while (0)
#define PG8_LDB(dst, b, h) do { _Pragma("unroll") for (int n = 0; n < 2; ++n) _Pragma("unroll") for (int k = 0; k < 2; ++k) dst[n][k] = *(const PG8_LAS bf16x8*)(lds + PG8_SB(b, h) + boff + n * 2048 + k * 1024); } while (0)
#define PG8_MMA(ai, bj, At, Bt) do { __builtin_amdgcn_s_setprio(1); _Pragma("unroll") for (int m = 0; m < 4; ++m) _Pragma("unroll") for (int n = 0; n < 2; ++n) _Pragma("unroll") for (int k = 0; k < 2; ++k) \
        acc[ai][bj][m][n] = __builtin_amdgcn_mfma_f32_16x16x32_bf16(Bt[n][k], At[m][k], acc[ai][bj][m][n], 0, 0, 0); __builtin_amdgcn_s_setprio(0); } while (0)
#define PG8_WAIT_V(n) asm volatile("s_waitcnt vmcnt(" #n ")" ::: "memory")
#define PG8_WAIT_L(n) asm volatile("s_waitcnt lgkmcnt(" #n ")" ::: "memory")
#define PG8_BAR __builtin_amdgcn_s_barrier()
#define PG8_SCHED __builtin_amdgcn_sched_barrier(0)
#define PG8_GOFFS(dst, un) do { _Pragma("unroll") for (int _h = 0; _h < 2; ++_h) _Pragma("unroll") for (int _i = 0; _i < 2; ++_i) \
        dst[_h][_i] = (unsigned)S.row_tok(un, _h * HALF + RA[_i]) * (unsigned)(g.lda * 2) + (unsigned)(CA[_i] * 2); } while (0)
    Unit cur, nxt; int ui = 0;
    if (!S.next(0, cur)) return;
    f32x4 acc[2][2][4][2];
#pragma unroll
    for (int a = 0; a < 2; ++a)
#pragma unroll
        for (int b = 0; b < 2; ++b)
#pragma unroll
            for (int m = 0; m < 4; ++m)
#pragma unroll
                for (int n = 0; n < 2; ++n) acc[a][b][m][n] = (f32x4){0.f, 0.f, 0.f, 0.f};
    bf16x8 At[4][2], B0[2][2], B1[2][2];
    unsigned gC[2][2] = {{0u, 0u}, {0u, 0u}}, gN[2][2] = {{0u, 0u}, {0u, 0u}};
    const char* cA = GATHER ? (const char*)g.A : S.a_base(g, cur); const char* cB = S.b_base(g, cur);
    if constexpr (GATHER) { PG8_GOFFS(gC, cur); asm volatile("s_waitcnt vmcnt(0)" ::: "memory"); }
    PG8_STAGE(PG8_SB(0, 0), cB, voffB); PG8_STAGE(PG8_SB(0, 1), cB + hstepB, voffB); PG8_STAGE_A(PG8_SA(0, 0), cA, 0, gC); PG8_STAGE_A(PG8_SA(0, 1), cA, 1, gC);
    if (wr == 1) PG8_BAR;
    PG8_WAIT_V(2); PG8_BAR;
    PG8_STAGE(PG8_SB(1, 0), cB + kstep, voffB); PG8_STAGE_A(PG8_SA(1, 0), cA + kstep, 0, gC); PG8_STAGE(PG8_SB(1, 1), cB + hstepB + kstep, voffB);
    PG8_WAIT_V(6); PG8_BAR;
    for (;;) {
        const bool has_next = S.next(ui + 1, nxt);
        const char* nA = GATHER ? (const char*)g.A : (has_next ? S.a_base(g, nxt) : cA); const char* nB = has_next ? S.b_base(g, nxt) : cB;
        if constexpr (GATHER) {
            if (has_next) { PG8_GOFFS(gN, nxt); }
            else {
#pragma unroll
                for (int _h = 0; _h < 2; ++_h)
#pragma unroll
                    for (int _i = 0; _i < 2; ++_i) gN[_h][_i] = gC[_h][_i];
            }
        }
        for (int t = 0; t < nt; t += 2) {
            if constexpr (Epi::MID) { if (t > 0 && (t & 3) == 0) { const int l2_ = lane_id_fresh_pg8(); E.mid(acc, cur, t >> 2, wr, wc, l2_ & 15, l2_ >> 4); } }
            const bool last = (t == nt - 2);
            const char* a1 = cA + (size_t)(t + 1) * kstep;
            const char* a2 = last ? nA : cA + (size_t)(t + 2) * kstep; const char* b2 = last ? nB : cB + (size_t)(t + 2) * kstep;
            const char* a3 = a2 + kstep; const char* b3 = b2 + kstep;
            unsigned g2[2][2];
            if constexpr (GATHER) {
#pragma unroll
                for (int _h = 0; _h < 2; ++_h)
#pragma unroll
                    for (int _i = 0; _i < 2; ++_i) g2[_h][_i] = last ? gN[_h][_i] : gC[_h][_i];
            }
            PG8_LDB(B0, 0, 0); PG8_LDB(B1, 0, 1); PG8_SCHED; PG8_LDA(At, 0, 0); PG8_STAGE_A(PG8_SA(1, 1), a1, 1, gC);
            PG8_WAIT_V(8); PG8_WAIT_L(0); PG8_BAR; PG8_MMA(0, 0, At, B0); PG8_MMA(0, 1, At, B1); PG8_BAR; PG8_SCHED;
            PG8_LDA(At, 0, 1); PG8_STAGE(PG8_SB(0, 0), b2, voffB); PG8_STAGE(PG8_SB(0, 1), b2 + hstepB, voffB); PG8_STAGE_A(PG8_SA(0, 0), a2, 0, g2);
            PG8_WAIT_V(8); PG8_WAIT_L(0); PG8_BAR; PG8_MMA(1, 0, At, B0); PG8_MMA(1, 1, At, B1); PG8_BAR; PG8_SCHED;
            PG8_LDB(B0, 1, 0); PG8_LDB(B1, 1, 1); PG8_SCHED; PG8_LDA(At, 1, 0); PG8_STAGE_A(PG8_SA(0, 1), a2, 1, g2);
            PG8_WAIT_V(8); PG8_WAIT_L(0); PG8_BAR; PG8_MMA(0, 0, At, B0); PG8_MMA(0, 1, At, B1); PG8_BAR; PG8_SCHED;
            PG8_LDA(At, 1, 1); PG8_STAGE(PG8_SB(1, 0), b3, voffB); PG8_STAGE(PG8_SB(1, 1), b3 + hstepB, voffB); PG8_STAGE_A(PG8_SA(1, 0), a3, 0, g2);
            PG8_WAIT_V(8); PG8_WAIT_L(0); PG8_BAR; PG8_MMA(1, 0, At, B0); PG8_MMA(1, 1, At, B1); PG8_BAR; PG8_SCHED;
        }
        if constexpr (ALIGN_EPI) { if (wr == 0) PG8_BAR; }
        { const int l2_ = lane_id_fresh_pg8();
          E(acc, cur, wr, wc, l2_ & 15, l2_ >> 4); }
        if (!has_next) break;
#pragma unroll
        for (int a = 0; a < 2; ++a)
#pragma unroll
            for (int b = 0; b < 2; ++b)
#pragma unroll
                for (int m = 0; m < 4; ++m)
#pragma unroll
                    for (int n = 0; n < 2; ++n) acc[a][b][m][n] = (f32x4){0.f, 0.f, 0.f, 0.f};
        cur = nxt; cA = nA; cB = nB; ++ui;
        if constexpr (GATHER) {
#pragma unroll
            for (int _h = 0; _h < 2; ++_h)
#pragma unroll
                for (int _i = 0; _i < 2; ++_i) gC[_h][_i] = gN[_h][_i];
        }
        if constexpr (ALIGN_EPI) { if (wr == 1) PG8_BAR; }
    }
    PG8_WAIT_V(0);
    if constexpr (!ALIGN_EPI) { if (wr == 0) PG8_BAR; }
    PG8_BAR;
#undef PG8_SA
#undef PG8_SB
#undef PG8_STAGE
#undef PG8_STAGE_A
#undef PG8_LDA
#undef PG8_LDB
#undef PG8_MMA
#undef PG8_WAIT_V
#undef PG8_WAIT_L
#undef PG8_BAR
#undef PG8_SCHED
#undef PG8_GOFFS
}
}

constexpr int NWAVES = 8;
constexpr int BATCH = 2, SEQ = 8192, D = 1024, M = BATCH * SEQ, NP = 7168, DFF = 2816, NE = 8, INC = 7056;
constexpr int MROWS_MOE = 2 * M + 2048;
constexpr int C_NSAQ = 0, C_KC = 256, C_VC = 320, C_KSL = 384, C_VSL = 448, C_KW = 512, C_VW = 576, C_AG = 640, C_DF = 652,
              C_BQ = 768, C_BK = 1024, C_BV = 1280, C_CQ = 1536, C_CK = 1792, C_CV = 2048, C_DQ = 2304, C_DK = 2560, C_DV = 2816, C_MG = 3072;
constexpr float EPS = 1e-6f;
constexpr float SKIP_THR = 40.0f;

constexpr size_t MiB = 1u << 20;
constexpr size_t WS_CTL = 0, CTL_ZERO_BYTES = 1 * MiB;
constexpr size_t WS_MOD = 1 * MiB;
constexpr size_t WS_LIST = 1 * MiB + 256 * 1024;
constexpr size_t WS_TOKINFO = 2 * MiB;
constexpr size_t WS_Y = 4 * MiB;
constexpr size_t WS_ROPE_C = 4 * MiB, WS_ROPE_S = 5 * MiB;
constexpr size_t WS_KCMP = 6 * MiB, WS_VCMP = 6 * MiB + 256 * 1024;
constexpr size_t WS_CW1T = 8 * MiB;
constexpr size_t WS_WIN = 16 * MiB;
constexpr size_t WS_WBR = 44 * MiB;
constexpr size_t WS_WOUT = 48 * MiB;
constexpr size_t WS_W13 = 52 * MiB;
constexpr size_t WS_W2 = 63 * MiB;
constexpr size_t WS_ARENA = 72 * MiB;
constexpr size_t WS_PROJ = WS_ARENA;
constexpr size_t WS_O = WS_ARENA + 224 * MiB;
constexpr size_t WS_GACC = WS_ARENA + 256 * MiB;
constexpr size_t WS_H = WS_ARENA + 320 * MiB;
constexpr size_t WS_HMID = WS_ARENA;
constexpr size_t WS_MOEW13 = WS_ARENA;
constexpr size_t WS_MOEW2 = WS_ARENA + 88 * MiB;
constexpr size_t WS_HMID_MOE = WS_ARENA + 132 * MiB;
constexpr size_t WS_TILED = WS_GACC;
constexpr size_t WS_LC = WS_TILED + 88 * MiB;
constexpr size_t WS_TC = WS_LC + 512 * 1024;
constexpr size_t WS_END = WS_ARENA + 352 * MiB;
static_assert(WS_TC + 8192 <= WS_H + 32 * MiB, "tiled region");
static_assert(WS_HMID_MOE + (size_t)MROWS_MOE * DFF * 2 <= WS_H, "moe hmid vs H");
static_assert(WS_Y + (size_t)MROWS_MOE * 1024 * 2 <= WS_ARENA, "Y overlay");
constexpr int CW_BAR = 4096;
constexpr int CW_MOECNT = 1024;

constexpr int RING_BYTES = 131072;
constexpr int MISC_OFF = 139264;
constexpr int LDS_BYTES = 147456;

#define GAS __attribute__((address_space(1)))
#define LAS __attribute__((address_space(3)))
typedef unsigned short bf16;
typedef unsigned v4u __attribute__((ext_vector_type(4)));
typedef float f32x4 __attribute__((ext_vector_type(4)));
typedef GAS unsigned gu32;
#define RLX_AGENT __ATOMIC_RELAXED, __HIP_MEMORY_SCOPE_AGENT
#define LDS_WAIT() asm volatile("s_waitcnt lgkmcnt(0)" ::: "memory")
__device__ __forceinline__ unsigned f2bf(float f) { unsigned u = __builtin_bit_cast(unsigned, f); return (u + 0x7fffu + ((u >> 16) & 1u)) >> 16; }
__device__ __forceinline__ unsigned pk2(float lo, float hi) { return f2bf(lo) | (f2bf(hi) << 16); }
__device__ __forceinline__ float bf2f(unsigned short v) { return __uint_as_float((unsigned)v << 16); }
__device__ __forceinline__ int lane_id_fresh() { int l; asm volatile("v_mbcnt_lo_u32_b32 %0, -1, 0\n\tv_mbcnt_hi_u32_b32 %0, -1, %0" : "=v"(l)); return l; }

#define XB_TMO      128
#define XB_XCNT(j)  (256  + 64 * (j))
#define XB_XSUB(j)  (1280 + 64 * (j))
#define XB_XGEN(j)  (2304 + 64 * (j))
#define XB_TOP      3328
#define XB_TOPGEN   3392
#define XCD_BAR_WORDS 3456
#define XB_SPIN_CAP (1u << 22)
__device__ __forceinline__ unsigned xb_ld(unsigned* p)              { return __hip_atomic_load(p, __ATOMIC_RELAXED, __HIP_MEMORY_SCOPE_AGENT); }
__device__ __forceinline__ unsigned xb_add(unsigned* p, unsigned v) { return __hip_atomic_fetch_add(p, v, __ATOMIC_RELAXED, __HIP_MEMORY_SCOPE_AGENT); }
__device__ __forceinline__ unsigned xb_xcc_id() { return (unsigned)__builtin_amdgcn_s_getreg((3 << 11) | 20) & 0xFu; }
#define XB_SPIN(cond, bar) do { unsigned _sp = 0; while (cond) { __builtin_amdgcn_s_sleep(1); \
    if ((++_sp & 255u) == 0u) { if (xb_ld(&(bar)[XB_TMO])) break; if (_sp > XB_SPIN_CAP) { atomicAdd(&(bar)[XB_TMO], 1u); break; } } } } while (0)
struct XcdBarrier { unsigned* bar; unsigned x; volatile LAS unsigned* st; };
__device__ __forceinline__ XcdBarrier xcd_barrier_post(unsigned* bar, volatile LAS unsigned* st, bool leader) {
    XcdBarrier b; b.bar = bar; b.x = xb_xcc_id(); b.st = st;
    if (leader) (void)xb_add(&bar[XB_XCNT(b.x)], 1u);
    return b;
}
__device__ __forceinline__ void xcd_barrier_complete(unsigned* bar, unsigned x, unsigned& nloc, unsigned& nx) {
    const unsigned G = gridDim.x * gridDim.y * gridDim.z;
    unsigned sum, cnt, mine, sp = 0u;
    for (;;) {
        sum = 0u; cnt = 0u; mine = 0u;
#pragma unroll
        for (unsigned j = 0; j < 16; ++j) { const unsigned c = xb_ld(&bar[XB_XCNT(j)]); sum += c; cnt += (c > 0u) ? 1u : 0u; mine = (j == x) ? c : mine; }
        if (sum == G) break;
        __builtin_amdgcn_s_sleep(1);
        if ((++sp & 255u) == 0u) { if (xb_ld(&bar[XB_TMO])) break; if (sp > XB_SPIN_CAP) { atomicAdd(&bar[XB_TMO], 1u); break; } }
    }
    nloc = mine > 0u ? mine : 1u; nx = cnt > 0u ? cnt : 1u;
}
__device__ __forceinline__ void xcd_barrier(const XcdBarrier& b, bool leader) {
    asm volatile("s_waitcnt vmcnt(0)" ::: "memory");
    __syncthreads();
    if (leader) {
        unsigned* bar = b.bar;
        __builtin_amdgcn_s_waitcnt(0);
        unsigned nloc = b.st[0], nx = b.st[1];
        if (nloc == 0u) { xcd_barrier_complete(bar, b.x, nloc, nx); b.st[0] = nloc; b.st[1] = nx; }
        const unsigned old = xb_add(&bar[XB_XSUB(b.x)], 1u);
        const unsigned gen = old / nloc;
        if (old + 1u == (gen + 1u) * nloc) {
            __builtin_amdgcn_fence(__ATOMIC_RELEASE, "agent");
            asm volatile("s_waitcnt vmcnt(0)" ::: "memory");
            const unsigned og = xb_add(&bar[XB_TOP], 1u);
            const unsigned tg = og / nx;
            if (og + 1u == (tg + 1u) * nx) xb_add(&bar[XB_TOPGEN], 1u);
            else XB_SPIN(xb_ld(&bar[XB_TOPGEN]) == tg, bar);
            __builtin_amdgcn_fence(__ATOMIC_ACQUIRE, "agent");
            xb_add(&bar[XB_XGEN(b.x)], 1u);
            asm volatile("s_waitcnt vmcnt(0)" ::: "memory");
        } else {
            XB_SPIN(xb_ld(&bar[XB_XGEN(b.x)]) == gen, bar);
            __builtin_amdgcn_fence(__ATOMIC_ACQUIRE, "agent");
            asm volatile("s_waitcnt vmcnt(0)" ::: "memory");
        }
    }
    __syncthreads();
}

struct Args { const void* in[25]; float* out; unsigned char* ws; int ph_lo, ph_hi; unsigned dup; int pad; };
typedef const __attribute__((address_space(4))) Args* ArgsP;
struct Frame {
    LAS unsigned char* lds;
    int tid, lane, wave, G, gw, NGW, bx;
    unsigned char* ws;
    gu32* ctl;
};

template <int K> __device__ __forceinline__ float swz_xor(float v) { return __int_as_float(__builtin_amdgcn_ds_swizzle(__float_as_int(v), (K << 10) | 0x1f)); }
template <int K> __device__ __forceinline__ int swz_xor_i(int v) { return __builtin_amdgcn_ds_swizzle(v, (K << 10) | 0x1f); }
__device__ __forceinline__ float wave_sum(float v) {
    v += swz_xor<1>(v); v += swz_xor<2>(v); v += swz_xor<4>(v); v += swz_xor<8>(v); v += swz_xor<16>(v);
    const auto r = __builtin_amdgcn_permlane32_swap(__float_as_uint(v), __float_as_uint(v), false, false);
    return __uint_as_float(r[0]) + __uint_as_float(r[1]);
}

struct MapIdent { const float* W; int N; __device__ const float* operator()(int n) const { return W + n; } __device__ int stride() const { return N; } };
struct MapWin {
    const float* W;
    __device__ const float* operator()(int j) const {
        int o;
        if (j < 652) o = j; else if (j < 656) o = 2956 + (j - 652); else if (j < 768) return nullptr; else if (j < 3072) o = 652 + (j - 768); else o = 2960 + (j - 3072);
        return W + o;
    }
    __device__ int stride() const { return INC; }
};
struct MapW13 {
    const float* W1; const float* W3;
    __device__ const float* operator()(int j) const { const int tile = j >> 8, r = j & 255; return (r < 128) ? (W1 + tile * 128 + r) : (W3 + tile * 128 + (r - 128)); }
    __device__ int stride() const { return DFF; }
};
template <class Map>
__device__ __forceinline__ void transpose_item(const Map mp, int K, int ldo, bf16* WT, LAS float* scr, int kb, int nb, int lane) {
    const int k0 = 64 * kb, n0 = 64 * nb, kr = lane >> 4, nc = lane & 15; const float* cp = mp(n0 + 4 * nc); const int st = mp.stride();
    const bool live = cp != nullptr; const float* cq = live ? cp : mp(0);
    f32x4 v[16];
#pragma unroll
    for (int i = 0; i < 16; ++i) { v[i] = *(const f32x4*)(cq + (size_t)(k0 + 4 * i + kr) * st); if (!live) v[i] = (f32x4){0.f, 0.f, 0.f, 0.f}; }
#pragma unroll
    for (int i = 0; i < 16; ++i) { LAS float* d = scr + (4 * i + kr) * 65 + 4 * nc; d[0] = v[i][0]; d[1] = v[i][1]; d[2] = v[i][2]; d[3] = v[i][3]; }
    LDS_WAIT(); asm volatile("" ::: "memory");
    const int c = lane & 7;
#pragma unroll
    for (int j = 0; j < 8; ++j) { const int n = (lane >> 3) + 8 * j; const LAS float* sp = scr + (8 * c) * 65 + n;
        v4u o; o.x = pk2(sp[0 * 65], sp[1 * 65]); o.y = pk2(sp[2 * 65], sp[3 * 65]); o.z = pk2(sp[4 * 65], sp[5 * 65]); o.w = pk2(sp[6 * 65], sp[7 * 65]);
        *(GAS v4u*)(WT + (size_t)(n0 + n) * ldo + k0 + 8 * c) = o; }
    LDS_WAIT(); asm volatile("" ::: "memory");
}
template <class Map>
__device__ __forceinline__ void transpose_all(Frame& F, const Map mp, int K, int Nout, bf16* WT, int& itbase, int ldo = 0) {
    if (ldo == 0) ldo = K;
    LAS float* scr = (LAS float*)(F.lds + F.wave * 16640);
    const int nblk = Nout / 64, n = (K / 64) * nblk;
    int first = (F.gw - (itbase % F.NGW) + F.NGW) % F.NGW;
    for (int it = first; it < n; it += F.NGW) transpose_item(mp, K, ldo, WT, scr, it / nblk, it % nblk, F.lane);
    itbase += n;
}

__device__ __forceinline__ float gelu_tanh(float x) { const float u = 0.7978845608028654f * (x + 0.044715f * x * x * x); return 0.5f * x * (1.0f + tanhf(u)); }
__device__ __forceinline__ float log_sigmoid(float x) { return fminf(x, 0.f) - log1pf(__expf(-fabsf(x))); }

__device__ __forceinline__ void load64(const bf16* p, float (&v)[64]) {
    const v4u* p4 = (const v4u*)p;
#pragma unroll
    for (int i = 0; i < 8; ++i) { const v4u u = p4[i];
#pragma unroll
        for (int k = 0; k < 4; ++k) { v[8 * i + 2 * k] = __uint_as_float(u[k] << 16); v[8 * i + 2 * k + 1] = __uint_as_float(u[k] & 0xffff0000u); } }
}
__device__ __forceinline__ float dot64(const bf16* p, const float (&q)[64]) {
    const v4u* p4 = (const v4u*)p; float s0 = 0.f, s1 = 0.f;
#pragma unroll
    for (int i = 0; i < 8; ++i) { if (i == 4) asm volatile("" ::: "memory"); const v4u u = p4[i];
#pragma unroll
        for (int k = 0; k < 4; ++k) { s0 += __uint_as_float(u[k] << 16) * q[8 * i + 2 * k]; s1 += __uint_as_float(u[k] & 0xffff0000u) * q[8 * i + 2 * k + 1]; } }
    return s0 + s1;
}
__device__ __forceinline__ void axpy64(const bf16* p, float w, float (&o)[64]) {
    const v4u* p4 = (const v4u*)p;
#pragma unroll
    for (int i = 0; i < 8; ++i) { if (i == 4) asm volatile("" ::: "memory"); const v4u u = p4[i];
#pragma unroll
        for (int k = 0; k < 4; ++k) { o[8 * i + 2 * k] += w * __uint_as_float(u[k] << 16); o[8 * i + 2 * k + 1] += w * __uint_as_float(u[k] & 0xffff0000u); } }
}
__device__ __forceinline__ void store64(bf16* p, const float (&v)[64]) {
    v4u* p4 = (v4u*)p;
#pragma unroll
    for (int i = 0; i < 8; ++i) { v4u u;
#pragma unroll
        for (int k = 0; k < 4; ++k) u[k] = pk2(v[8 * i + 2 * k], v[8 * i + 2 * k + 1]);
        p4[i] = u; }
}
#define SOFTMAX_STEP(s_, vp_) do { const float _s = (s_); if (_s > m_run) { const float _f = __expf(m_run - _s); l_run *= _f; _Pragma("unroll") for (int _d = 0; _d < 64; ++_d) o[_d] *= _f; m_run = _s; } \
    const float _p = __expf(_s - m_run); l_run += _p; axpy64((vp_), _p, o); } while (0)

__device__ __forceinline__ void phase_prologue(Frame& F, ArgsP a) {
    const float* c_in = (const float*)a->in[1]; const int* pos = (const int*)a->in[2];
    const float* w_ada = (const float*)a->in[3]; const float* b_ada = (const float*)a->in[4];
    {
        LAS float* sc = (LAS float*)(F.lds);
        LAS float* part = (LAS float*)(F.lds + 8192);
        for (int i = F.tid; i < 2048; i += NWAVES * 64) { const float v = c_in[i]; sc[i] = v / (1.0f + __expf(-v)); }
        __syncthreads();
        for (int it = F.bx; it < 2 * 96; it += F.G) {
            const int l = it / 96, j0 = (it % 96) * 64; const float* W = w_ada + (size_t)l * 1024 * 6144 + j0 + F.lane;
            float a0 = 0.f, a1 = 0.f;
#pragma unroll 16
            for (int k = 0; k < 128; ++k) { const int kk = F.wave * 128 + k; const float w = W[(size_t)kk * 6144]; a0 += sc[kk] * w; a1 += sc[1024 + kk] * w; }
            part[(F.wave * 2 + 0) * 64 + F.lane] = a0; part[(F.wave * 2 + 1) * 64 + F.lane] = a1;
            __syncthreads();
            if (F.wave < 2) { float s = 0.f;
#pragma unroll
                for (int w = 0; w < 8; ++w) s += part[(w * 2 + F.wave) * 64 + F.lane];
                ((float*)(F.ws + WS_MOD))[((size_t)l * 2 + F.wave) * 6144 + j0 + F.lane] = s + b_ada[(size_t)l * 6144 + j0 + F.lane]; }
            __syncthreads();
        }
    }
    {
        float* rc = (float*)(F.ws + WS_ROPE_C); float* rs = (float*)(F.ws + WS_ROPE_S);
        for (int i = F.bx * (NWAVES * 64) + F.tid; i < M * 8; i += F.G * NWAVES * 64) {
            const int tok = i >> 3, fi = i & 7;
            const float inv = fi == 0 ? 1.0f : fi == 1 ? 0.1939227432012558f : fi == 2 ? 0.03760603070259094f : fi == 3 ? 0.007292664609849453f : fi == 4 ? 0.0014142135623842478f
                            : fi == 5 ? 0.00027424818836152554f : fi == 6 ? 5.318296098266728e-05f : 1.0313386155758053e-05f;
            const float ang = (float)pos[tok] * inv;
            double rev = (double)ang * 0.15915494309189535; rev -= floor(rev);
            const float fr = (float)rev;
            rs[i] = __builtin_amdgcn_sinf(fr); rc[i] = __builtin_amdgcn_cosf(fr);
        }
    }
    {
        int itb = 0;
        const float* w_in = (const float*)a->in[7]; const float* w_br = (const float*)a->in[16]; const float* w_out = (const float*)a->in[17];
        for (int l = 0; l < 2; ++l) {
            transpose_all(F, MapWin{w_in + (size_t)l * 1024 * INC}, 1024, NP, (bf16*)(F.ws + WS_WIN) + (size_t)l * NP * 1024, itb);
            for (int z = 0; z < 4; ++z) transpose_all(F, MapIdent{w_br + ((size_t)l * 4 + z) * 256 * 1024, 1024}, 256, 1024, (bf16*)(F.ws + WS_WBR) + (size_t)l * 1024 * 1024 + z * 256, itb, 1024);
            transpose_all(F, MapIdent{w_out + (size_t)l * 1024 * 1024, 1024}, 1024, 1024, (bf16*)(F.ws + WS_WOUT) + (size_t)l * 1024 * 1024, itb);
        }
        for (int l = 0; l < 2; ++l) {
            transpose_all(F, MapIdent{(const float*)a->in[11] + (size_t)l * 2048 * 128, 128}, 2048, 128, (bf16*)(F.ws + WS_CW1T) + (size_t)(l * 2 + 0) * 128 * 2048, itb);
            transpose_all(F, MapIdent{(const float*)a->in[13] + (size_t)l * 2048 * 128, 128}, 2048, 128, (bf16*)(F.ws + WS_CW1T) + (size_t)(l * 2 + 1) * 128 * 2048, itb);
        }
        transpose_all(F, MapW13{(const float*)a->in[18], (const float*)a->in[19]}, 1024, 2 * DFF, (bf16*)(F.ws + WS_W13), itb);
        transpose_all(F, MapIdent{(const float*)a->in[20], 1024}, DFF, 1024, (bf16*)(F.ws + WS_W2), itb);
    }
}
__device__ __forceinline__ void phase_moe_weights(Frame& F, ArgsP a) {
    int itb = 0;
    const float* w1 = (const float*)a->in[22]; const float* w3 = (const float*)a->in[23]; const float* w2 = (const float*)a->in[24];
    for (int e = 0; e < NE; ++e) {
        transpose_all(F, MapW13{w1 + (size_t)e * 1024 * DFF, w3 + (size_t)e * 1024 * DFF}, 1024, 2 * DFF, (bf16*)(F.ws + WS_MOEW13) + (size_t)e * 2 * DFF * 1024, itb);
        transpose_all(F, MapIdent{w2 + (size_t)e * DFF * 1024, 1024}, DFF, 1024, (bf16*)(F.ws + WS_MOEW2) + (size_t)e * 1024 * DFF, itb);
    }
}

template <bool ROUTE>
__device__ __forceinline__ void phase_norm(Frame& F, const float* x, const float* nw, const float* sh, const float* sc, const float* router) {
    bf16* H = (bf16*)(F.ws + WS_H);
    const int rows_per = ROUTE ? 8 : 1;
    for (int r0 = F.gw * rows_per; r0 < M; r0 += F.NGW * rows_per) {
        const int b = r0 >> 13;
        f32x4 A[4], Bv[4];
#pragma unroll
        for (int j = 0; j < 4; ++j) { const int c = 4 * F.lane + 256 * j; const f32x4 w = *(const f32x4*)(nw + c), s = *(const f32x4*)(sc + (size_t)b * 6144 + c); A[j] = w * (s + 1.0f); Bv[j] = *(const f32x4*)(sh + (size_t)b * 6144 + c); }
        int myE = 0; float myG = 0.f;
        for (int rr = 0; rr < rows_per; ++rr) {
            const int m = r0 + rr;
            const GAS f32x4* xr = (const GAS f32x4*)(x + (size_t)m * D) + F.lane;
            f32x4 v[4]; float s2 = 0.f;
#pragma unroll
            for (int j = 0; j < 4; ++j) { v[j] = xr[64 * j]; s2 += (v[j].x * v[j].x + v[j].y * v[j].y) + (v[j].z * v[j].z + v[j].w * v[j].w); }
            const float rstd = 1.0f / sqrtf(wave_sum(s2) * (1.f / D) + EPS);
#pragma unroll
            for (int j = 0; j < 4; ++j) v[j] = (v[j] * rstd) * A[j] + Bv[j];
            GAS unsigned long long* o8 = (GAS unsigned long long*)(H + (size_t)m * D) + F.lane;
#pragma unroll
            for (int j = 0; j < 4; ++j) o8[64 * j] = (unsigned long long)pk2(v[j].x, v[j].y) | ((unsigned long long)pk2(v[j].z, v[j].w) << 32);
            if constexpr (ROUTE) {
                float lg[8];
#pragma unroll
                for (int e = 0; e < 8; ++e) lg[e] = 0.f;
#pragma unroll
                for (int j = 0; j < 4; ++j)
#pragma unroll
                    for (int k = 0; k < 4; ++k) { const int c = 4 * F.lane + 256 * j + k; const f32x4 w0 = *(const f32x4*)(router + (size_t)c * 8), w1 = *(const f32x4*)(router + (size_t)c * 8 + 4); const float xv = v[j][k];
                        lg[0] += xv * w0.x; lg[1] += xv * w0.y; lg[2] += xv * w0.z; lg[3] += xv * w0.w; lg[4] += xv * w1.x; lg[5] += xv * w1.y; lg[6] += xv * w1.z; lg[7] += xv * w1.w; }
#pragma unroll
                for (int e = 0; e < 8; ++e) lg[e] = wave_sum(lg[e]);
                int e0 = 0; float v0 = lg[0];
#pragma unroll
                for (int e = 1; e < 8; ++e) if (lg[e] > v0) { v0 = lg[e]; e0 = e; }
                int e1 = -1; float v1 = -3.0e38f;
#pragma unroll
                for (int e = 0; e < 8; ++e) if (e != e0 && lg[e] > v1) { v1 = lg[e]; e1 = e; }
                const float g0 = 1.0f / (1.0f + __expf(v1 - v0)), g1 = 1.0f - g0;
                if (F.lane == 2 * rr) { myE = e0; myG = g0; }
                if (F.lane == 2 * rr + 1) { myE = e1; myG = g1; }
            }
        }
        if constexpr (ROUTE) {
            gu32* cnt = F.ctl + CW_MOECNT; int* list = (int*)(F.ws + WS_LIST); int* info = (int*)(F.ws + WS_TOKINFO);
            const bool act = F.lane < 16; int myrank = 0;
#pragma unroll
            for (int e = 0; e < 8; ++e) {
                const unsigned long long mk = __ballot(act && myE == e);
                const int c = __popcll(mk); unsigned base = 0;
                if (c > 0) { if (F.lane == 0) base = __hip_atomic_fetch_add(cnt + 64 * e, (unsigned)c, RLX_AGENT); base = __builtin_amdgcn_readfirstlane(base); }
                if (act && myE == e) myrank = (int)base + __popcll(mk & ((1ull << F.lane) - 1ull));
            }
            if (act) { const int tok = r0 + (F.lane >> 1); list[myE * 16384 + myrank] = tok; int* ip = info + ((size_t)tok * 2 + (F.lane & 1)) * 4; ip[0] = myE; ip[1] = myrank; ip[2] = __float_as_int(myG); ip[3] = 0; }
        }
    }
}

typedef short bf16x8c __attribute__((ext_vector_type(8)));
typedef float f32x16c __attribute__((ext_vector_type(16)));
__device__ __forceinline__ void compress_item(Frame& F, int item, const float* pe_k, const float* pe_v, const bf16* w1t_base, const float* k2, const float* v2, const float* g1) {
    const int which = item >> 5, b = (item >> 4) & 1, gi = item & 15, r32 = F.lane & 31, hi = F.lane >> 5;
    const float* pe = which ? pe_v : pe_k; const bf16* w1t = w1t_base + (size_t)which * 128 * 2048; const float* w2 = which ? v2 : k2; const int col = which ? C_VC : C_KC;
    const bf16* P = (const bf16*)(F.ws + WS_PROJ);
    LAS unsigned char* X = F.lds;
    LAS float* PE = (LAS float*)(F.lds + 78336);
    for (int i = F.lane; i < 528 * 8; i += 64) { const int tok = i >> 3, ch = i & 7; int gt = 512 * gi + tok; gt = gt > SEQ - 1 ? SEQ - 1 : gt;
        v4u raw = *(const v4u*)(P + (size_t)(b * SEQ + gt) * NP + col + 8 * ch);
        if (!which) {
            float v[8]; float ss = 0.f;
#pragma unroll
            for (int k = 0; k < 4; ++k) { v[2 * k] = __uint_as_float(raw[k] << 16); v[2 * k + 1] = __uint_as_float(raw[k] & 0xffff0000u); ss += v[2 * k] * v[2 * k] + v[2 * k + 1] * v[2 * k + 1]; }
            ss += swz_xor<1>(ss); ss += swz_xor<2>(ss); ss += swz_xor<4>(ss);
            const float rinv = 1.0f / sqrtf(ss * (1.f / 64.f) + EPS); const f32x4 ga = *(const f32x4*)(g1 + 8 * ch), gb = *(const f32x4*)(g1 + 8 * ch + 4);
            raw[0] = pk2(v[0] * rinv * ga[0], v[1] * rinv * ga[1]); raw[1] = pk2(v[2] * rinv * ga[2], v[3] * rinv * ga[3]); raw[2] = pk2(v[4] * rinv * gb[0], v[5] * rinv * gb[1]); raw[3] = pk2(v[6] * rinv * gb[2], v[7] * rinv * gb[3]);
        }
        *(LAS v4u*)(X + ((tok & 15) * 34 + (tok >> 4)) * 144 + ch * 16) = raw; }
    for (int i = F.lane; i < 2048; i += 64) PE[i] = pe[i];
    LDS_WAIT(); asm volatile("" ::: "memory");
    f32x16c acc[4];
#pragma unroll
    for (int nb = 0; nb < 4; ++nb) acc[nb] = (f32x16c){};
    bf16x8c ring[4][4];
    const bf16* wl = w1t + (size_t)r32 * 2048 + 8 * hi;
#define CLOADB(slot, ks_) do { _Pragma("unroll") for (int nb_ = 0; nb_ < 4; ++nb_) ring[slot][nb_] = *(const bf16x8c*)(wl + (size_t)nb_ * 32 * 2048 + 16 * (ks_)); } while (0)
    CLOADB(0, 0); CLOADB(1, 1); CLOADB(2, 2);
#pragma unroll 1
    for (int l = 0; l < 32; ++l) {
        const LAS unsigned char* xr = X + ((l & 15) * 34 + r32 + (l >> 4)) * 144 + 16 * hi;
        const LAS float* per = PE + l * 64 + 8 * hi;
#pragma unroll
        for (int u = 0; u < 4; ++u) {
            const int ks = 4 * l + u;
            if (ks + 3 < 128) CLOADB((u + 3) & 3, ks + 3);
            const v4u raw = *(const LAS v4u*)(xr + 32 * u);
            const f32x4 p0 = *(const LAS f32x4*)(per + 16 * u), p1 = *(const LAS f32x4*)(per + 16 * u + 4);
            v4u w;
            w[0] = pk2(__uint_as_float(raw[0] << 16) + p0[0], __uint_as_float(raw[0] & 0xffff0000u) + p0[1]);
            w[1] = pk2(__uint_as_float(raw[1] << 16) + p0[2], __uint_as_float(raw[1] & 0xffff0000u) + p0[3]);
            w[2] = pk2(__uint_as_float(raw[2] << 16) + p1[0], __uint_as_float(raw[2] & 0xffff0000u) + p1[1]);
            w[3] = pk2(__uint_as_float(raw[3] << 16) + p1[2], __uint_as_float(raw[3] & 0xffff0000u) + p1[3]);
            const bf16x8c af = __builtin_bit_cast(bf16x8c, w);
#pragma unroll
            for (int nb = 0; nb < 4; ++nb) acc[nb] = __builtin_amdgcn_mfma_f32_32x32x16_bf16(ring[u][nb], af, acc[nb], 0, 0, 0);
        }
    }
#undef CLOADB
    f32x16c o0 = {}, o1 = {};
#pragma unroll
    for (int nb = 0; nb < 4; ++nb) {
#pragma unroll
        for (int r = 0; r < 16; ++r) { const float x = acc[nb][r]; const float u2 = 1.5957691216057308f * (x + 0.044715f * x * x * x); acc[nb][r] = x * __builtin_amdgcn_rcpf(1.0f + __expf(-u2)); }
#pragma unroll
        for (int s2 = 0; s2 < 2; ++s2) {
            v4u hw;
#pragma unroll
            for (int k = 0; k < 4; ++k) hw[k] = pk2(acc[nb][8 * s2 + 2 * k], acc[nb][8 * s2 + 2 * k + 1]);
            const bf16x8c hf = __builtin_bit_cast(bf16x8c, hw);
            v4u a0, a1;
#pragma unroll
            for (int k = 0; k < 4; ++k) { const int j0 = 2 * k, j1 = 2 * k + 1;
                const int n0 = 32 * nb + 16 * s2 + 8 * (j0 >> 2) + 4 * hi + (j0 & 3), n1 = 32 * nb + 16 * s2 + 8 * (j1 >> 2) + 4 * hi + (j1 & 3);
                a0[k] = pk2(w2[n0 * 64 + r32], w2[n1 * 64 + r32]); a1[k] = pk2(w2[n0 * 64 + 32 + r32], w2[n1 * 64 + 32 + r32]); }
            o0 = __builtin_amdgcn_mfma_f32_32x32x16_bf16(__builtin_bit_cast(bf16x8c, a0), hf, o0, 0, 0, 0);
            o1 = __builtin_amdgcn_mfma_f32_32x32x16_bf16(__builtin_bit_cast(bf16x8c, a1), hf, o1, 0, 0, 0);
        }
    }
    const bool live = (32 * gi + r32) <= 510;
    char* base = (char*)(F.ws + (which ? WS_VCMP : WS_KCMP)) + (size_t)b * 65536 + gi * 4096;
#pragma unroll
    for (int db = 0; db < 2; ++db)
#pragma unroll
        for (int g = 0; g < 4; ++g) {
            float v[4];
#pragma unroll
            for (int k = 0; k < 4; ++k) { const float x = db ? o1[4 * g + k] : o0[4 * g + k]; v[k] = live ? x : 0.f; }
            if (!which) { uint2 w; w.x = pk2(v[0], v[1]); w.y = pk2(v[2], v[3]); *(uint2*)(base + (2 * db + (g >> 1)) * 1024 + (r32 + 32 * (g & 1)) * 16 + 8 * hi) = w; }
            else { const int kk = r32, s2 = kk >> 4, rem = kk & 15, hh = (rem >> 2) & 1, j = 4 * (rem >> 3) + (rem & 3);
#pragma unroll
                for (int k = 0; k < 4; ++k) { const int d = 32 * db + 8 * g + 4 * hi + k; *(bf16*)(base + ((d >> 5) * 2 + s2) * 1024 + ((d & 31) + 32 * hh) * 16 + j * 2) = (bf16)f2bf(v[k]); } }
        }
    LDS_WAIT(); asm volatile("" ::: "memory");
}
__device__ __forceinline__ void phase_compress(Frame& F, int l, const float* pe_k, const float* pe_v, const float* k2, const float* v2, const float* g1) {
    const bf16* w1t = (const bf16*)(F.ws + WS_CW1T) + (size_t)l * 2 * 128 * 2048;
    if (F.wave == 0) { for (int it = F.bx; it < 64; it += F.G) compress_item(F, it, pe_k, pe_v, w1t, k2, v2, g1); }
}

typedef short bf16x8v __attribute__((ext_vector_type(8)));
typedef float f32x16 __attribute__((ext_vector_type(16)));
constexpr float LOG2E = 1.4426950408889634f;
constexpr float QK_C = 0.125f * LOG2E;
constexpr float THR2 = SKIP_THR * LOG2E;
__device__ __forceinline__ const char* stream_tile(const Frame& F, int sid, int b, int tile) { return (const char*)(F.ws + WS_TILED) + (size_t)sid * (2 * MiB) + (size_t)b * MiB + (size_t)tile * 4096; }
__device__ __forceinline__ void load_tile(const char* kt, const char* vt, int lane, bf16x8v (&kf)[4], bf16x8v (&vf)[4]) {
#pragma unroll
    for (int i = 0; i < 4; ++i) { kf[i] = *(const bf16x8v*)(kt + i * 1024 + lane * 16); vf[i] = *(const bf16x8v*)(vt + i * 1024 + lane * 16); }
}
__device__ __forceinline__ f32x16 qk_tile(const bf16x8v (&kf)[4], const bf16x8v (&qf)[4]) {
    f32x16 s = {};
#pragma unroll
    for (int i = 0; i < 4; ++i) s = __builtin_amdgcn_mfma_f32_32x32x16_bf16(kf[i], qf[i], s, 0, 0, 0);
    return s;
}
__device__ __forceinline__ float half_max(float v) { const auto r = __builtin_amdgcn_permlane32_swap(__float_as_uint(v), __float_as_uint(v), false, false); return fmaxf(__uint_as_float(r[0]), __uint_as_float(r[1])); }
__device__ __forceinline__ float half_sum(float v) { const auto r = __builtin_amdgcn_permlane32_swap(__float_as_uint(v), __float_as_uint(v), false, false); return __uint_as_float(r[0]) + __uint_as_float(r[1]); }
__device__ __forceinline__ float half_other(float v, int hi) { const auto r = __builtin_amdgcn_permlane32_swap(__float_as_uint(v), __float_as_uint(v), false, false); return __uint_as_float(hi ? r[0] : r[1]); }
struct SoftSt { f32x16 o0, o1; float m, l; };
__device__ __forceinline__ void soft_init(SoftSt& st) { st.o0 = (f32x16){}; st.o1 = (f32x16){}; st.m = -1.0e30f; st.l = 0.f; }
__device__ __forceinline__ void pv_tile(SoftSt& st, const f32x16& p, const bf16x8v (&vf)[4]) {
    bf16x8v pf[2];
#pragma unroll
    for (int s2 = 0; s2 < 2; ++s2) { v4u w;
#pragma unroll
        for (int k = 0; k < 4; ++k) w[k] = pg8::cvt_pk_bf16(p[8 * s2 + 2 * k], p[8 * s2 + 2 * k + 1]);
        pf[s2] = __builtin_bit_cast(bf16x8v, w); }
    st.o0 = __builtin_amdgcn_mfma_f32_32x32x16_bf16(vf[0], pf[0], st.o0, 0, 0, 0);
    st.o0 = __builtin_amdgcn_mfma_f32_32x32x16_bf16(vf[1], pf[1], st.o0, 0, 0, 0);
    st.o1 = __builtin_amdgcn_mfma_f32_32x32x16_bf16(vf[2], pf[0], st.o1, 0, 0, 0);
    st.o1 = __builtin_amdgcn_mfma_f32_32x32x16_bf16(vf[3], pf[1], st.o1, 0, 0, 0);
}
__device__ __forceinline__ void soft_pv(SoftSt& st, f32x16& s, const bf16x8v (&vf)[4]) {
    float tm = fmaxf(fmaxf(s[0], s[1]), fmaxf(s[2], s[3]));
#pragma unroll
    for (int r = 4; r < 16; r += 4) tm = fmaxf(tm, fmaxf(fmaxf(s[r], s[r + 1]), fmaxf(s[r + 2], s[r + 3])));
    tm = half_max(tm);
    const float mn = fmaxf(st.m, tm);
    if (__any(mn > st.m)) { const float al = __builtin_amdgcn_exp2f(st.m - mn); st.l *= al; st.o0 = st.o0 * al; st.o1 = st.o1 * al; }
    st.m = mn;
    float ls = 0.f;
#pragma unroll
    for (int r = 0; r < 16; ++r) { s[r] = __builtin_amdgcn_exp2f(s[r] - mn); ls += s[r]; }
    st.l += ls;
    pv_tile(st, s, vf);
}
__device__ __forceinline__ void fixed_pv(SoftSt& st, f32x16& s, const bf16x8v (&vf)[4]) {
    float ls = 0.f;
#pragma unroll
    for (int r = 0; r < 16; ++r) { s[r] = __builtin_amdgcn_exp2f(s[r]); ls += s[r]; }
    st.l += ls;
    pv_tile(st, s, vf);
}
__device__ __forceinline__ void store_ot(bf16* orow, const f32x16& o0, const f32x16& o1, float sc, int hi) {
#pragma unroll
    for (int g = 0; g < 4; ++g) {
        uint2 w0, w1;
        w0.x = pg8::cvt_pk_bf16(o0[4 * g] * sc, o0[4 * g + 1] * sc); w0.y = pg8::cvt_pk_bf16(o0[4 * g + 2] * sc, o0[4 * g + 3] * sc);
        w1.x = pg8::cvt_pk_bf16(o1[4 * g] * sc, o1[4 * g + 1] * sc); w1.y = pg8::cvt_pk_bf16(o1[4 * g + 2] * sc, o1[4 * g + 3] * sc);
        *(uint2*)(orow + 8 * g + 4 * hi) = w0; *(uint2*)(orow + 32 + 8 * g + 4 * hi) = w1;
    }
}
__device__ __forceinline__ void load_q(const bf16* qrow, int hi, bf16x8v (&qf)[4]) {
#pragma unroll
    for (int i = 0; i < 4; ++i) qf[i] = *(const bf16x8v*)(qrow + 16 * i + 8 * hi);
}
#define CROW(r, hi) (((r) & 3) + 8 * ((r) >> 2) + 4 * (hi))
#define PIPE3(n_, PTRS, BODY) do { const int np_ = (n_); const char* kp_; const char* vp_; \
    if (np_ > 0) { PTRS(0, kp_, vp_); load_tile(kp_, vp_, F.lane, kfA, vfA); PTRS((np_ > 1 ? 1 : 0), kp_, vp_); load_tile(kp_, vp_, F.lane, kfB, vfB); } \
    _Pragma("unroll 1") for (int i_ = 0; i_ < np_; i_ += 3) { \
          \
        { const int j_ = i_ + 2 < np_ ? i_ + 2 : np_ - 1; PTRS(j_, kp_, vp_); load_tile(kp_, vp_, F.lane, kfC, vfC); } \
        BODY(i_, kfA, vfA); \
        if (i_ + 1 < np_) { { const int j_ = i_ + 3 < np_ ? i_ + 3 : np_ - 1; PTRS(j_, kp_, vp_); load_tile(kp_, vp_, F.lane, kfA, vfA); } BODY(i_ + 1, kfB, vfB); \
        if (i_ + 2 < np_) { { const int j_ = i_ + 4 < np_ ? i_ + 4 : np_ - 1; PTRS(j_, kp_, vp_); load_tile(kp_, vp_, F.lane, kfB, vfB); } BODY(i_ + 2, kfC, vfC); } } } } while (0)

__device__ __forceinline__ void attn_fox_unit(Frame& F, int unit, const float* gk) {
    const int h = unit & 3, qt = (unit >> 2) & 255, b = unit >> 10, r32 = F.lane & 31, hi = F.lane >> 5;
    const bf16* P = (const bf16*)(F.ws + WS_PROJ); bf16* O = (bf16*)(F.ws + WS_O);
    const int tg = b * SEQ + 32 * qt + r32;
    bf16x8v qf[4]; load_q(P + (size_t)tg * NP + C_DQ + 64 * h, hi, qf);
    float qn = 0.f, gmax = 0.f;
#pragma unroll
    for (int i = 0; i < 4; ++i)
#pragma unroll
        for (int j = 0; j < 8; ++j) { const float v = bf2f((unsigned short)qf[i][j]); qn += v * v; }
    qn = half_sum(qn);
    for (int d = 0; d < 64; ++d) gmax = fmaxf(gmax, fabsf(gk[d]));
    const float qkmax2 = sqrtf(qn) * (8.0f * gmax) * QK_C * 1.02f;
    const float* LC = (const float*)(F.ws + WS_LC) + ((size_t)b * 4 + h) * SEQ; const float* TC = (const float*)(F.ws + WS_TC) + ((size_t)b * 4 + h) * 256;
    const float lct = LC[32 * qt + r32];
    SoftSt st; soft_init(st);
    bf16x8v kf[4], vf[4], kn[4], vn[4];
    load_tile(stream_tile(F, 36 + h, b, qt), stream_tile(F, 40 + h, b, qt), F.lane, kf, vf);
    float gacc = 0.f;
    for (int kt = qt; kt >= 0; --kt) {
        { const int kq = kt > 0 ? kt - 1 : 0; load_tile(stream_tile(F, 36 + h, b, kq), stream_tile(F, 40 + h, b, kq), F.lane, kn, vn); }
        f32x16 s = qk_tile(kf, qf);
        const float base = lct + gacc - qkmax2;
#pragma unroll
        for (int g = 0; g < 4; ++g) { const f32x4 lc = *(const f32x4*)(LC + 32 * kt + 8 * g + 4 * hi);
#pragma unroll
            for (int k = 0; k < 4; ++k) s[4 * g + k] = s[4 * g + k] * QK_C + (base - lc[k]); }
        if (kt == qt) {
#pragma unroll
            for (int r = 0; r < 16; ++r) if (CROW(r, hi) > r32) s[r] = -INFINITY;
        }
        fixed_pv(st, s, vf);
        if (__all(lct + gacc + 13.0f < __builtin_amdgcn_logf(half_sum(st.l)) - THR2)) break;
        if (kt > 0) gacc += TC[kt - 1];
#pragma unroll
        for (int i = 0; i < 4; ++i) { kf[i] = kn[i]; vf[i] = vn[i]; }
    }
    const float lt = half_sum(st.l);
    store_ot(O + (size_t)tg * 1024 + 768 + 64 * h, st.o0, st.o1, 1.0f / lt, hi);
}
__device__ __forceinline__ void attn_sb_unit(Frame& F, int unit) {
    const int h = unit & 3, qt = (unit >> 2) & 255, b = unit >> 10, r32 = F.lane & 31, hi = F.lane >> 5;
    const bf16* P = (const bf16*)(F.ws + WS_PROJ); bf16* O = (bf16*)(F.ws + WS_O);
    const int tg = b * SEQ + 32 * qt + r32;
    bf16x8v qf[4]; load_q(P + (size_t)tg * NP + C_CQ + 64 * h, hi, qf);
    SoftSt st; soft_init(st);
    bf16x8v kf[4], vf[4], kn[4], vn[4];
    load_tile(stream_tile(F, 28 + h, b, qt), stream_tile(F, 32 + h, b, qt), F.lane, kf, vf);
    float R = 0.f;
    for (int kt = qt; kt >= 0; --kt) {
        { const int kq = kt > 0 ? kt - 1 : 0; load_tile(stream_tile(F, 28 + h, b, kq), stream_tile(F, 32 + h, b, kq), F.lane, kn, vn); }
        f32x16 s = qk_tile(kf, qf);
        float L[16];
#pragma unroll
        for (int r = 0; r < 16; ++r) { const float z2 = s[r] * QK_C; const float sp = fmaxf(z2, 0.f) + __builtin_amdgcn_logf(1.0f + __builtin_amdgcn_exp2f(-fabsf(z2)));
            const bool ok = (kt < qt) || (CROW(r, hi) < r32); L[r] = ok ? -sp : 0.f; s[r] = ok ? (z2 - sp) : -INFINITY; }
        float gt[4], og[4];
#pragma unroll
        for (int g = 0; g < 4; ++g) { gt[g] = (L[4 * g] + L[4 * g + 1]) + (L[4 * g + 2] + L[4 * g + 3]); og[g] = half_other(gt[g], hi); }
        float suf[4];
        { float a = 0.f;
#pragma unroll
          for (int g = 3; g >= 0; --g) { suf[g] = a; a += gt[g]; }
          float bsum = 0.f;
#pragma unroll
          for (int g = 3; g >= 0; --g) { if (hi == 0) { bsum += og[g]; suf[g] += bsum; } else { suf[g] += bsum; bsum += og[g]; } }
        }
#pragma unroll
        for (int g = 0; g < 4; ++g) { const float a3 = R + suf[g], a2 = a3 + L[4 * g + 3], a1 = a2 + L[4 * g + 2], a0 = a1 + L[4 * g + 1];
            s[4 * g + 3] = __builtin_amdgcn_exp2f(s[4 * g + 3] + a3); s[4 * g + 2] = __builtin_amdgcn_exp2f(s[4 * g + 2] + a2);
            s[4 * g + 1] = __builtin_amdgcn_exp2f(s[4 * g + 1] + a1); s[4 * g] = __builtin_amdgcn_exp2f(s[4 * g] + a0); }
        pv_tile(st, s, vf);
        R += ((gt[0] + gt[1]) + (gt[2] + gt[3])) + ((og[0] + og[1]) + (og[2] + og[3]));
        if (__all(R < -THR2)) break;
#pragma unroll
        for (int i = 0; i < 4; ++i) { kf[i] = kn[i]; vf[i] = vn[i]; }
    }
    store_ot(O + (size_t)tg * 1024 + 512 + 64 * h, st.o0, st.o1, 1.0f, hi);
}
__device__ __forceinline__ void attn_dil_unit(Frame& F, int unit, const float* gk) {
    const int h = unit & 3, r16 = (unit >> 2) & 15, blk = (unit >> 6) & 15, b = unit >> 10, r32 = F.lane & 31, hi = F.lane >> 5;
    const bf16* P = (const bf16*)(F.ws + WS_PROJ); bf16* O = (bf16*)(F.ws + WS_O);
    const int t = 512 * blk + r16 + 16 * r32, tg = b * SEQ + t;
    bf16x8v qf[4]; load_q(P + (size_t)tg * NP + C_BQ + 64 * h, hi, qf);
    float mfix;
    { float qn = 0.f, gmax = 0.f;
#pragma unroll
      for (int i = 0; i < 4; ++i)
#pragma unroll
          for (int j = 0; j < 8; ++j) { const float v = bf2f((unsigned short)qf[i][j]); qn += v * v; }
      qn = half_sum(qn);
      for (int d = 0; d < 64; ++d) gmax = fmaxf(gmax, fabsf(gk[d]));
      mfix = sqrtf(qn) * (8.0f * gmax) * QK_C * 1.02f; }
    SoftSt st; soft_init(st);
    bf16x8v kfA[4], vfA[4], kfB[4], vfB[4], kfC[4], vfC[4];
    const int lo0 = 16 * blk - 4 < 0 ? 0 : 16 * blk - 4, lo1 = 4 * blk - 4 < 0 ? 0 : 4 * blk - 4, lo2 = blk - 4 < 0 ? 0 : blk - 4;
    const int n0 = 16 * blk + 15 - lo0 + 1, n1 = 4 * blk + 3 - lo1 + 1, n2 = blk - lo2 + 1;
#define DIL_DEC(i, gi_, tl_) const int gi_ = ((i) >= n0) + ((i) >= n0 + n1); const int tl_ = gi_ == 0 ? lo0 + (i) : gi_ == 1 ? lo1 + ((i) - n0) : lo2 + ((i) - n0 - n1)
#define DIL_PTRS(i, kp, vp) do { DIL_DEC(i, g_, t_); const int sid_ = 4 + 4 * g_ + h; const int tb_ = g_ == 0 ? 0 : g_ == 1 ? (r16 & 3) * 64 : r16 * 16; kp = stream_tile(F, sid_, b, tb_ + t_); vp = stream_tile(F, sid_ + 12, b, tb_ + t_); } while (0)
#define DIL_BODY(i, KF, VF) do { DIL_DEC(i, g_, t_); const int qi_ = g_ == 0 ? t : g_ == 1 ? (t >> 2) : (t >> 4); f32x16 s = qk_tile(KF, qf); \
        _Pragma("unroll") for (int r = 0; r < 16; ++r) { const int df = qi_ - (32 * t_ + CROW(r, hi)); s[r] = (df >= 0 && df <= 128) ? (s[r] * QK_C - mfix) : -INFINITY; } \
        fixed_pv(st, s, VF); } while (0)
    PIPE3(n0 + n1 + n2, DIL_PTRS, DIL_BODY);
#undef DIL_DEC
#undef DIL_PTRS
#undef DIL_BODY
    const float lt = half_sum(st.l);
    store_ot(O + (size_t)tg * 1024 + 256 + 64 * h, st.o0, st.o1, 1.0f / lt, hi);
}

__device__ __forceinline__ void attn_nsa_unit(Frame& F, int unit, const float* qk_gain, unsigned mode) {
    const int b = unit >> 10, t0 = (unit & 1023) * 8, r32 = F.lane & 31, hi = F.lane >> 5, qi = r32 >> 2, head = r32 & 3;
    const int t = t0 + qi, tg = b * SEQ + t;
    const bf16* P = (const bf16*)(F.ws + WS_PROJ); bf16* O = (bf16*)(F.ws + WS_O);
    LAS float* imp = (LAS float*)(F.lds + F.wave * 5120);
    LAS unsigned* selm = (LAS unsigned*)(F.lds + F.wave * 5120 + 4096);
    LAS float* otl = (LAS float*)(F.lds + 40960 + F.wave * 8192) + F.lane;
    const bf16* prow = P + (size_t)tg * NP;
    const float g0 = pg8::sigmoid_f(bf2f(prow[C_AG + 3 * head])), g1 = pg8::sigmoid_f(bf2f(prow[C_AG + 3 * head + 1])), g2 = pg8::sigmoid_f(bf2f(prow[C_AG + 3 * head + 2]));
    bf16x8v qf[4]; load_q(prow + C_NSAQ + 64 * head, hi, qf);
    SoftSt st; bf16x8v kfA[4], vfA[4], kfB[4], vfB[4], kfC[4], vfC[4];
    const int cmax = (t >= 31) ? ((t - 31) >> 4) : -1;
    const int cmax_last = (t0 + 7 >= 31) ? ((t0 + 7 - 31) >> 4) : -1;
    const int ntc = (cmax_last >= 0) ? (cmax_last >> 5) + 1 : 0;
    const int ntc1 = (mode & 1u) ? ntc : 0, ntc2 = (mode & 2u) ? ntc : 0;
    const char* kcb = (const char*)(F.ws + WS_KCMP) + (size_t)b * 65536; const char* vcb = (const char*)(F.ws + WS_VCMP) + (size_t)b * 65536;
    soft_init(st);
#define CMP_PTRS(i, kp, vp) do { kp = kcb + (i) * 4096; vp = vcb + (i) * 4096; } while (0)
#define CMP_BODY(i, KF, VF) do { f32x16 s = qk_tile(KF, qf); _Pragma("unroll") for (int r = 0; r < 16; ++r) s[r] = (32 * (i) + CROW(r, hi) <= cmax) ? s[r] * QK_C : -INFINITY; soft_pv(st, s, VF); } while (0)
    PIPE3(ntc1, CMP_PTRS, CMP_BODY);
#undef CMP_PTRS
#undef CMP_BODY
    float inv;
    { const float lt = half_sum(st.l); inv = lt > 0.f ? 1.0f / lt : 0.f; const float sc = g0 * inv;
#pragma unroll
      for (int r = 0; r < 16; ++r) { otl[r * 64] = st.o0[r] * sc; otl[(16 + r) * 64] = st.o1[r] * sc; } }
    const float mfin = st.m;
    for (int i = F.lane; i < 8 * 128; i += 64) imp[i] = 0.f;
    LDS_WAIT(); asm volatile("" ::: "memory");
    { float carry = 0.f;
      if (ntc2 > 0) {
#pragma unroll
        for (int i = 0; i < 4; ++i) kfA[i] = *(const bf16x8v*)(kcb + i * 1024 + F.lane * 16); }
#pragma unroll 1
      for (int ct = 0; ct < ntc2; ++ct) {
        { const int cq = ct + 1 < ntc2 ? ct + 1 : ct;
#pragma unroll
            for (int i = 0; i < 4; ++i) kfB[i] = *(const bf16x8v*)(kcb + cq * 4096 + i * 1024 + F.lane * 16); }
        f32x16 s = qk_tile(kfA, qf);
#pragma unroll
        for (int i = 0; i < 4; ++i) kfA[i] = kfB[i];
        float Sg[4], X[4];
#pragma unroll
        for (int r = 0; r < 16; ++r) { float p = (32 * ct + CROW(r, hi) <= cmax) ? __builtin_amdgcn_exp2f(s[r] * QK_C - mfin) * inv : 0.f; p += swz_xor<1>(p); p += swz_xor<2>(p); s[r] = p; }
#pragma unroll
        for (int g = 0; g < 4; ++g) { Sg[g] = (s[4 * g] + s[4 * g + 1]) + (s[4 * g + 2] + s[4 * g + 3]); X[g] = half_other(s[4 * g + 3], hi); }
        if (head == 0) {
#pragma unroll
            for (int g = 0; g < 4; ++g) { const float prev = hi ? X[g] : (g > 0 ? X[g > 0 ? g - 1 : 0] : carry); imp[qi * 128 + 8 * ct + 2 * g + hi] = Sg[g] + prev; }
        }
        carry = X[3];
      }
      if (head == 0 && hi == 0 && 8 * ntc < 128) imp[qi * 128 + 8 * ntc] = carry;
    }
    LDS_WAIT(); asm volatile("" ::: "memory");
    const int cur = t0 >> 6; const int n_pick = (mode & 2u) ? ((cur + 1 < 16) ? cur + 1 : 16) : 0;
    { const int q8 = F.lane >> 3, sub = F.lane & 7;
      unsigned mk0 = 1u, mk1 = 0u, mk2 = 0u, mk3 = 0u; int nsel = 1;
#define NSA_SETBIT(j_) do { const int jj_ = (j_); const unsigned bb_ = 1u << (jj_ & 31); if ((jj_ >> 5) == 0) mk0 |= bb_; else if ((jj_ >> 5) == 1) mk1 |= bb_; else if ((jj_ >> 5) == 2) mk2 |= bb_; else mk3 |= bb_; } while (0)
      if (cur >= 1) { NSA_SETBIT(cur); ++nsel; }
      if (cur >= 2) { NSA_SETBIT(cur - 1); ++nsel; }
      for (; nsel < n_pick; ++nsel) {
          float bv = -2.0f; int bi = 1 << 20;
          for (int j = 1 + sub; j <= cur - 2; j += 8) { const float v = imp[q8 * 128 + j]; if (v > bv) { bv = v; bi = j; } }
          { const float ov = swz_xor<1>(bv); const int oi = swz_xor_i<1>(bi); if (ov > bv || (ov == bv && oi < bi)) { bv = ov; bi = oi; } }
          { const float ov = swz_xor<2>(bv); const int oi = swz_xor_i<2>(bi); if (ov > bv || (ov == bv && oi < bi)) { bv = ov; bi = oi; } }
          { const float ov = swz_xor<4>(bv); const int oi = swz_xor_i<4>(bi); if (ov > bv || (ov == bv && oi < bi)) { bv = ov; bi = oi; } }
          NSA_SETBIT(bi);
          if (sub == 0) imp[q8 * 128 + bi] = -1.0f;
          LDS_WAIT(); asm volatile("" ::: "memory");
      }
#undef NSA_SETBIT
      if (sub == 0) { selm[q8 * 4 + 0] = mk0; selm[q8 * 4 + 1] = mk1; selm[q8 * 4 + 2] = mk2; selm[q8 * 4 + 3] = mk3; }
      LDS_WAIT(); asm volatile("" ::: "memory");
    }
    unsigned mk[4], uni[4];
#pragma unroll
    for (int w = 0; w < 4; ++w) { mk[w] = selm[qi * 4 + w]; unsigned u = mk[w]; u |= (unsigned)swz_xor_i<4>((int)u); u |= (unsigned)swz_xor_i<8>((int)u); u |= (unsigned)swz_xor_i<16>((int)u); uni[w] = (unsigned)__builtin_amdgcn_readfirstlane((int)u); }
    { const float* rc = (const float*)(F.ws + WS_ROPE_C) + (size_t)tg * 8; const float* rs = (const float*)(F.ws + WS_ROPE_S) + (size_t)tg * 8; float nv[8];
#pragma unroll
      for (int j = 0; j < 8; ++j) { const float mine = bf2f((unsigned short)qf[0][j]); const float oth = half_other(mine, hi); const float c = rc[j], sn = rs[j]; nv[j] = hi ? (mine * c + oth * sn) : (mine * c - oth * sn); }
      v4u w;
#pragma unroll
      for (int k = 0; k < 4; ++k) w[k] = pk2(nv[2 * k], nv[2 * k + 1]);
      qf[0] = __builtin_bit_cast(bf16x8v, w); }
    float mfs, mfw;
    { float qn = 0.f, g2m = 0.f, g3m = 0.f;
#pragma unroll
      for (int i = 0; i < 4; ++i)
#pragma unroll
          for (int j = 0; j < 8; ++j) { const float v = bf2f((unsigned short)qf[i][j]); qn += v * v; }
      qn = sqrtf(half_sum(qn));
      for (int d = 0; d < 64; ++d) { g2m = fmaxf(g2m, fabsf(qk_gain[2 * 64 + d])); g3m = fmaxf(g3m, fabsf(qk_gain[3 * 64 + d])); }
      mfs = qn * (8.0f * g2m) * QK_C * 1.02f; mfw = qn * (8.0f * g3m) * QK_C * 1.02f; }
    soft_init(st);
    { LAS int* blist = (LAS int*)(F.lds + F.wave * 5120 + 4096 + 128);
      const int c0 = __builtin_popcount(uni[0]), c1 = __builtin_popcount(uni[1]), c2 = __builtin_popcount(uni[2]), c3 = __builtin_popcount(uni[3]);
#pragma unroll
      for (int w2 = 0; w2 < 2; ++w2) { const int jb = F.lane + 64 * w2, wd = jb >> 5, bit = jb & 31;
          const unsigned uw = wd == 0 ? uni[0] : wd == 1 ? uni[1] : wd == 2 ? uni[2] : uni[3]; const int below = wd == 0 ? 0 : wd == 1 ? c0 : wd == 2 ? c0 + c1 : c0 + c1 + c2;
          if ((uw >> bit) & 1u) blist[below + __builtin_popcount(uw & ((1u << bit) - 1u))] = jb; }
      LDS_WAIT(); asm volatile("" ::: "memory");
      const int nblk = c0 + c1 + c2 + c3;
#define SEL_PTRS(i, kp, vp) do { const int jb_ = __builtin_amdgcn_readfirstlane(blist[(i) >> 1]); kp = stream_tile(F, 0, b, 2 * jb_ + ((i) & 1)); vp = stream_tile(F, 1, b, 2 * jb_ + ((i) & 1)); } while (0)
#define SEL_BODY(i, KF, VF) do { const int jb_ = __builtin_amdgcn_readfirstlane(blist[(i) >> 1]); const int wd_ = jb_ >> 5; const unsigned mkw_ = wd_ == 0 ? mk[0] : wd_ == 1 ? mk[1] : wd_ == 2 ? mk[2] : mk[3]; \
        const float cb_ = ((mkw_ >> (jb_ & 31)) & 1u) ? -mfs : -INFINITY; f32x16 s = qk_tile(KF, qf); \
        if (jb_ == cur) { _Pragma("unroll") for (int r = 0; r < 16; ++r) s[r] = (64 * jb_ + 32 * ((i) & 1) + CROW(r, hi) <= t) ? (s[r] * QK_C + cb_) : -INFINITY; } \
        else { _Pragma("unroll") for (int r = 0; r < 16; ++r) s[r] = s[r] * QK_C + cb_; } \
        fixed_pv(st, s, VF); } while (0)
      PIPE3((mode & 4u) ? 2 * nblk : 0, SEL_PTRS, SEL_BODY);
#undef SEL_PTRS
#undef SEL_BODY
    }
    { const float lt = half_sum(st.l); const float sc = g1 / lt;
#pragma unroll
      for (int r = 0; r < 16; ++r) { otl[r * 64] += st.o0[r] * sc; otl[(16 + r) * 64] += st.o1[r] * sc; } }
    soft_init(st);
    { const int lo_t = (t0 >= 511 ? t0 - 511 : 0) >> 5, hi_t = (t0 + 7) >> 5;
#define WIN_PTRS(i, kp, vp) do { kp = stream_tile(F, 2, b, lo_t + (i)); vp = stream_tile(F, 3, b, lo_t + (i)); } while (0)
#define WIN_BODY(i, KF, VF) do { f32x16 s = qk_tile(KF, qf); const int k0_ = 32 * (lo_t + (i)); \
        if (k0_ + 31 > t0 || k0_ + 511 < t0 + 7) { _Pragma("unroll") for (int r = 0; r < 16; ++r) { const int kp2 = k0_ + CROW(r, hi); s[r] = (kp2 <= t && kp2 + 511 >= t) ? (s[r] * QK_C - mfw) : -INFINITY; } } \
        else { _Pragma("unroll") for (int r = 0; r < 16; ++r) s[r] = s[r] * QK_C - mfw; } \
        fixed_pv(st, s, VF); } while (0)
      PIPE3((mode & 8u) ? hi_t - lo_t + 1 : 0, WIN_PTRS, WIN_BODY);
#undef WIN_PTRS
#undef WIN_BODY
    }
    { const float lt = half_sum(st.l); const float sc = g2 / lt;
#pragma unroll
      for (int r = 0; r < 16; ++r) { st.o0[r] = otl[r * 64] + st.o0[r] * sc; st.o1[r] = otl[(16 + r) * 64] + st.o1[r] * sc; } }
    if (mode & 16u) store_ot(O + (size_t)tg * 1024 + 64 * head, st.o0, st.o1, 1.0f, hi);
    LDS_WAIT(); asm volatile("" ::: "memory");
}

__device__ __forceinline__ int pack_tok(int mode, int tile, int i) {
    if (mode == 0) return 32 * tile + i;
    if (mode == 1) return (tile >> 6) + 4 * (32 * (tile & 63) + i);
    return (tile >> 4) + 16 * (32 * (tile & 15) + i);
}
__device__ __forceinline__ void norm_rope_row(const bf16* src, const float* gain, bool rope, const float* rc, const float* rs, int hi, v4u (&w)[4]) {
    float v[4][8]; float ss = 0.f;
#pragma unroll
    for (int d0 = 0; d0 < 4; ++d0) { const v4u raw = *(const v4u*)(src + 16 * d0 + 8 * hi);
#pragma unroll
        for (int k = 0; k < 4; ++k) { v[d0][2 * k] = __uint_as_float(raw[k] << 16); v[d0][2 * k + 1] = __uint_as_float(raw[k] & 0xffff0000u); ss += v[d0][2 * k] * v[d0][2 * k] + v[d0][2 * k + 1] * v[d0][2 * k + 1]; } }
    if (gain) {
        ss = half_sum(ss); const float rinv = 1.0f / sqrtf(ss * (1.f / 64.f) + EPS);
#pragma unroll
        for (int d0 = 0; d0 < 4; ++d0) { const f32x4 ga = *(const f32x4*)(gain + 16 * d0 + 8 * hi), gb = *(const f32x4*)(gain + 16 * d0 + 8 * hi + 4);
#pragma unroll
            for (int j = 0; j < 4; ++j) { v[d0][j] = v[d0][j] * rinv * ga[j]; v[d0][4 + j] = v[d0][4 + j] * rinv * gb[j]; } }
    }
    if (rope) {
#pragma unroll
        for (int j = 0; j < 8; ++j) { const float mine = v[0][j], oth = half_other(mine, hi), c = rc[j], sn = rs[j]; v[0][j] = hi ? (mine * c + oth * sn) : (mine * c - oth * sn); }
    }
#pragma unroll
    for (int d0 = 0; d0 < 4; ++d0)
#pragma unroll
        for (int k = 0; k < 4; ++k) w[d0][k] = pk2(v[d0][2 * k], v[d0][2 * k + 1]);
}
__device__ __forceinline__ void phase_pack(Frame& F, const float* fox_b, const float* qk_gain) {
    bf16* P = (bf16*)(F.ws + WS_PROJ); const float* rc = (const float*)(F.ws + WS_ROPE_C); const float* rs = (const float*)(F.ws + WS_ROPE_S);
    for (int it = F.gw; it < 12 * 512; it += F.NGW) {
        const int qs = it >> 9, tt = it & 511, r32 = F.lane & 31, hi = F.lane >> 5; const int tokg = 32 * tt + r32;
        const int col = (qs < 4) ? C_NSAQ + 64 * qs : (qs < 8) ? C_BQ + 64 * (qs - 4) : C_DQ + 64 * (qs - 8); const int gi = (qs < 4) ? 0 : (qs < 8) ? 4 : 6;
        bf16* row = P + (size_t)tokg * NP + col; v4u w[4];
        norm_rope_row(row, qk_gain + gi * 64, qs >= 4 && qs < 8, rc + (size_t)tokg * 8, rs + (size_t)tokg * 8, hi, w);
#pragma unroll
        for (int d0 = 0; d0 < 4; ++d0) *(v4u*)(row + 16 * d0 + 8 * hi) = w[d0];
    }
    LAS unsigned char* vs = F.lds + 90112 + F.wave * 4608;
    for (int it = F.gw; it < 44 * 512; it += F.NGW) {
        const int sid = it >> 9, b = (it >> 8) & 1, tile = it & 255;
        int col, isv, mode, gi = -1; bool rope = false;
        if (sid < 4) { col = (sid == 0) ? C_KSL : (sid == 1) ? C_VSL : (sid == 2) ? C_KW : C_VW; isv = sid & 1; mode = 0; gi = (sid == 0) ? 2 : 3; rope = true; }
        else if (sid < 16) { col = C_BK + 64 * (sid & 3); isv = 0; mode = (sid - 4) >> 2; gi = 5; rope = true; }
        else if (sid < 28) { col = C_BV + 64 * (sid & 3); isv = 1; mode = (sid - 16) >> 2; }
        else if (sid < 32) { col = C_CK + 64 * (sid & 3); isv = 0; mode = 0; }
        else if (sid < 36) { col = C_CV + 64 * (sid & 3); isv = 1; mode = 0; }
        else if (sid < 40) { col = C_DK + 64 * (sid & 3); isv = 0; mode = 0; gi = 7; }
        else { col = C_DV + 64 * (sid & 3); isv = 1; mode = 0; }
        char* dst = (char*)(F.ws + WS_TILED) + (size_t)sid * (2 * MiB) + (size_t)b * MiB + (size_t)tile * 4096;
        if (!isv) {
            const int r32 = F.lane & 31, hi = F.lane >> 5; const int tokg = b * SEQ + pack_tok(mode, tile, r32);
            v4u w[4]; norm_rope_row(P + (size_t)tokg * NP + col, gi >= 0 ? qk_gain + gi * 64 : nullptr, rope, rc + (size_t)tokg * 8, rs + (size_t)tokg * 8, hi, w);
#pragma unroll
            for (int d0 = 0; d0 < 4; ++d0) *(v4u*)(dst + d0 * 1024 + F.lane * 16) = w[d0];
        } else {
            const int key = F.lane >> 1, half = F.lane & 1; const bf16* src = P + (size_t)(b * SEQ + pack_tok(mode, tile, key)) * NP + col + 32 * half;
#pragma unroll
            for (int i = 0; i < 4; ++i) *(LAS v4u*)(vs + key * 144 + half * 64 + i * 16) = *(const v4u*)(src + 8 * i);
            LDS_WAIT(); asm volatile("" ::: "memory");
            const int r32 = F.lane & 31, hi = F.lane >> 5;
#pragma unroll
            for (int f = 0; f < 4; ++f) { const int db = f >> 1, s2 = f & 1; v4u w;
#pragma unroll
                for (int k = 0; k < 4; ++k) { const int j0 = 2 * k, j1 = 2 * k + 1;
                    const int k0 = 16 * s2 + 8 * (j0 >> 2) + 4 * hi + (j0 & 3), k1 = 16 * s2 + 8 * (j1 >> 2) + 4 * hi + (j1 & 3);
                    const unsigned e0 = *(const LAS unsigned short*)(vs + k0 * 144 + (32 * db + r32) * 2), e1 = *(const LAS unsigned short*)(vs + k1 * 144 + (32 * db + r32) * 2);
                    w[k] = e0 | (e1 << 16); }
                *(v4u*)(dst + f * 1024 + F.lane * 16) = w; }
            LDS_WAIT(); asm volatile("" ::: "memory");
        }
    }
    {
        float* LCo = (float*)(F.ws + WS_LC); float* TCo = (float*)(F.ws + WS_TC);
        for (int it = F.gw; it < 2 * 256; it += F.NGW) {
            const int b = it >> 8, ch = it & 255, i = F.lane & 31;
            const bf16* prow = P + (size_t)(b * SEQ + 32 * ch + i) * NP + C_DF;
#pragma unroll
            for (int h = 0; h < 4; ++h) {
                const float v = log_sigmoid(bf2f(prow[h]) + fox_b[h]) * LOG2E;
                LAS float* sc = (LAS float*)(vs);
                if (F.lane < 32) sc[i] = v;
                LDS_WAIT(); asm volatile("" ::: "memory");
                float acc = 0.f;
                for (int k = 0; k < 32; ++k) { const float x = sc[k]; acc += (k <= i) ? x : 0.f; }
                LDS_WAIT(); asm volatile("" ::: "memory");
                if (F.lane < 32) { LCo[((size_t)b * 4 + h) * SEQ + 32 * ch + i] = acc; if (i == 31) TCo[((size_t)b * 4 + h) * 256 + ch] = acc; }
            }
        }
    }
}

__device__ __forceinline__ void phase_attention(Frame& F, const float* fox_b, const float* qk_gain, unsigned dupm) {
    const int vgw = ((F.G & 7) == 0 ? ((F.bx & 7) * (F.G >> 3) + (F.bx >> 3)) : F.bx) * NWAVES + F.wave;
    const int xty = (dupm >> 24) & 7u, nit = 4 * 2048 + (xty ? 2048 : 0);
    for (int it = vgw; it < nit; it += F.NGW) {
        const int ty = it < 8192 ? (it >> 11) : xty - 1, sub = it & 2047;
        if (ty == 0) attn_nsa_unit(F, sub, qk_gain, it < 8192 ? 31u : (dupm >> 28));
        else if (ty == 1) attn_dil_unit(F, sub, qk_gain + 5 * 64);
        else if (ty == 2) attn_fox_unit(F, sub, qk_gain + 7 * 64);
        else attn_sb_unit(F, sub);
    }
}

__device__ __forceinline__ void phase_combine(Frame& F, float* out, const float* gate) {
    const bf16* Y = (const bf16*)(F.ws + WS_Y); const int* info = (const int*)(F.ws + WS_TOKINFO);
    int pre[8]; { int p = 0;
#pragma unroll
        for (int e = 0; e < 8; ++e) { int n = (int)__hip_atomic_load(F.ctl + CW_MOECNT + 64 * e, RLX_AGENT); if (n > 16384) n = 16384; pre[e] = p; p += (n + 255) >> 8; } }
    for (int m = F.gw; m < M; m += F.NGW) {
        const int b = m >> 13; const int* ip = info + (size_t)m * 8;
        const int e0 = ip[0], r0 = ip[1], e1 = ip[4], r1 = ip[5]; const float g0 = __int_as_float(ip[2]), g1 = __int_as_float(ip[6]);
        int p0 = 0, p1 = 0;
#pragma unroll
        for (int e = 0; e < 8; ++e) { if (e == e0) p0 = pre[e]; if (e == e1) p1 = pre[e]; }
        const bf16* y0 = Y + ((size_t)p0 * 256 + r0) * 1024; const bf16* y1 = Y + ((size_t)p1 * 256 + r1) * 1024;
#pragma unroll
        for (int j = 0; j < 4; ++j) { const int c = 4 * F.lane + 256 * j;
            const uint2 a0 = *(const uint2*)(y0 + c), a1 = *(const uint2*)(y1 + c); const f32x4 gv = *(const f32x4*)(gate + (size_t)b * 6144 + c); f32x4 xv = *(const f32x4*)(out + (size_t)m * D + c);
            xv.x += gv.x * (g0 * __uint_as_float(a0.x << 16) + g1 * __uint_as_float(a1.x << 16));
            xv.y += gv.y * (g0 * __uint_as_float(a0.x & 0xffff0000u) + g1 * __uint_as_float(a1.x & 0xffff0000u));
            xv.z += gv.z * (g0 * __uint_as_float(a0.y << 16) + g1 * __uint_as_float(a1.y << 16));
            xv.w += gv.w * (g0 * __uint_as_float(a0.y & 0xffff0000u) + g1 * __uint_as_float(a1.y & 0xffff0000u));
            *(f32x4*)(out + (size_t)m * D + c) = xv; }
    }
}

constexpr int PH_PER_LAYER = 11, N_PHASES = 1 + 2 * PH_PER_LAYER;
extern __shared__ __attribute__((aligned(16))) unsigned char lds_dyn[];
#define SITE_PROLOGUE() Frame F; ArgsP ap = (ArgsP)__builtin_amdgcn_kernarg_segment_ptr(); asm volatile("" : "+s"(ap)); l = __builtin_amdgcn_readfirstlane(l); \
    F.lds = (LAS unsigned char*)lds_dyn; F.lane = lane_id_fresh(); F.wave = wave0; F.tid = F.wave * 64 + F.lane; \
    { int bx_ = blockIdx.x; asm volatile("" : "+s"(bx_)); F.bx = bx_; } F.G = gridDim.x; F.gw = F.bx * NWAVES + F.wave; F.NGW = F.G * NWAVES; F.ws = ap->ws; F.ctl = (gu32*)(F.ws + WS_CTL); \
    float* const out = ap->out; const float* const modl = (const float*)(F.ws + WS_MOD) + (size_t)l * 2 * 6144; (void)out; (void)modl
static __device__ __forceinline__ void site_prologue(int l, int wave0) { SITE_PROLOGUE(); phase_prologue(F, ap); }
static __device__ __forceinline__ void site_norm_mix(int l, int wave0) { SITE_PROLOGUE(); const float* xin = (l == 0) ? (const float*)ap->in[0] : (const float*)out;
    phase_norm<false>(F, xin, (const float*)ap->in[5] + l * 1024, modl + 0, modl + 1024, nullptr); }
static __device__ __forceinline__ void site_gemm_in(int l, int wave0) { SITE_PROLOGUE();
    pg8::Gemm g{(const bf16*)(F.ws + WS_H), (const bf16*)(F.ws + WS_WIN) + (size_t)l * NP * 1024, 1024, 1024}; pg8::StaticOrder S; S.init(M, NP, F.G, F.bx);
    pg8::EpiStoreMG E{(bf16*)(F.ws + WS_PROJ), NP};
    pg8::gemm_phase<pg8::EpiStoreMG, pg8::StaticOrder, true, false>(F.lds, g, S, E, F.tid); }
static __device__ __forceinline__ void site_compress(int l, int wave0) { SITE_PROLOGUE();
    phase_compress(F, l, (const float*)ap->in[9] + l * 2048, (const float*)ap->in[10] + l * 2048, (const float*)ap->in[12] + l * 128 * 64, (const float*)ap->in[14] + l * 128 * 64, (const float*)ap->in[8] + l * 512 + 64);
    phase_pack(F, (const float*)ap->in[15] + l * 4, (const float*)ap->in[8] + l * 512); }
static __device__ __forceinline__ void site_attention(int l, int wave0) { SITE_PROLOGUE(); phase_attention(F, (const float*)ap->in[15] + l * 4, (const float*)ap->in[8] + l * 512, ap->dup); }
static __device__ __forceinline__ void site_gemm_branch(int l, int wave0) { SITE_PROLOGUE();
    pg8::Gemm g{(const bf16*)(F.ws + WS_O), (const bf16*)(F.ws + WS_WBR) + (size_t)l * 1024 * 1024, 1024, 1024}; pg8::StaticOrder S; S.init(M, 1024, F.G, F.bx);
    pg8::EpiGateMerge E{(const bf16*)(F.ws + WS_PROJ), NP, C_MG, (bf16*)(F.ws + WS_H)};
    pg8::gemm_phase<pg8::EpiGateMerge, pg8::StaticOrder, false, false>(F.lds, g, S, E, F.tid); }
static __device__ __forceinline__ void site_gemm_out(int l, int wave0) { SITE_PROLOGUE(); const float* xin = (l == 0) ? (const float*)ap->in[0] : (const float*)out;
    pg8::Gemm g{(const bf16*)(F.ws + WS_H), (const bf16*)(F.ws + WS_WOUT) + (size_t)l * 1024 * 1024, 1024, 1024}; pg8::StaticOrder S; S.init(M, 1024, F.G, F.bx);
    pg8::EpiResid E{xin, out, modl + 2048, 6144};
    pg8::gemm_phase<pg8::EpiResid, pg8::StaticOrder, false, false>(F.lds, g, S, E, F.tid); }
static __device__ __forceinline__ void site_norm_ffn(int l, int wave0) { SITE_PROLOGUE();
    if (l == 0) phase_norm<false>(F, out, (const float*)ap->in[6] + l * 1024, modl + 3 * 1024, modl + 4 * 1024, nullptr);
    else { phase_norm<true>(F, out, (const float*)ap->in[6] + l * 1024, modl + 3 * 1024, modl + 4 * 1024, (const float*)ap->in[21]); phase_moe_weights(F, ap); if ((ap->dup >> 27) & 1u) phase_moe_weights(F, ap); } }
static __device__ __forceinline__ void site_gemm_up_dense(int l, int wave0) { SITE_PROLOGUE();
    pg8::Gemm g{(const bf16*)(F.ws + WS_H), (const bf16*)(F.ws + WS_W13), 1024, 1024}; pg8::StaticOrder S; S.init(M, 2 * DFF, F.G, F.bx);
    pg8::EpiSwiglu E{(bf16*)(F.ws + WS_HMID), DFF};
    pg8::gemm_phase<pg8::EpiSwiglu, pg8::StaticOrder, true, false>(F.lds, g, S, E, F.tid); }
static __device__ __forceinline__ void site_gemm_up_moe(int l, int wave0) { SITE_PROLOGUE();
    pg8::Gemm g{(const bf16*)(F.ws + WS_H), (const bf16*)(F.ws + WS_MOEW13), 1024, 1024}; pg8::MoeOrder S; S.init((unsigned*)(F.ctl + CW_MOECNT), (const int*)(F.ws + WS_LIST), 2 * DFF / 256, (size_t)2 * DFF * 1024, F.G, F.bx);
    pg8::EpiSwiglu E{(bf16*)(F.ws + WS_HMID_MOE), DFF};
    pg8::gemm_phase<pg8::EpiSwiglu, pg8::MoeOrder, true, true>(F.lds, g, S, E, F.tid); }
static __device__ __forceinline__ void site_gemm_down_dense(int l, int wave0) { SITE_PROLOGUE();
    pg8::Gemm g{(const bf16*)(F.ws + WS_HMID), (const bf16*)(F.ws + WS_W2), DFF, DFF}; pg8::StaticOrder S; S.init(M, 1024, F.G, F.bx);
    pg8::EpiResid E{out, out, modl + 5 * 1024, 6144};
    pg8::gemm_phase<pg8::EpiResid, pg8::StaticOrder, false, false>(F.lds, g, S, E, F.tid); }
static __device__ __forceinline__ void site_gemm_down_moe(int l, int wave0) { SITE_PROLOGUE();
    pg8::Gemm g{(const bf16*)(F.ws + WS_HMID_MOE), (const bf16*)(F.ws + WS_MOEW2), DFF, DFF}; pg8::MoeOrder S; S.init((unsigned*)(F.ctl + CW_MOECNT), (const int*)(F.ws + WS_LIST), 4, (size_t)1024 * DFF, F.G, F.bx);
    pg8::EpiStore E{(bf16*)(F.ws + WS_Y), 1024};
    pg8::gemm_phase<pg8::EpiStore, pg8::MoeOrder, true, false>(F.lds, g, S, E, F.tid); }
static __device__ __forceinline__ void site_combine(int l, int wave0) { SITE_PROLOGUE(); phase_combine(F, out, modl + 5 * 1024); }

__global__ void __launch_bounds__(NWAVES * 64, 2) fwd_kernel(Args args_unused) {
    (void)args_unused;
    const ArgsP ap0 = (ArgsP)__builtin_amdgcn_kernarg_segment_ptr();
    const int wave0 = __builtin_amdgcn_readfirstlane((int)threadIdx.x >> 6);
    LAS unsigned char* lds = (LAS unsigned char*)lds_dyn;
    volatile LAS unsigned* MISC = (volatile LAS unsigned*)(lds + MISC_OFF);
    for (int u = wave0 * 64 + lane_id_fresh(); u < (LDS_BYTES - RING_BYTES) / 4; u += NWAVES * 64) ((LAS unsigned*)(lds + RING_BYTES))[u] = 0u;
    __syncthreads();
    const int lo = ap0->ph_lo, hi = ap0->ph_hi; const unsigned dupm = ap0->dup;
    unsigned* barw = (unsigned*)(ap0->ws + WS_CTL) + CW_BAR;
    XcdBarrier bar; bar.bar = barw; bar.x = 0; bar.st = nullptr;
#define LEADER() (wave0 == 0 && lane_id_fresh() == 0)
    if (hi - lo > 1) bar = xcd_barrier_post(barw, MISC + 8, LEADER());
#define IN(k) (lo <= (k) && (k) < hi)
#define SEAM(k) do { if (IN(k) && IN((k) + 1)) xcd_barrier(bar, LEADER()); } while (0)
    { const int l = 0; if (PHON(0) && IN(0)) { for (int rep_ = 0; rep_ <= (int)DUP(0); ++rep_) { if (rep_) xcd_barrier(bar, LEADER()); site_prologue(0, wave0); } } }
    SEAM(0);
    for (int l = 0; l < 2; ++l) {
        const int pb = 1 + l * PH_PER_LAYER;
        if (PHON(1) && IN(pb + 0)) { for (int rep_ = 0; rep_ <= (int)DUP(1); ++rep_) { if (rep_) xcd_barrier(bar, LEADER()); site_norm_mix(l, wave0); } }
        SEAM(pb + 0);
        if (PHON(2) && IN(pb + 1)) { for (int rep_ = 0; rep_ <= (int)DUP(2); ++rep_) { if (rep_) xcd_barrier(bar, LEADER()); site_gemm_in(l, wave0); } }
        if (IN(pb + 1) && IN(pb + 3)) xcd_barrier(bar, LEADER());
        if (PHON(4) && IN(pb + 3)) { for (int rep_ = 0; rep_ <= (int)DUP(4); ++rep_) { if (rep_) xcd_barrier(bar, LEADER()); site_compress(l, wave0); } }
        SEAM(pb + 3);
        if (PHON(5) && IN(pb + 4)) { for (int rep_ = 0; rep_ <= (int)DUP(5); ++rep_) { if (rep_) xcd_barrier(bar, LEADER()); site_attention(l, wave0); } }
        SEAM(pb + 4);
        if (PHON(6) && IN(pb + 5)) { for (int rep_ = 0; rep_ <= (int)DUP(6); ++rep_) { if (rep_) xcd_barrier(bar, LEADER()); site_gemm_branch(l, wave0); } }
        SEAM(pb + 5);
        if (PHON(7) && IN(pb + 6)) { for (int rep_ = 0; rep_ <= (int)DUP(7); ++rep_) { if (rep_) xcd_barrier(bar, LEADER()); site_gemm_out(l, wave0); } }
        SEAM(pb + 6);
        if (PHON(8) && IN(pb + 7)) { for (int rep_ = 0; rep_ <= (int)DUP(8); ++rep_) { if (rep_) xcd_barrier(bar, LEADER()); site_norm_ffn(l, wave0); } }
        SEAM(pb + 7);
        if (PHON(9) && IN(pb + 8)) { for (int rep_ = 0; rep_ <= (int)DUP(9); ++rep_) { if (rep_) xcd_barrier(bar, LEADER()); if (l == 0) site_gemm_up_dense(l, wave0); else site_gemm_up_moe(l, wave0); } }
        SEAM(pb + 8);
        if (PHON(10) && IN(pb + 9)) { for (int rep_ = 0; rep_ <= (int)DUP(10); ++rep_) { if (rep_) xcd_barrier(bar, LEADER()); if (l == 0) site_gemm_down_dense(l, wave0); else site_gemm_down_moe(l, wave0); } }
        SEAM(pb + 9);
        if (PHON(11) && IN(pb + 10)) { if (l == 1) site_combine(l, wave0); }
    }
#undef IN
#undef SEAM
}

extern "C" void kernel_launch(void* const* d_in, const int* in_sizes, int n_in, void* d_out, int out_size, void* d_ws, size_t ws_size, hipStream_t stream) {
    static int grid = 0;
    if (grid == 0) {
        if (n_in != 25 || out_size != M * D || ws_size < WS_END) { fprintf(stderr, "kernel_launch: unexpected problem (n_in %d, out %d, ws %zu < %zu)\n", n_in, out_size, ws_size, (size_t)WS_END); grid = -1; return; }
        int dev = 0, cus = 0, per_cu = 0;
        if (hipGetDevice(&dev) != hipSuccess || hipDeviceGetAttribute(&cus, hipDeviceAttributeMultiprocessorCount, dev) != hipSuccess) { grid = -1; return; }
        if (hipFuncSetAttribute((const void*)fwd_kernel, hipFuncAttributeMaxDynamicSharedMemorySize, LDS_BYTES) != hipSuccess) { fprintf(stderr, "kernel_launch: hipFuncSetAttribute failed\n"); grid = -1; return; }
        if (hipOccupancyMaxActiveBlocksPerMultiprocessor(&per_cu, (const void*)fwd_kernel, NWAVES * 64, LDS_BYTES) != hipSuccess || per_cu < 1) fprintf(stderr, "kernel_launch: occupancy query reports %d\n", per_cu);
        (void)hipGetLastError();
        grid = cus;
    }
    if (grid < 0) return;
    if (hipMemsetAsync((char*)d_ws + WS_CTL, 0, CTL_ZERO_BYTES, stream) != hipSuccess) return;
    Args a{};
    for (int i = 0; i < 25; ++i) a.in[i] = d_in[i];
    a.out = (float*)d_out; a.ws = (unsigned char*)d_ws; a.dup = DUPMASK; a.pad = 0;
#if MK_ONE_LAUNCH
    a.ph_lo = 0; a.ph_hi = N_PHASES;
    hipLaunchKernelGGL(fwd_kernel, dim3(grid), dim3(NWAVES * 64), LDS_BYTES, stream, a);
#else
    for (int p = 0; p < N_PHASES; ++p) {
        if (p == 1 + 10) continue;
        a.ph_lo = p; a.ph_hi = p + 1;
        hipLaunchKernelGGL(fwd_kernel, dim3(grid), dim3(NWAVES * 64), LDS_BYTES, stream, a);
    }
#endif
}
```

```cpp
#include <hip/hip_runtime.h>
#include <cstdio>
#include <cstdint>

#ifndef MK_ONE_LAUNCH
#define MK_ONE_LAUNCH 1
#endif
#ifndef PHMASK
#define PHMASK 0xFFFFu
#endif
#define PHON(k) (((PHMASK) >> (k)) & 1u)
#ifndef DUPMASK
#define DUPMASK 0u
#endif
#define DUP(k) ((dupm >> ((k) + 12 * l)) & 1u)

namespace pg8 {
#define PG8_LAS __attribute__((address_space(3)))
typedef unsigned short bf16_t;
typedef short bf16x8 __attribute__((ext_vector_type(8)));
typedef float f32x4 __attribute__((ext_vector_type(4)));
typedef unsigned u32x4 __attribute__((ext_vector_type(4)));
constexpr int BM = 256, BK = 64, HALF = 128, HTB = HALF * BK * 2, STAGE_BYTES = 8 * HTB, NXCD = 8, WGM = 8;

__host__ __device__ __forceinline__ int lds_byte(int r, int c) { const int st = (r >> 4) * 2 + (c >> 5), rr = r & 15, cc = c & 31, ob = rr * 64 + cc * 2; return st * 1024 + (ob ^ (((ob >> 9) & 1) << 5)); }
__host__ __device__ __forceinline__ void stage_rc(int b, int& R, int& C) { const int st = b / 1024, sb = b % 1024, swz = sb ^ (((sb >> 9) & 1) << 5); R = (st >> 1) * 16 + swz / 64; C = (st & 1) * 32 + (swz % 64) / 2; }
__host__ __device__ __forceinline__ int perm32(int rho) { const int n = rho >> 4, i = rho & 15; return 8 * (i >> 2) + 4 * n + (i & 3); }

struct Unit { int pm, pn, z; };
struct Gemm { const bf16_t* A; const bf16_t* Bt; int lda; int K; };

__host__ __device__ __forceinline__ void tile_pmpn(int wgid, int nM, int nN, int& pm, int& pn) {
    const int nwg = nM * nN;
    { const int q = nwg / NXCD, r = nwg % NXCD, xcd = wgid % NXCD, off = wgid / NXCD; wgid = (xcd < r ? xcd * (q + 1) : r * (q + 1) + (xcd - r) * q) + off; }
    const int nig = WGM * nN, gid = wgid / nig, fm = gid * WGM, gsz = (nM - fm) < WGM ? (nM - fm) : WGM;
    pm = fm + ((wgid % nig) % gsz); pn = (wgid % nig) / gsz;
}
struct StaticOrder {
    int nM, nN, nwg, G, c;
    __device__ void init(int M, int N, int G_, int c_) { nM = M / BM; nN = N / BM; nwg = nM * nN; G = G_; c = c_; }
    __device__ bool next(int i, Unit& u) const { const long L = (long)i * G + c; if (L >= nwg) return false; tile_pmpn((int)L, nM, nN, u.pm, u.pn); u.z = 0; return true; }
    __device__ const char* a_base(const Gemm& g, const Unit& u) const { return (const char*)g.A + (size_t)u.pm * BM * g.lda * 2; }
    __device__ const char* b_base(const Gemm& g, const Unit& u) const { return (const char*)g.Bt + (size_t)u.pn * BM * g.K * 2; }
    __device__ int row_tok(const Unit&, int) const { return 0; }
};
struct MoeOrder {
    int G, c, nN; int pre[9]; const int* list; int cnt[8]; size_t zstrideB;
    __device__ void init(unsigned* counts, const int* list_, int nN_, size_t zstrideB_, int G_, int c_) {
        G = G_; c = c_; nN = nN_; list = list_; zstrideB = zstrideB_; int p = 0;
#pragma unroll
        for (int e = 0; e < 8; ++e) { int n = __builtin_amdgcn_readfirstlane((int)__hip_atomic_load(counts + 64 * e, __ATOMIC_RELAXED, __HIP_MEMORY_SCOPE_AGENT)); if (n > 16384) n = 16384; cnt[e] = n; pre[e] = p; p += (n + 255) >> 8; }
        pre[8] = p;
    }
    __device__ bool next(int i, Unit& u) const {
        const long L = (long)i * G + c; if (L >= (long)pre[8] * nN) return false;
        const int rt = (int)(L / nN); u.pn = (int)(L % nN); u.pm = rt; int e = 0;
#pragma unroll
        for (int k = 1; k < 8; ++k) e += (rt >= pre[k]) ? 1 : 0;
        u.z = e; return true;
    }
    __device__ const char* a_base(const Gemm& g, const Unit& u) const { return (const char*)g.A + (size_t)u.pm * BM * g.lda * 2; }
    __device__ const char* b_base(const Gemm& g, const Unit& u) const { return (const char*)g.Bt + ((size_t)u.z * zstrideB + (size_t)u.pn * BM * g.K) * 2; }
    __device__ int row_tok(const Unit& u, int r) const {
        int e = 0, c0 = 0, p0 = 0;
#pragma unroll
        for (int k = 0; k < 8; ++k) if (k == u.z) { c0 = cnt[k]; p0 = pre[k]; }
        const int idx = (u.pm - p0) * 256 + r; (void)e;
        return idx < c0 ? list[u.z * 16384 + idx] : 0;
    }
};

__device__ __forceinline__ int lane_id_fresh_pg8() { int l; asm volatile("v_mbcnt_lo_u32_b32 %0, -1, 0\n\tv_mbcnt_hi_u32_b32 %0, -1, %0" : "=v"(l)); return l; }
__device__ __forceinline__ unsigned cvt_pk_bf16(float lo, float hi) { unsigned r; asm volatile("v_cvt_pk_bf16_f32 %0, %1, %2" : "=v"(r) : "v"(lo), "v"(hi)); return r; }

struct EpiStore {
    static constexpr bool PERM = true, MID = false;
    bf16_t* O; int ldc;
    __device__ __forceinline__ void operator()(const f32x4 (&acc)[2][2][4][2], const Unit& u, int wr, int wc, int fr, int fq) const {
        const unsigned base = ((unsigned)(u.pm * BM + wr * 64 + fr) * (unsigned)ldc + (unsigned)(u.pn * BM + wc * 32 + 8 * fq)) * 2u;
        char* Ob = (char*)O;
#pragma unroll
        for (int ai = 0; ai < 2; ++ai)
#pragma unroll
            for (int m = 0; m < 4; ++m) { const unsigned off = base + (unsigned)((ai * HALF + m * 16) * 2) * (unsigned)ldc;
#pragma unroll
                for (int bj = 0; bj < 2; ++bj) { const f32x4 v0 = acc[ai][bj][m][0], v1 = acc[ai][bj][m][1];
                    u32x4 w; w.x = cvt_pk_bf16(v0[0], v0[1]); w.y = cvt_pk_bf16(v0[2], v0[3]); w.z = cvt_pk_bf16(v1[0], v1[1]); w.w = cvt_pk_bf16(v1[2], v1[3]);
                    *(u32x4*)(Ob + (off + (unsigned)(bj * HALF * 2))) = w; } }
    }
};
__device__ __forceinline__ float silu_f(float a) { return a * __builtin_amdgcn_rcpf(1.0f + __expf(-a)); }
struct EpiSwiglu {
    static constexpr bool PERM = true, MID = false;
    bf16_t* O; int ldc;
    __device__ __forceinline__ void operator()(const f32x4 (&acc)[2][2][4][2], const Unit& u, int wr, int wc, int fr, int fq) const {
        const unsigned base = ((unsigned)(u.pm * BM + wr * 64 + fr) * (unsigned)ldc + (unsigned)(u.pn * HALF + wc * 32 + 8 * fq)) * 2u;
        char* Ob = (char*)O;
#pragma unroll
        for (int ai = 0; ai < 2; ++ai)
#pragma unroll
            for (int m = 0; m < 4; ++m) { const unsigned off = base + (unsigned)((ai * HALF + m * 16) * 2) * (unsigned)ldc;
                float h[8];
#pragma unroll
                for (int n = 0; n < 2; ++n)
#pragma unroll
                    for (int j = 0; j < 4; ++j) h[n * 4 + j] = silu_f(acc[ai][0][m][n][j]) * acc[ai][1][m][n][j];
                u32x4 w; w.x = cvt_pk_bf16(h[0], h[1]); w.y = cvt_pk_bf16(h[2], h[3]); w.z = cvt_pk_bf16(h[4], h[5]); w.w = cvt_pk_bf16(h[6], h[7]);
                *(u32x4*)(Ob + off) = w; }
    }
};
struct EpiResid {
    static constexpr bool PERM = false, MID = false;
    const float* xin; float* out; const float* gate; int gate_bstride;
    __device__ __forceinline__ void operator()(const f32x4 (&acc)[2][2][4][2], const Unit& u, int wr, int wc, int fr, int fq) const {
        const int b = (u.pm * BM) >> 13; const int col0 = u.pn * BM + wc * 32 + 4 * fq;
        f32x4 gv[2][2];
#pragma unroll
        for (int bj = 0; bj < 2; ++bj)
#pragma unroll
            for (int n = 0; n < 2; ++n) gv[bj][n] = *(const f32x4*)(gate + (size_t)b * gate_bstride + col0 + bj * HALF + n * 16);
        const unsigned base = ((unsigned)(u.pm * BM + wr * 64 + fr) * 1024u + (unsigned)col0) * 4u;
        const char* xb = (const char*)xin; char* ob = (char*)out;
#pragma unroll
        for (int ai = 0; ai < 2; ++ai)
#pragma unroll
            for (int m = 0; m < 4; ++m) { const unsigned off = base + (unsigned)((ai * HALF + m * 16) * 4096);
#pragma unroll
                for (int bj = 0; bj < 2; ++bj)
#pragma unroll
                    for (int n = 0; n < 2; ++n) { const unsigned o2 = off + (unsigned)((bj * HALF + n * 16) * 4); const f32x4 xi = *(const f32x4*)(xb + o2); *(f32x4*)(ob + o2) = xi + gv[bj][n] * acc[ai][bj][m][n]; }
                if (m & 1) asm volatile("" ::: "memory"); }
    }
};
__device__ __forceinline__ float sigmoid_f(float a) { return __builtin_amdgcn_rcpf(1.0f + __expf(-a)); }
struct EpiStoreMG {
    static constexpr bool PERM = true, MID = false;
    bf16_t* O; int ldc;
    __device__ __forceinline__ void operator()(const f32x4 (&acc)[2][2][4][2], const Unit& u, int wr, int wc, int fr, int fq) const {
        const unsigned base = ((unsigned)(u.pm * BM + wr * 64 + fr) * (unsigned)ldc + (unsigned)(u.pn * BM + wc * 32 + 8 * fq)) * 2u;
        char* Ob = (char*)O; const bool mg = u.pn >= 12;
#pragma unroll
        for (int ai = 0; ai < 2; ++ai)
#pragma unroll
            for (int m = 0; m < 4; ++m) { const unsigned off = base + (unsigned)((ai * HALF + m * 16) * 2) * (unsigned)ldc;
#pragma unroll
                for (int bj = 0; bj < 2; ++bj) { f32x4 v0 = acc[ai][bj][m][0], v1 = acc[ai][bj][m][1];
                    if (mg) {
#pragma unroll
                        for (int k = 0; k < 4; ++k) { v0[k] = fminf(1.0f + __expf(-v0[k]), 1.0e18f); v1[k] = fminf(1.0f + __expf(-v1[k]), 1.0e18f); } }
                    u32x4 w; w.x = cvt_pk_bf16(v0[0], v0[1]); w.y = cvt_pk_bf16(v0[2], v0[3]); w.z = cvt_pk_bf16(v1[0], v1[1]); w.w = cvt_pk_bf16(v1[2], v1[3]);
                    *(u32x4*)(Ob + (off + (unsigned)(bj * HALF * 2))) = w; } }
    }
};
struct EpiGateMerge {
    static constexpr bool PERM = true, MID = true;
    const bf16_t* proj; int ldp; int cmg; bf16_t* gated;
    __device__ __forceinline__ void mid(f32x4 (&acc)[2][2][4][2], const Unit& u, int z  , int wr, int wc, int fr, int fq) const {
        const unsigned pbase = ((unsigned)(u.pm * BM + wr * 64 + fr) * (unsigned)ldp + (unsigned)(cmg + (z - 1) * 1024 + u.pn * BM + wc * 32 + 8 * fq)) * 2u;
        const char* pb = (const char*)proj;
#pragma unroll
        for (int ai = 0; ai < 2; ++ai)
#pragma unroll
            for (int m = 0; m < 4; ++m) { const unsigned off = pbase + (unsigned)((ai * HALF + m * 16) * 2) * (unsigned)ldp;
#pragma unroll
                for (int bj = 0; bj < 2; ++bj) {
                    const u32x4 ip = *(const u32x4*)(pb + (off + (unsigned)(bj * HALF * 2))), in = *(const u32x4*)(pb + (off + (unsigned)(bj * HALF * 2) + 2048u));
#pragma unroll
                    for (int k = 0; k < 4; ++k) {
                        const float r0 = __uint_as_float(in[k] << 16) * __builtin_amdgcn_rcpf(__uint_as_float(ip[k] << 16)), r1 = __uint_as_float(in[k] & 0xffff0000u) * __builtin_amdgcn_rcpf(__uint_as_float(ip[k] & 0xffff0000u));
                        acc[ai][bj][m][k >> 1][(2 * k) & 3] *= r0; acc[ai][bj][m][k >> 1][(2 * k + 1) & 3] *= r1; } }
                if (m & 1) asm volatile("" ::: "memory"); }
    }
    __device__ __forceinline__ void operator()(const f32x4 (&acc)[2][2][4][2], const Unit& u, int wr, int wc, int fr, int fq) const {
        const unsigned row0 = (unsigned)(u.pm * BM + wr * 64 + fr), col0 = (unsigned)(u.pn * BM + wc * 32 + 8 * fq);
        const unsigned pbase = (row0 * (unsigned)ldp + (unsigned)(cmg + 3 * 1024) + col0) * 2u, gbase = (row0 * 1024u + col0) * 2u;
        const char* pb = (const char*)proj; char* ob = (char*)gated;
#pragma unroll
        for (int ai = 0; ai < 2; ++ai)
#pragma unroll
            for (int m = 0; m < 4; ++m) { const unsigned rr = (unsigned)(ai * HALF + m * 16);
#pragma unroll
                for (int bj = 0; bj < 2; ++bj) {
                    const u32x4 ig = *(const u32x4*)(pb + (pbase + rr * (unsigned)(ldp * 2) + (unsigned)(bj * HALF * 2)));
                    float v[8];
#pragma unroll
                    for (int k = 0; k < 4; ++k) { v[2 * k] = acc[ai][bj][m][k >> 1][(2 * k) & 3] * __builtin_amdgcn_rcpf(__uint_as_float(ig[k] << 16)); v[2 * k + 1] = acc[ai][bj][m][k >> 1][(2 * k + 1) & 3] * __builtin_amdgcn_rcpf(__uint_as_float(ig[k] & 0xffff0000u)); }
                    u32x4 w; w.x = cvt_pk_bf16(v[0], v[1]); w.y = cvt_pk_bf16(v[2], v[3]); w.z = cvt_pk_bf16(v[4], v[5]); w.w = cvt_pk_bf16(v[6], v[7]);
                    *(u32x4*)(ob + (gbase + rr * 2048u + (unsigned)(bj * HALF * 2))) = w; }
                if (m & 1) asm volatile("" ::: "memory"); }
    }
};

template <class Epi, class Sched, bool ALIGN_EPI, bool GATHER>
__device__ __forceinline__ void gemm_phase(PG8_LAS unsigned char* lds, const Gemm g, const Sched& S, const Epi& E, int tid) {
    asm volatile("" : "+v"(tid));
    const int wid = __builtin_amdgcn_readfirstlane(tid >> 6), lane = tid & 63, wr = wid >> 2, wc = wid & 3, fr = lane & 15, fq = lane >> 4;
    int K = g.K; asm volatile("" : "+s"(K));
    const int nt = K / BK;
    unsigned voffA[2], voffB[2]; int RA[2], CA[2];
#pragma unroll
    for (int i = 0; i < 2; ++i) { int R, C; stage_rc(tid * 16 + i * 8192, R, C); const int Rb = Epi::PERM ? ((R & ~31) + perm32(R & 31)) : R;
        RA[i] = R; CA[i] = C; voffA[i] = (unsigned)(R * g.lda + C) * 2u; voffB[i] = (unsigned)(Rb * K + C) * 2u; }
    const size_t kstep = (size_t)(BK * 2);
    const size_t hstepA = (size_t)HALF * g.lda * 2, hstepB = (size_t)HALF * K * 2;
    const unsigned ldsw = (unsigned)wid * 1024u;
    const int aoff = lds_byte(wr * 64 + fr, fq * 8), boff = lds_byte(wc * 32 + fr, fq * 8);
#define PG8_SA(b, h) (((b) * 2 + (h)) * HTB)
#define PG8_SB(b, h) ((4 + (b) * 2 + (h)) * HTB)
#define PG8_STAGE(bufoff, gbase, voff) do { _Pragma("unroll") for (int _i = 0; _i < 2; ++_i) \
        __builtin_amdgcn_global_load_lds((const unsigned*)((const char*)(gbase) + (voff)[_i]), (PG8_LAS unsigned*)(lds + (bufoff) + ldsw + _i * 8192), 16, 0, 0); } while (0)
#define PG8_STAGE_A(bufoff, kbase, h, GV) do { if constexpr (GATHER) { PG8_STAGE(bufoff, kbase, (GV)[h]); } else { PG8_STAGE(bufoff, (kbase) + (h) * hstepA, voffA); } } while (0)
#define PG8_LDA(dst, b, h) do { _Pragma("unroll") for (int m = 0; m < 4; ++m) _Pragma("unroll") for (int k = 0; k < 2; ++k) dst[m][k] = *(const PG8_LAS bf16x8*)(lds + PG8_SA(b, h) + aoff + m * 2048 + k * 1024); } while (0)
#define PG8_LDB(dst, b, h) do { _Pragma("unroll") for (int n = 0; n < 2; ++n) _Pragma("unroll") for (int k = 0; k < 2; ++k) dst[n][k] = *(const PG8_LAS bf16x8*)(lds + PG8_SB(b, h) + boff + n * 2048 + k * 1024); } while (0)
#define PG8_MMA(ai, bj, At, Bt) do { __builtin_amdgcn_s_setprio(1); _Pragma("unroll") for (int m = 0; m < 4; ++m) _Pragma("unroll") for (int n = 0; n < 2; ++n) _Pragma("unroll") for (int k = 0; k < 2; ++k) \
        acc[ai][bj][m][n] = __builtin_amdgcn_mfma_f32_16x16x32_bf16(Bt[n][k], At[m][k], acc[ai][bj][m][n], 0, 0, 0); __builtin_amdgcn_s_setprio(0); } while (0)
#define PG8_WAIT_V(n) asm volatile("s_waitcnt vmcnt(" #n ")" ::: "memory")
#define PG8_WAIT_L(n) asm volatile("s_waitcnt lgkmcnt(" #n ")" ::: "memory")
#define PG8_BAR __builtin_amdgcn_s_barrier()
#define PG8_SCHED __builtin_amdgcn_sched_barrier(0)
#define PG8_GOFFS(dst, un) do { _Pragma("unroll") for (int _h = 0; _h < 2; ++_h) _Pragma("unroll") for (int _i = 0; _i < 2; ++_i) \
        dst[_h][_i] = (unsigned)S.row_tok(un, _h * HALF + RA[_i]) * (unsigned)(g.lda * 2) + (unsigned)(CA[_i] * 2); } while (0)
    Unit cur, nxt; int ui = 0;
    if (!S.next(0, cur)) return;
    f32x4 acc[2][2][4][2];
#pragma unroll
    for (int a = 0; a < 2; ++a)
#pragma unroll
        for (int b = 0; b < 2; ++b)
#pragma unroll
            for (int m = 0; m < 4; ++m)
#pragma unroll
                for (int n = 0; n < 2; ++n) acc[a][b][m][n] = (f32x4){0.f, 0.f, 0.f, 0.f};
    bf16x8 At[4][2], B0[2][2], B1[2][2];
    unsigned gC[2][2] = {{0u, 0u}, {0u, 0u}}, gN[2][2] = {{0u, 0u}, {0u, 0u}};
    const char* cA = GATHER ? (const char*)g.A : S.a_base(g, cur); const char* cB = S.b_base(g, cur);
    if constexpr (GATHER) { PG8_GOFFS(gC, cur); asm volatile("s_waitcnt vmcnt(0)" ::: "memory"); }
    PG8_STAGE(PG8_SB(0, 0), cB, voffB); PG8_STAGE(PG8_SB(0, 1), cB + hstepB, voffB); PG8_STAGE_A(PG8_SA(0, 0), cA, 0, gC); PG8_STAGE_A(PG8_SA(0, 1), cA, 1, gC);
    if (wr == 1) PG8_BAR;
    PG8_WAIT_V(2); PG8_BAR;
    PG8_STAGE(PG8_SB(1, 0), cB + kstep, voffB); PG8_STAGE_A(PG8_SA(1, 0), cA + kstep, 0, gC); PG8_STAGE(PG8_SB(1, 1), cB + hstepB + kstep, voffB);
    PG8_WAIT_V(6); PG8_BAR;
    for (;;) {
        const bool has_next = S.next(ui + 1, nxt);
        const char* nA = GATHER ? (const char*)g.A : (has_next ? S.a_base(g, nxt) : cA); const char* nB = has_next ? S.b_base(g, nxt) : cB;
        if constexpr (GATHER) {
            if (has_next) { PG8_GOFFS(gN, nxt); }
            else {
#pragma unroll
                for (int _h = 0; _h < 2; ++_h)
#pragma unroll
                    for (int _i = 0; _i < 2; ++_i) gN[_h][_i] = gC[_h][_i];
            }
        }
        for (int t = 0; t < nt; t += 2) {
            if constexpr (Epi::MID) { if (t > 0 && (t & 3) == 0) { const int l2_ = lane_id_fresh_pg8(); E.mid(acc, cur, t >> 2, wr, wc, l2_ & 15, l2_ >> 4); } }
            const bool last = (t == nt - 2);
            const char* a1 = cA + (size_t)(t + 1) * kstep;
            const char* a2 = last ? nA : cA + (size_t)(t + 2) * kstep; const char* b2 = last ? nB : cB + (size_t)(t + 2) * kstep;
            const char* a3 = a2 + kstep; const char* b3 = b2 + kstep;
            unsigned g2[2][2];
            if constexpr (GATHER) {
#pragma unroll
                for (int _h = 0; _h < 2; ++_h)
#pragma unroll
                    for (int _i = 0; _i < 2; ++_i) g2[_h][_i] = last ? gN[_h][_i] : gC[_h][_i];
            }
            PG8_LDB(B0, 0, 0); PG8_LDB(B1, 0, 1); PG8_SCHED; PG8_LDA(At, 0, 0); PG8_STAGE_A(PG8_SA(1, 1), a1, 1, gC);
            PG8_WAIT_V(8); PG8_WAIT_L(0); PG8_BAR; PG8_MMA(0, 0, At, B0); PG8_MMA(0, 1, At, B1); PG8_BAR; PG8_SCHED;
            PG8_LDA(At, 0, 1); PG8_STAGE(PG8_SB(0, 0), b2, voffB); PG8_STAGE(PG8_SB(0, 1), b2 + hstepB, voffB); PG8_STAGE_A(PG8_SA(0, 0), a2, 0, g2);
            PG8_WAIT_V(8); PG8_WAIT_L(0); PG8_BAR; PG8_MMA(1, 0, At, B0); PG8_MMA(1, 1, At, B1); PG8_BAR; PG8_SCHED;
            PG8_LDB(B0, 1, 0); PG8_LDB(B1, 1, 1); PG8_SCHED; PG8_LDA(At, 1, 0); PG8_STAGE_A(PG8_SA(0, 1), a2, 1, g2);
            PG8_WAIT_V(8); PG8_WAIT_L(0); PG8_BAR; PG8_MMA(0, 0, At, B0); PG8_MMA(0, 1, At, B1); PG8_BAR; PG8_SCHED;
            PG8_LDA(At, 1, 1); PG8_STAGE(PG8_SB(1, 0), b3, voffB); PG8_STAGE(PG8_SB(1, 1), b3 + hstepB, voffB); PG8_STAGE_A(PG8_SA(1, 0), a3, 0, g2);
            PG8_WAIT_V(8); PG8_WAIT_L(0); PG8_BAR; PG8_MMA(1, 0, At, B0); PG8_MMA(1, 1, At, B1); PG8_BAR; PG8_SCHED;
        }
        if constexpr (ALIGN_EPI) { if (wr == 0) PG8_BAR; }
        { const int l2_ = lane_id_fresh_pg8();
          E(acc, cur, wr, wc, l2_ & 15, l2_ >> 4); }
        if (!has_next) break;
#pragma unroll
        for (int a = 0; a < 2; ++a)
#pragma unroll
            for (int b = 0; b < 2; ++b)
#pragma unroll
                for (int m = 0; m < 4; ++m)
#pragma unroll
                    for (int n = 0; n < 2; ++n) acc[a][b][m][n] = (f32x4){0.f, 0.f, 0.f, 0.f};
        cur = nxt; cA = nA; cB = nB; ++ui;
        if constexpr (GATHER) {
#pragma unroll
            for (int _h = 0; _h < 2; ++_h)
#pragma unroll
                for (int _i = 0; _i < 2; ++_i) gC[_h][_i] = gN[_h][_i];
        }
        if constexpr (ALIGN_EPI) { if (wr == 1) PG8_BAR; }
    }
    PG8_WAIT_V(0);
    if constexpr (!ALIGN_EPI) { if (wr == 0) PG8_BAR; }
    PG8_BAR;
#undef PG8_SA
#undef PG8_SB
#undef PG8_STAGE
#undef PG8_STAGE_A
#undef PG8_LDA
#undef PG8_LDB
#undef PG8_MMA
#undef PG8_WAIT_V
#undef PG8_WAIT_L
#undef PG8_BAR
#undef PG8_SCHED
#undef PG8_GOFFS
}
}

constexpr int NWAVES = 8;
constexpr int BATCH = 2, SEQ = 8192, D = 1024, M = BATCH * SEQ, NP = 7168, DFF = 2816, NE = 8, INC = 7056;
constexpr int MROWS_MOE = 2 * M + 2048;
constexpr int C_NSAQ = 0, C_KC = 256, C_VC = 320, C_KSL = 384, C_VSL = 448, C_KW = 512, C_VW = 576, C_AG = 640, C_DF = 652,
              C_BQ = 768, C_BK = 1024, C_BV = 1280, C_CQ = 1536, C_CK = 1792, C_CV = 2048, C_DQ = 2304, C_DK = 2560, C_DV = 2816, C_MG = 3072;
constexpr float EPS = 1e-6f;
constexpr float SKIP_THR = 40.0f;

constexpr size_t MiB = 1u << 20;
constexpr size_t WS_CTL = 0, CTL_ZERO_BYTES = 1 * MiB;
constexpr size_t WS_MOD = 1 * MiB;
constexpr size_t WS_LIST = 1 * MiB + 256 * 1024;
constexpr size_t WS_TOKINFO = 2 * MiB;
constexpr size_t WS_Y = 4 * MiB;
constexpr size_t WS_ROPE_C = 4 * MiB, WS_ROPE_S = 5 * MiB;
constexpr size_t WS_KCMP = 6 * MiB, WS_VCMP = 6 * MiB + 256 * 1024;
constexpr size_t WS_CW1T = 8 * MiB;
constexpr size_t WS_WIN = 16 * MiB;
constexpr size_t WS_WBR = 44 * MiB;
constexpr size_t WS_WOUT = 48 * MiB;
constexpr size_t WS_W13 = 52 * MiB;
constexpr size_t WS_W2 = 63 * MiB;
constexpr size_t WS_ARENA = 72 * MiB;
constexpr size_t WS_PROJ = WS_ARENA;
constexpr size_t WS_O = WS_ARENA + 224 * MiB;
constexpr size_t WS_GACC = WS_ARENA + 256 * MiB;
constexpr size_t WS_H = WS_ARENA + 320 * MiB;
constexpr size_t WS_HMID = WS_ARENA;
constexpr size_t WS_MOEW13 = WS_ARENA;
constexpr size_t WS_MOEW2 = WS_ARENA + 88 * MiB;
constexpr size_t WS_HMID_MOE = WS_ARENA + 132 * MiB;
constexpr size_t WS_TILED = WS_GACC;
constexpr size_t WS_LC = WS_TILED + 88 * MiB;
constexpr size_t WS_TC = WS_LC + 512 * 1024;
constexpr size_t WS_END = WS_ARENA + 352 * MiB;
static_assert(WS_TC + 8192 <= WS_H + 32 * MiB, "tiled region");
static_assert(WS_HMID_MOE + (size_t)MROWS_MOE * DFF * 2 <= WS_H, "moe hmid vs H");
static_assert(WS_Y + (size_t)MROWS_MOE * 1024 * 2 <= WS_ARENA, "Y overlay");
constexpr int CW_BAR = 4096;
constexpr int CW_MOECNT = 1024;

constexpr int RING_BYTES = 131072;
constexpr int MISC_OFF = 139264;
constexpr int LDS_BYTES = 147456;

#define GAS __attribute__((address_space(1)))
#define LAS __attribute__((address_space(3)))
typedef unsigned short bf16;
typedef unsigned v4u __attribute__((ext_vector_type(4)));
typedef float f32x4 __attribute__((ext_vector_type(4)));
typedef GAS unsigned gu32;
#define RLX_AGENT __ATOMIC_RELAXED, __HIP_MEMORY_SCOPE_AGENT
#define LDS_WAIT() asm volatile("s_waitcnt lgkmcnt(0)" ::: "memory")
__device__ __forceinline__ unsigned f2bf(float f) { unsigned u = __builtin_bit_cast(unsigned, f); return (u + 0x7fffu + ((u >> 16) & 1u)) >> 16; }
__device__ __forceinline__ unsigned pk2(float lo, float hi) { return f2bf(lo) | (f2bf(hi) << 16); }
__device__ __forceinline__ float bf2f(unsigned short v) { return __uint_as_float((unsigned)v << 16); }
__device__ __forceinline__ int lane_id_fresh() { int l; asm volatile("v_mbcnt_lo_u32_b32 %0, -1, 0\n\tv_mbcnt_hi_u32_b32 %0, -1, %0" : "=v"(l)); return l; }

#define XB_TMO      128
#define XB_XCNT(j)  (256  + 64 * (j))
#define XB_XSUB(j)  (1280 + 64 * (j))
#define XB_XGEN(j)  (2304 + 64 * (j))
#define XB_TOP      3328
#define XB_TOPGEN   3392
#define XCD_BAR_WORDS 3456
#define XB_SPIN_CAP (1u << 22)
__device__ __forceinline__ unsigned xb_ld(unsigned* p)              { return __hip_atomic_load(p, __ATOMIC_RELAXED, __HIP_MEMORY_SCOPE_AGENT); }
__device__ __forceinline__ unsigned xb_add(unsigned* p, unsigned v) { return __hip_atomic_fetch_add(p, v, __ATOMIC_RELAXED, __HIP_MEMORY_SCOPE_AGENT); }
__device__ __forceinline__ unsigned xb_xcc_id() { return (unsigned)__builtin_amdgcn_s_getreg((3 << 11) | 20) & 0xFu; }
#define XB_SPIN(cond, bar) do { unsigned _sp = 0; while (cond) { __builtin_amdgcn_s_sleep(1); \
    if ((++_sp & 255u) == 0u) { if (xb_ld(&(bar)[XB_TMO])) break; if (_sp > XB_SPIN_CAP) { atomicAdd(&(bar)[XB_TMO], 1u); break; } } } } while (0)
struct XcdBarrier { unsigned* bar; unsigned x; volatile LAS unsigned* st; };
__device__ __forceinline__ XcdBarrier xcd_barrier_post(unsigned* bar, volatile LAS unsigned* st, bool leader) {
    XcdBarrier b; b.bar = bar; b.x = xb_xcc_id(); b.st = st;
    if (leader) (void)xb_add(&bar[XB_XCNT(b.x)], 1u);
    return b;
}
__device__ __forceinline__ void xcd_barrier_complete(unsigned* bar, unsigned x, unsigned& nloc, unsigned& nx) {
    const unsigned G = gridDim.x * gridDim.y * gridDim.z;
    unsigned sum, cnt, mine, sp = 0u;
    for (;;) {
        sum = 0u; cnt = 0u; mine = 0u;
#pragma unroll
        for (unsigned j = 0; j < 16; ++j) { const unsigned c = xb_ld(&bar[XB_XCNT(j)]); sum += c; cnt += (c > 0u) ? 1u : 0u; mine = (j == x) ? c : mine; }
        if (sum == G) break;
        __builtin_amdgcn_s_sleep(1);
        if ((++sp & 255u) == 0u) { if (xb_ld(&bar[XB_TMO])) break; if (sp > XB_SPIN_CAP) { atomicAdd(&bar[XB_TMO], 1u); break; } }
    }
    nloc = mine > 0u ? mine : 1u; nx = cnt > 0u ? cnt : 1u;
}
__device__ __forceinline__ void xcd_barrier(const XcdBarrier& b, bool leader) {
    asm volatile("s_waitcnt vmcnt(0)" ::: "memory");
    __syncthreads();
    if (leader) {
        unsigned* bar = b.bar;
        __builtin_amdgcn_s_waitcnt(0);
        unsigned nloc = b.st[0], nx = b.st[1];
        if (nloc == 0u) { xcd_barrier_complete(bar, b.x, nloc, nx); b.st[0] = nloc; b.st[1] = nx; }
        const unsigned old = xb_add(&bar[XB_XSUB(b.x)], 1u);
        const unsigned gen = old / nloc;
        if (old + 1u == (gen + 1u) * nloc) {
            __builtin_amdgcn_fence(__ATOMIC_RELEASE, "agent");
            asm volatile("s_waitcnt vmcnt(0)" ::: "memory");
            const unsigned og = xb_add(&bar[XB_TOP], 1u);
            const unsigned tg = og / nx;
            if (og + 1u == (tg + 1u) * nx) xb_add(&bar[XB_TOPGEN], 1u);
            else XB_SPIN(xb_ld(&bar[XB_TOPGEN]) == tg, bar);
            __builtin_amdgcn_fence(__ATOMIC_ACQUIRE, "agent");
            xb_add(&bar[XB_XGEN(b.x)], 1u);
            asm volatile("s_waitcnt vmcnt(0)" ::: "memory");
        } else {
            XB_SPIN(xb_ld(&bar[XB_XGEN(b.x)]) == gen, bar);
            __builtin_amdgcn_fence(__ATOMIC_ACQUIRE, "agent");
            asm volatile("s_waitcnt vmcnt(0)" ::: "memory");
        }
    }
    __syncthreads();
}

struct Args { const void* in[25]; float* out; unsigned char* ws; int ph_lo, ph_hi; unsigned dup; int pad; };
typedef const __attribute__((address_space(4))) Args* ArgsP;
struct Frame {
    LAS unsigned char* lds;
    int tid, lane, wave, G, gw, NGW, bx;
    unsigned char* ws;
    gu32* ctl;
};

__device__ __forceinline__ float quad_xor1(float v) { return __int_as_float(__builtin_amdgcn_mov_dpp(__float_as_int(v), 0xB1, 0xf, 0xf, true)); }
__device__ __forceinline__ float quad_xor2(float v) { return __int_as_float(__builtin_amdgcn_mov_dpp(__float_as_int(v), 0x4E, 0xf, 0xf, true)); }
template <int K> __device__ __forceinline__ float swz_xor(float v) { return __int_as_float(__builtin_amdgcn_ds_swizzle(__float_as_int(v), (K << 10) | 0x1f)); }
template <int K> __device__ __forceinline__ int swz_xor_i(int v) { return __builtin_amdgcn_ds_swizzle(v, (K << 10) | 0x1f); }
__device__ __forceinline__ float wave_sum(float v) {
    v += swz_xor<1>(v); v += swz_xor<2>(v); v += swz_xor<4>(v); v += swz_xor<8>(v); v += swz_xor<16>(v);
    const auto r = __builtin_amdgcn_permlane32_swap(__float_as_uint(v), __float_as_uint(v), false, false);
    return __uint_as_float(r[0]) + __uint_as_float(r[1]);
}

struct MapIdent { const float* W; int N; __device__ const float* operator()(int n) const { return W + n; } __device__ int stride() const { return N; } };
struct MapWin {
    const float* W;
    __device__ const float* operator()(int j) const {
        int o;
        if (j < 652) o = j; else if (j < 656) o = 2956 + (j - 652); else if (j < 768) return nullptr; else if (j < 3072) o = 652 + (j - 768); else o = 2960 + (j - 3072);
        return W + o;
    }
    __device__ int stride() const { return INC; }
};
struct MapW13 {
    const float* W1; const float* W3;
    __device__ const float* operator()(int j) const { const int tile = j >> 8, r = j & 255; return (r < 128) ? (W1 + tile * 128 + r) : (W3 + tile * 128 + (r - 128)); }
    __device__ int stride() const { return DFF; }
};
template <class Map>
__device__ __forceinline__ void transpose_item(const Map mp, int K, int ldo, bf16* WT, LAS float* scr, int kb, int nb, int lane) {
    const int k0 = 64 * kb, n0 = 64 * nb, kr = lane >> 4, nc = lane & 15; const float* cp = mp(n0 + 4 * nc); const int st = mp.stride();
    const bool live = cp != nullptr; const float* cq = live ? cp : mp(0);
    f32x4 v[16];
#pragma unroll
    for (int i = 0; i < 16; ++i) { v[i] = *(const f32x4*)(cq + (size_t)(k0 + 4 * i + kr) * st); if (!live) v[i] = (f32x4){0.f, 0.f, 0.f, 0.f}; }
#pragma unroll
    for (int i = 0; i < 16; ++i) { LAS float* d = scr + (4 * i + kr) * 65 + 4 * nc; d[0] = v[i][0]; d[1] = v[i][1]; d[2] = v[i][2]; d[3] = v[i][3]; }
    LDS_WAIT(); asm volatile("" ::: "memory");
    const int c = lane & 7;
#pragma unroll
    for (int j = 0; j < 8; ++j) { const int n = (lane >> 3) + 8 * j; const LAS float* sp = scr + (8 * c) * 65 + n;
        v4u o; o.x = pk2(sp[0 * 65], sp[1 * 65]); o.y = pk2(sp[2 * 65], sp[3 * 65]); o.z = pk2(sp[4 * 65], sp[5 * 65]); o.w = pk2(sp[6 * 65], sp[7 * 65]);
        *(GAS v4u*)(WT + (size_t)(n0 + n) * ldo + k0 + 8 * c) = o; }
    LDS_WAIT(); asm volatile("" ::: "memory");
}
template <class Map>
__device__ __forceinline__ void transpose_all(Frame& F, const Map mp, int K, int Nout, bf16* WT, int& itbase, int ldo = 0) {
    if (ldo == 0) ldo = K;
    LAS float* scr = (LAS float*)(F.lds + F.wave * 16640);
    const int nblk = Nout / 64, n = (K / 64) * nblk;
    int first = (F.gw - (itbase % F.NGW) + F.NGW) % F.NGW;
    for (int it = first; it < n; it += F.NGW) transpose_item(mp, K, ldo, WT, scr, it / nblk, it % nblk, F.lane);
    itbase += n;
}

__device__ __forceinline__ float gelu_tanh(float x) { const float u = 0.7978845608028654f * (x + 0.044715f * x * x * x); return 0.5f * x * (1.0f + tanhf(u)); }
__device__ __forceinline__ float log_sigmoid(float x) { return fminf(x, 0.f) - log1pf(__expf(-fabsf(x))); }

__device__ __forceinline__ void load64(const bf16* p, float (&v)[64]) {
    const v4u* p4 = (const v4u*)p;
#pragma unroll
    for (int i = 0; i < 8; ++i) { const v4u u = p4[i];
#pragma unroll
        for (int k = 0; k < 4; ++k) { v[8 * i + 2 * k] = __uint_as_float(u[k] << 16); v[8 * i + 2 * k + 1] = __uint_as_float(u[k] & 0xffff0000u); } }
}
__device__ __forceinline__ float dot64(const bf16* p, const float (&q)[64]) {
    const v4u* p4 = (const v4u*)p; float s0 = 0.f, s1 = 0.f;
#pragma unroll
    for (int i = 0; i < 8; ++i) { if (i == 4) asm volatile("" ::: "memory"); const v4u u = p4[i];
#pragma unroll
        for (int k = 0; k < 4; ++k) { s0 += __uint_as_float(u[k] << 16) * q[8 * i + 2 * k]; s1 += __uint_as_float(u[k] & 0xffff0000u) * q[8 * i + 2 * k + 1]; } }
    return s0 + s1;
}
__device__ __forceinline__ void axpy64(const bf16* p, float w, float (&o)[64]) {
    const v4u* p4 = (const v4u*)p;
#pragma unroll
    for (int i = 0; i < 8; ++i) { if (i == 4) asm volatile("" ::: "memory"); const v4u u = p4[i];
#pragma unroll
        for (int k = 0; k < 4; ++k) { o[8 * i + 2 * k] += w * __uint_as_float(u[k] << 16); o[8 * i + 2 * k + 1] += w * __uint_as_float(u[k] & 0xffff0000u); } }
}
__device__ __forceinline__ void store64(bf16* p, const float (&v)[64]) {
    v4u* p4 = (v4u*)p;
#pragma unroll
    for (int i = 0; i < 8; ++i) { v4u u;
#pragma unroll
        for (int k = 0; k < 4; ++k) u[k] = pk2(v[8 * i + 2 * k], v[8 * i + 2 * k + 1]);
        p4[i] = u; }
}
#define SOFTMAX_STEP(s_, vp_) do { const float _s = (s_); if (_s > m_run) { const float _f = __expf(m_run - _s); l_run *= _f; _Pragma("unroll") for (int _d = 0; _d < 64; ++_d) o[_d] *= _f; m_run = _s; } \
    const float _p = __expf(_s - m_run); l_run += _p; axpy64((vp_), _p, o); } while (0)

__device__ __forceinline__ void phase_prologue(Frame& F, ArgsP a) {
    const float* c_in = (const float*)a->in[1]; const int* pos = (const int*)a->in[2];
    const float* w_ada = (const float*)a->in[3]; const float* b_ada = (const float*)a->in[4];
    {
        LAS float* sc = (LAS float*)(F.lds);
        LAS float* part = (LAS float*)(F.lds + 8192);
        for (int i = F.tid; i < 2048; i += NWAVES * 64) { const float v = c_in[i]; sc[i] = v / (1.0f + __expf(-v)); }
        __syncthreads();
        for (int it = F.bx; it < 2 * 96; it += F.G) {
            const int l = it / 96, j0 = (it % 96) * 64; const float* W = w_ada + (size_t)l * 1024 * 6144 + j0 + F.lane;
            float a0 = 0.f, a1 = 0.f;
#pragma unroll 16
            for (int k = 0; k < 128; ++k) { const int kk = F.wave * 128 + k; const float w = W[(size_t)kk * 6144]; a0 += sc[kk] * w; a1 += sc[1024 + kk] * w; }
            part[(F.wave * 2 + 0) * 64 + F.lane] = a0; part[(F.wave * 2 + 1) * 64 + F.lane] = a1;
            __syncthreads();
            if (F.wave < 2) { float s = 0.f;
#pragma unroll
                for (int w = 0; w < 8; ++w) s += part[(w * 2 + F.wave) * 64 + F.lane];
                ((float*)(F.ws + WS_MOD))[((size_t)l * 2 + F.wave) * 6144 + j0 + F.lane] = s + b_ada[(size_t)l * 6144 + j0 + F.lane]; }
            __syncthreads();
        }
    }
    {
        float* rc = (float*)(F.ws + WS_ROPE_C); float* rs = (float*)(F.ws + WS_ROPE_S);
        for (int i = F.bx * (NWAVES * 64) + F.tid; i < M * 8; i += F.G * NWAVES * 64) {
            const int tok = i >> 3, fi = i & 7;
            const float inv = fi == 0 ? 1.0f : fi == 1 ? 0.1939227432012558f : fi == 2 ? 0.03760603070259094f : fi == 3 ? 0.007292664609849453f : fi == 4 ? 0.0014142135623842478f
                            : fi == 5 ? 0.00027424818836152554f : fi == 6 ? 5.318296098266728e-05f : 1.0313386155758053e-05f;
            const float ang = (float)pos[tok] * inv;
            double rev = (double)ang * 0.15915494309189535; rev -= floor(rev);
            const float fr = (float)rev;
            rs[i] = __builtin_amdgcn_sinf(fr); rc[i] = __builtin_amdgcn_cosf(fr);
        }
    }
    {
        int itb = 0;
        const float* w_in = (const float*)a->in[7]; const float* w_br = (const float*)a->in[16]; const float* w_out = (const float*)a->in[17];
        for (int l = 0; l < 2; ++l) {
            transpose_all(F, MapWin{w_in + (size_t)l * 1024 * INC}, 1024, NP, (bf16*)(F.ws + WS_WIN) + (size_t)l * NP * 1024, itb);
            for (int z = 0; z < 4; ++z) transpose_all(F, MapIdent{w_br + ((size_t)l * 4 + z) * 256 * 1024, 1024}, 256, 1024, (bf16*)(F.ws + WS_WBR) + (size_t)l * 1024 * 1024 + z * 256, itb, 1024);
            transpose_all(F, MapIdent{w_out + (size_t)l * 1024 * 1024, 1024}, 1024, 1024, (bf16*)(F.ws + WS_WOUT) + (size_t)l * 1024 * 1024, itb);
        }
        for (int l = 0; l < 2; ++l) {
            transpose_all(F, MapIdent{(const float*)a->in[11] + (size_t)l * 2048 * 128, 128}, 2048, 128, (bf16*)(F.ws + WS_CW1T) + (size_t)(l * 2 + 0) * 128 * 2048, itb);
            transpose_all(F, MapIdent{(const float*)a->in[13] + (size_t)l * 2048 * 128, 128}, 2048, 128, (bf16*)(F.ws + WS_CW1T) + (size_t)(l * 2 + 1) * 128 * 2048, itb);
        }
        transpose_all(F, MapW13{(const float*)a->in[18], (const float*)a->in[19]}, 1024, 2 * DFF, (bf16*)(F.ws + WS_W13), itb);
        transpose_all(F, MapIdent{(const float*)a->in[20], 1024}, DFF, 1024, (bf16*)(F.ws + WS_W2), itb);
    }
}
__device__ __forceinline__ void phase_moe_weights(Frame& F, ArgsP a) {
    int itb = 0;
    const float* w1 = (const float*)a->in[22]; const float* w3 = (const float*)a->in[23]; const float* w2 = (const float*)a->in[24];
    for (int e = 0; e < NE; ++e) {
        transpose_all(F, MapW13{w1 + (size_t)e * 1024 * DFF, w3 + (size_t)e * 1024 * DFF}, 1024, 2 * DFF, (bf16*)(F.ws + WS_MOEW13) + (size_t)e * 2 * DFF * 1024, itb);
        transpose_all(F, MapIdent{w2 + (size_t)e * DFF * 1024, 1024}, DFF, 1024, (bf16*)(F.ws + WS_MOEW2) + (size_t)e * 1024 * DFF, itb);
    }
}

template <bool ROUTE>
__device__ __forceinline__ void phase_norm(Frame& F, const float* x, const float* nw, const float* sh, const float* sc, const float* router) {
    bf16* H = (bf16*)(F.ws + WS_H);
    const int rows_per = ROUTE ? 8 : 1;
    for (int r0 = F.gw * rows_per; r0 < M; r0 += F.NGW * rows_per) {
        const int b = r0 >> 13;
        f32x4 A[4], Bv[4];
#pragma unroll
        for (int j = 0; j < 4; ++j) { const int c = 4 * F.lane + 256 * j; const f32x4 w = *(const f32x4*)(nw + c), s = *(const f32x4*)(sc + (size_t)b * 6144 + c); A[j] = w * (s + 1.0f); Bv[j] = *(const f32x4*)(sh + (size_t)b * 6144 + c); }
        int myE = 0; float myG = 0.f;
        for (int rr = 0; rr < rows_per; ++rr) {
            const int m = r0 + rr;
            const GAS f32x4* xr = (const GAS f32x4*)(x + (size_t)m * D) + F.lane;
            f32x4 v[4]; float s2 = 0.f;
#pragma unroll
            for (int j = 0; j < 4; ++j) { v[j] = xr[64 * j]; s2 += (v[j].x * v[j].x + v[j].y * v[j].y) + (v[j].z * v[j].z + v[j].w * v[j].w); }
            const float rstd = 1.0f / sqrtf(wave_sum(s2) * (1.f / D) + EPS);
#pragma unroll
            for (int j = 0; j < 4; ++j) v[j] = (v[j] * rstd) * A[j] + Bv[j];
            GAS unsigned long long* o8 = (GAS unsigned long long*)(H + (size_t)m * D) + F.lane;
#pragma unroll
            for (int j = 0; j < 4; ++j) o8[64 * j] = (unsigned long long)pk2(v[j].x, v[j].y) | ((unsigned long long)pk2(v[j].z, v[j].w) << 32);
            if constexpr (ROUTE) {
                float lg[8];
#pragma unroll
                for (int e = 0; e < 8; ++e) lg[e] = 0.f;
#pragma unroll
                for (int j = 0; j < 4; ++j)
#pragma unroll
                    for (int k = 0; k < 4; ++k) { const int c = 4 * F.lane + 256 * j + k; const f32x4 w0 = *(const f32x4*)(router + (size_t)c * 8), w1 = *(const f32x4*)(router + (size_t)c * 8 + 4); const float xv = v[j][k];
                        lg[0] += xv * w0.x; lg[1] += xv * w0.y; lg[2] += xv * w0.z; lg[3] += xv * w0.w; lg[4] += xv * w1.x; lg[5] += xv * w1.y; lg[6] += xv * w1.z; lg[7] += xv * w1.w; }
#pragma unroll
                for (int e = 0; e < 8; ++e) lg[e] = wave_sum(lg[e]);
                int e0 = 0; float v0 = lg[0];
#pragma unroll
                for (int e = 1; e < 8; ++e) if (lg[e] > v0) { v0 = lg[e]; e0 = e; }
                int e1 = -1; float v1 = -3.0e38f;
#pragma unroll
                for (int e = 0; e < 8; ++e) if (e != e0 && lg[e] > v1) { v1 = lg[e]; e1 = e; }
                const float g0 = 1.0f / (1.0f + __expf(v1 - v0)), g1 = 1.0f - g0;
                if (F.lane == 2 * rr) { myE = e0; myG = g0; }
                if (F.lane == 2 * rr + 1) { myE = e1; myG = g1; }
            }
        }
        if constexpr (ROUTE) {
            gu32* cnt = F.ctl + CW_MOECNT; int* list = (int*)(F.ws + WS_LIST); int* info = (int*)(F.ws + WS_TOKINFO);
            const bool act = F.lane < 16; int myrank = 0;
#pragma unroll
            for (int e = 0; e < 8; ++e) {
                const unsigned long long mk = __ballot(act && myE == e);
                const int c = __popcll(mk); unsigned base = 0;
                if (c > 0) { if (F.lane == 0) base = __hip_atomic_fetch_add(cnt + 64 * e, (unsigned)c, RLX_AGENT); base = __builtin_amdgcn_readfirstlane(base); }
                if (act && myE == e) myrank = (int)base + __popcll(mk & ((1ull << F.lane) - 1ull));
            }
            if (act) { const int tok = r0 + (F.lane >> 1); list[myE * 16384 + myrank] = tok; int* ip = info + ((size_t)tok * 2 + (F.lane & 1)) * 4; ip[0] = myE; ip[1] = myrank; ip[2] = __float_as_int(myG); ip[3] = 0; }
        }
    }
}

typedef short bf16x8c __attribute__((ext_vector_type(8)));
typedef float f32x16c __attribute__((ext_vector_type(16)));
__device__ __forceinline__ void compress_item(Frame& F, int item, const float* pe_k, const float* pe_v, const bf16* w1t_base, const float* k2, const float* v2, const float* g1) {
    const int which = item >> 5, b = (item >> 4) & 1, gi = item & 15, r32 = F.lane & 31, hi = F.lane >> 5, nb = F.wave & 3, kh = F.wave >> 2;
    const float* pe = which ? pe_v : pe_k; const bf16* w1t = w1t_base + (size_t)which * 128 * 2048; const float* w2 = which ? v2 : k2; const int col = which ? C_VC : C_KC;
    const bf16* P = (const bf16*)(F.ws + WS_PROJ);
    LAS unsigned char* X = F.lds;
    LAS float* PE = (LAS float*)(F.lds + 78336);
    LAS float* HX = (LAS float*)(F.lds + 86528);
    LAS float* OP = (LAS float*)(F.lds + 102912);
    LAS float* hxb = HX + nb * 1024 + F.lane; LAS float* opb = OP + nb * 2048 + F.lane; LAS float* op0 = OP + F.lane; asm volatile("" : "+v"(hxb), "+v"(opb), "+v"(op0));
    { const f32x4 gav = *(const f32x4*)(g1 + 8 * (F.lane & 7)), gbv = *(const f32x4*)(g1 + 8 * (F.lane & 7) + 4);
      v4u rawv[9];
#pragma unroll
      for (int u = 0; u < 9; ++u) { int i = F.tid + 512 * u; i = i < 4224 ? i : 4223; const int tok = i >> 3, ch = i & 7; int gt = 512 * gi + tok; gt = gt > SEQ - 1 ? SEQ - 1 : gt;
          rawv[u] = *(const v4u*)(P + (size_t)(b * SEQ + gt) * NP + col + 8 * ch); }
#pragma unroll
      for (int u = 0; u < 9; ++u) { const int i = F.tid + 512 * u; const int tok = i >> 3, ch = i & 7; v4u raw = rawv[u];
          if (!which) {
              float v[8]; float ss = 0.f;
#pragma unroll
              for (int k = 0; k < 4; ++k) { v[2 * k] = __uint_as_float(raw[k] << 16); v[2 * k + 1] = __uint_as_float(raw[k] & 0xffff0000u); ss += v[2 * k] * v[2 * k] + v[2 * k + 1] * v[2 * k + 1]; }
              ss += swz_xor<1>(ss); ss += swz_xor<2>(ss); ss += swz_xor<4>(ss);
              const float rinv = 1.0f / sqrtf(ss * (1.f / 64.f) + EPS);
              raw[0] = pk2(v[0] * rinv * gav[0], v[1] * rinv * gav[1]); raw[1] = pk2(v[2] * rinv * gav[2], v[3] * rinv * gav[3]); raw[2] = pk2(v[4] * rinv * gbv[0], v[5] * rinv * gbv[1]); raw[3] = pk2(v[6] * rinv * gbv[2], v[7] * rinv * gbv[3]);
          }
          if (i < 4224) *(LAS v4u*)(X + ((tok & 15) * 34 + (tok >> 4)) * 144 + ch * 16) = raw; }
      for (int i = F.tid; i < 2048; i += NWAVES * 64) PE[i] = pe[i];
    }
    __syncthreads();
    f32x16c acc = {};
    { bf16x8c ring[4];
      const bf16* wl = w1t + (size_t)(32 * nb + r32) * 2048 + 8 * hi + 16 * (64 * kh);
#define CLOADB(slot, ks_) ring[slot] = *(const bf16x8c*)(wl + 16 * (ks_))
      CLOADB(0, 0); CLOADB(1, 1); CLOADB(2, 2);
#pragma unroll 1
      for (int ll = 0; ll < 16; ++ll) { const int l = 16 * kh + ll;
          const LAS unsigned char* xr = X + ((l & 15) * 34 + r32 + (l >> 4)) * 144 + 16 * hi;
          const LAS float* per = PE + l * 64 + 8 * hi;
#pragma unroll
          for (int u = 0; u < 4; ++u) {
              const int ks = 4 * ll + u; { const int kq = ks + 3 < 64 ? ks + 3 : 63; CLOADB((u + 3) & 3, kq); }
              const v4u raw = *(const LAS v4u*)(xr + 32 * u);
              const f32x4 p0 = *(const LAS f32x4*)(per + 16 * u), p1 = *(const LAS f32x4*)(per + 16 * u + 4);
              v4u w;
              w[0] = pk2(__uint_as_float(raw[0] << 16) + p0[0], __uint_as_float(raw[0] & 0xffff0000u) + p0[1]);
              w[1] = pk2(__uint_as_float(raw[1] << 16) + p0[2], __uint_as_float(raw[1] & 0xffff0000u) + p0[3]);
              w[2] = pk2(__uint_as_float(raw[2] << 16) + p1[0], __uint_as_float(raw[2] & 0xffff0000u) + p1[1]);
              w[3] = pk2(__uint_as_float(raw[3] << 16) + p1[2], __uint_as_float(raw[3] & 0xffff0000u) + p1[3]);
              acc = __builtin_amdgcn_mfma_f32_32x32x16_bf16(ring[u], __builtin_bit_cast(bf16x8c, w), acc, 0, 0, 0);
          }
      }
#undef CLOADB
    }
    if (kh == 1) {
#pragma unroll
        for (int r = 0; r < 16; ++r) hxb[r * 64] = acc[r]; }
    __syncthreads();
    if (kh == 0) {
#pragma unroll
        for (int r = 0; r < 16; ++r) acc[r] += hxb[r * 64];
#pragma unroll
        for (int r = 0; r < 16; ++r) { const float x = acc[r]; const float u2 = 1.5957691216057308f * (x + 0.044715f * x * x * x); acc[r] = x * __builtin_amdgcn_rcpf(1.0f + __expf(-u2)); }
        f32x16c o0 = {}, o1 = {};
#pragma unroll
        for (int s2 = 0; s2 < 2; ++s2) {
            v4u hw;
#pragma unroll
            for (int k = 0; k < 4; ++k) hw[k] = pk2(acc[8 * s2 + 2 * k], acc[8 * s2 + 2 * k + 1]);
            const bf16x8c hf = __builtin_bit_cast(bf16x8c, hw);
            v4u a0, a1;
#pragma unroll
            for (int k = 0; k < 4; ++k) { const int j0 = 2 * k, j1 = 2 * k + 1;
                const int n0 = 32 * nb + 16 * s2 + 8 * (j0 >> 2) + 4 * hi + (j0 & 3), n1 = 32 * nb + 16 * s2 + 8 * (j1 >> 2) + 4 * hi + (j1 & 3);
                a0[k] = pk2(w2[n0 * 64 + r32], w2[n1 * 64 + r32]); a1[k] = pk2(w2[n0 * 64 + 32 + r32], w2[n1 * 64 + 32 + r32]); }
            o0 = __builtin_amdgcn_mfma_f32_32x32x16_bf16(__builtin_bit_cast(bf16x8c, a0), hf, o0, 0, 0, 0);
            o1 = __builtin_amdgcn_mfma_f32_32x32x16_bf16(__builtin_bit_cast(bf16x8c, a1), hf, o1, 0, 0, 0);
        }
#pragma unroll
        for (int r = 0; r < 16; ++r) { opb[r * 64] = o0[r]; opb[(16 + r) * 64] = o1[r]; }
    }
    __syncthreads();
    if (F.wave == 0) {
        f32x16c o0, o1;
#pragma unroll
        for (int r = 0; r < 16; ++r) { o0[r] = (op0[r * 64] + op0[(32 + r) * 64]) + (op0[(64 + r) * 64] + op0[(96 + r) * 64]);
                                       o1[r] = (op0[(16 + r) * 64] + op0[(48 + r) * 64]) + (op0[(80 + r) * 64] + op0[(112 + r) * 64]); }
        const bool live = (32 * gi + r32) <= 510;
        char* base = (char*)(F.ws + (which ? WS_VCMP : WS_KCMP)) + (size_t)b * 65536 + gi * 4096;
#pragma unroll
        for (int db = 0; db < 2; ++db)
#pragma unroll
            for (int g = 0; g < 4; ++g) {
                float v[4];
#pragma unroll
                for (int k = 0; k < 4; ++k) { const float x = db ? o1[4 * g + k] : o0[4 * g + k]; v[k] = live ? x : 0.f; }
                if (!which) { uint2 w; w.x = pk2(v[0], v[1]); w.y = pk2(v[2], v[3]); *(uint2*)(base + (2 * db + (g >> 1)) * 1024 + (r32 + 32 * (g & 1)) * 16 + 8 * hi) = w; }
                else { const int kk = r32, s2 = kk >> 4, rem = kk & 15, hh = (rem >> 2) & 1, j = 4 * (rem >> 3) + (rem & 3);
#pragma unroll
                    for (int k = 0; k < 4; ++k) { const int d = 32 * db + 8 * g + 4 * hi + k; *(bf16*)(base + ((d >> 5) * 2 + s2) * 1024 + ((d & 31) + 32 * hh) * 16 + j * 2) = (bf16)f2bf(v[k]); } }
            }
    }
    __syncthreads();
}
__device__ __forceinline__ void phase_compress(Frame& F, int l, const float* pe_k, const float* pe_v, const float* k2, const float* v2, const float* g1) {
    const bf16* w1t = (const bf16*)(F.ws + WS_CW1T) + (size_t)l * 2 * 128 * 2048;
    for (int it = F.bx; it < 64; it += F.G) compress_item(F, it, pe_k, pe_v, w1t, k2, v2, g1);
}

typedef short bf16x8v __attribute__((ext_vector_type(8)));
typedef float f32x16 __attribute__((ext_vector_type(16)));
constexpr float LOG2E = 1.4426950408889634f;
constexpr float QK_C = 0.125f * LOG2E;
constexpr float THR2 = SKIP_THR * LOG2E;
__device__ __forceinline__ const char* stream_tile(const Frame& F, int sid, int b, int tile) { return (const char*)(F.ws + WS_TILED) + (size_t)sid * (2 * MiB) + (size_t)b * MiB + (size_t)tile * 4096; }
__device__ __forceinline__ void load_tile(const char* kt, const char* vt, int lane, bf16x8v (&kf)[4], bf16x8v (&vf)[4]) {
#pragma unroll
    for (int i = 0; i < 4; ++i) { kf[i] = *(const bf16x8v*)(kt + i * 1024 + lane * 16); vf[i] = *(const bf16x8v*)(vt + i * 1024 + lane * 16); }
}
__device__ __forceinline__ f32x16 qk_tile(const bf16x8v (&kf)[4], const bf16x8v (&qf)[4]) {
    f32x16 s = {};
#pragma unroll
    for (int i = 0; i < 4; ++i) s = __builtin_amdgcn_mfma_f32_32x32x16_bf16(kf[i], qf[i], s, 0, 0, 0);
    return s;
}
__device__ __forceinline__ float half_max(float v) { const auto r = __builtin_amdgcn_permlane32_swap(__float_as_uint(v), __float_as_uint(v), false, false); return fmaxf(__uint_as_float(r[0]), __uint_as_float(r[1])); }
__device__ __forceinline__ float half_sum(float v) { const auto r = __builtin_amdgcn_permlane32_swap(__float_as_uint(v), __float_as_uint(v), false, false); return __uint_as_float(r[0]) + __uint_as_float(r[1]); }
__device__ __forceinline__ float half_other(float v, int hi) { const auto r = __builtin_amdgcn_permlane32_swap(__float_as_uint(v), __float_as_uint(v), false, false); return __uint_as_float(hi ? r[0] : r[1]); }
struct SoftSt { f32x16 o0, o1; float m, l; };
__device__ __forceinline__ void soft_init(SoftSt& st) { st.o0 = (f32x16){}; st.o1 = (f32x16){}; st.m = -1.0e30f; st.l = 0.f; }
__device__ __forceinline__ void pv_tile(SoftSt& st, const f32x16& p, const bf16x8v (&vf)[4]) {
    bf16x8v pf[2];
#pragma unroll
    for (int s2 = 0; s2 < 2; ++s2) { v4u w;
#pragma unroll
        for (int k = 0; k < 4; ++k) w[k] = pg8::cvt_pk_bf16(p[8 * s2 + 2 * k], p[8 * s2 + 2 * k + 1]);
        pf[s2] = __builtin_bit_cast(bf16x8v, w); }
    st.o0 = __builtin_amdgcn_mfma_f32_32x32x16_bf16(vf[0], pf[0], st.o0, 0, 0, 0);
    st.o0 = __builtin_amdgcn_mfma_f32_32x32x16_bf16(vf[1], pf[1], st.o0, 0, 0, 0);
    st.o1 = __builtin_amdgcn_mfma_f32_32x32x16_bf16(vf[2], pf[0], st.o1, 0, 0, 0);
    st.o1 = __builtin_amdgcn_mfma_f32_32x32x16_bf16(vf[3], pf[1], st.o1, 0, 0, 0);
}
__device__ __forceinline__ void soft_pv(SoftSt& st, f32x16& s, const bf16x8v (&vf)[4]) {
    float tm = fmaxf(fmaxf(s[0], s[1]), fmaxf(s[2], s[3]));
#pragma unroll
    for (int r = 4; r < 16; r += 4) tm = fmaxf(tm, fmaxf(fmaxf(s[r], s[r + 1]), fmaxf(s[r + 2], s[r + 3])));
    tm = half_max(tm);
    const float mn = fmaxf(st.m, tm);
    if (__any(mn > st.m)) { const float al = __builtin_amdgcn_exp2f(st.m - mn); st.l *= al; st.o0 = st.o0 * al; st.o1 = st.o1 * al; }
    st.m = mn;
    float ls = 0.f;
#pragma unroll
    for (int r = 0; r < 16; ++r) { s[r] = __builtin_amdgcn_exp2f(s[r] - mn); ls += s[r]; }
    st.l += ls;
    pv_tile(st, s, vf);
}
__device__ __forceinline__ void fixed_pv(SoftSt& st, f32x16& s, const bf16x8v (&vf)[4]) {
    float ls = 0.f;
#pragma unroll
    for (int r = 0; r < 16; ++r) { s[r] = __builtin_amdgcn_exp2f(s[r]); ls += s[r]; }
    st.l += ls;
    pv_tile(st, s, vf);
}
__device__ __forceinline__ void store_ot(bf16* orow, const f32x16& o0, const f32x16& o1, float sc, int hi) {
#pragma unroll
    for (int g = 0; g < 4; ++g) {
        uint2 w0, w1;
        w0.x = pg8::cvt_pk_bf16(o0[4 * g] * sc, o0[4 * g + 1] * sc); w0.y = pg8::cvt_pk_bf16(o0[4 * g + 2] * sc, o0[4 * g + 3] * sc);
        w1.x = pg8::cvt_pk_bf16(o1[4 * g] * sc, o1[4 * g + 1] * sc); w1.y = pg8::cvt_pk_bf16(o1[4 * g + 2] * sc, o1[4 * g + 3] * sc);
        *(uint2*)(orow + 8 * g + 4 * hi) = w0; *(uint2*)(orow + 32 + 8 * g + 4 * hi) = w1;
    }
}
__device__ __forceinline__ void load_q(const bf16* qrow, int hi, bf16x8v (&qf)[4]) {
#pragma unroll
    for (int i = 0; i < 4; ++i) qf[i] = *(const bf16x8v*)(qrow + 16 * i + 8 * hi);
}
#define CROW(r, hi) (((r) & 3) + 8 * ((r) >> 2) + 4 * (hi))
#define PIPE3(n_, PTRS, BODY) do { const int np_ = (n_); const char* kp_; const char* vp_; \
    if (np_ > 0) { PTRS(0, kp_, vp_); load_tile(kp_, vp_, F.lane, kfA, vfA); PTRS((np_ > 1 ? 1 : 0), kp_, vp_); load_tile(kp_, vp_, F.lane, kfB, vfB); } \
    _Pragma("unroll 1") for (int i_ = 0; i_ < np_; i_ += 3) { \
          \
        { const int j_ = i_ + 2 < np_ ? i_ + 2 : np_ - 1; PTRS(j_, kp_, vp_); load_tile(kp_, vp_, F.lane, kfC, vfC); } \
        BODY(i_, kfA, vfA); \
        if (i_ + 1 < np_) { { const int j_ = i_ + 3 < np_ ? i_ + 3 : np_ - 1; PTRS(j_, kp_, vp_); load_tile(kp_, vp_, F.lane, kfA, vfA); } BODY(i_ + 1, kfB, vfB); \
        if (i_ + 2 < np_) { { const int j_ = i_ + 4 < np_ ? i_ + 4 : np_ - 1; PTRS(j_, kp_, vp_); load_tile(kp_, vp_, F.lane, kfB, vfB); } BODY(i_ + 2, kfC, vfC); } } } } while (0)

__device__ __forceinline__ void attn_fox_unit(Frame& F, int unit, const float* gk) {
    const int h = unit & 3, qt = (unit >> 2) & 255, b = unit >> 10, r32 = F.lane & 31, hi = F.lane >> 5;
    const bf16* P = (const bf16*)(F.ws + WS_PROJ); bf16* O = (bf16*)(F.ws + WS_O);
    const int tg = b * SEQ + 32 * qt + r32;
    bf16x8v qf[4]; load_q(P + (size_t)tg * NP + C_DQ + 64 * h, hi, qf);
    float qn = 0.f, gmax = 0.f;
#pragma unroll
    for (int i = 0; i < 4; ++i)
#pragma unroll
        for (int j = 0; j < 8; ++j) { const float v = bf2f((unsigned short)qf[i][j]); qn += v * v; }
    qn = half_sum(qn);
    for (int d = 0; d < 64; ++d) gmax = fmaxf(gmax, fabsf(gk[d]));
    const float qkmax2 = sqrtf(qn) * (8.0f * gmax) * QK_C * 1.02f;
    const float* LC = (const float*)(F.ws + WS_LC) + ((size_t)b * 4 + h) * SEQ; const float* TC = (const float*)(F.ws + WS_TC) + ((size_t)b * 4 + h) * 256;
    const float lct = LC[32 * qt + r32];
    SoftSt st; soft_init(st);
    bf16x8v kf[4], vf[4], kn[4], vn[4];
    load_tile(stream_tile(F, 36 + h, b, qt), stream_tile(F, 40 + h, b, qt), F.lane, kf, vf);
    float gacc = 0.f;
    for (int kt = qt; kt >= 0; --kt) {
        { const int kq = kt > 0 ? kt - 1 : 0; load_tile(stream_tile(F, 36 + h, b, kq), stream_tile(F, 40 + h, b, kq), F.lane, kn, vn); }
        f32x16 s = qk_tile(kf, qf);
        const float base = lct + gacc - qkmax2;
#pragma unroll
        for (int g = 0; g < 4; ++g) { const f32x4 lc = *(const f32x4*)(LC + 32 * kt + 8 * g + 4 * hi);
#pragma unroll
            for (int k = 0; k < 4; ++k) s[4 * g + k] = s[4 * g + k] * QK_C + (base - lc[k]); }
        if (kt == qt) {
#pragma unroll
            for (int r = 0; r < 16; ++r) if (CROW(r, hi) > r32) s[r] = -INFINITY;
        }
        fixed_pv(st, s, vf);
        if (__all(lct + gacc + 13.0f < __builtin_amdgcn_logf(half_sum(st.l)) - THR2)) break;
        if (kt > 0) gacc += TC[kt - 1];
#pragma unroll
        for (int i = 0; i < 4; ++i) { kf[i] = kn[i]; vf[i] = vn[i]; }
    }
    const float lt = half_sum(st.l);
    store_ot(O + (size_t)tg * 1024 + 768 + 64 * h, st.o0, st.o1, 1.0f / lt, hi);
}
__device__ __forceinline__ void attn_sb_unit(Frame& F, int unit) {
    const int h = unit & 3, qt = (unit >> 2) & 255, b = unit >> 10, r32 = F.lane & 31, hi = F.lane >> 5;
    const bf16* P = (const bf16*)(F.ws + WS_PROJ); bf16* O = (bf16*)(F.ws + WS_O);
    const int tg = b * SEQ + 32 * qt + r32;
    bf16x8v qf[4]; load_q(P + (size_t)tg * NP + C_CQ + 64 * h, hi, qf);
    SoftSt st; soft_init(st);
    bf16x8v kf[4], vf[4], kn[4], vn[4];
    load_tile(stream_tile(F, 28 + h, b, qt), stream_tile(F, 32 + h, b, qt), F.lane, kf, vf);
    float R = 0.f;
    for (int kt = qt; kt >= 0; --kt) {
        { const int kq = kt > 0 ? kt - 1 : 0; load_tile(stream_tile(F, 28 + h, b, kq), stream_tile(F, 32 + h, b, kq), F.lane, kn, vn); }
        f32x16 s = qk_tile(kf, qf);
        float L[16];
#pragma unroll
        for (int r = 0; r < 16; ++r) { const float z2 = s[r] * QK_C; const float sp = fmaxf(z2, 0.f) + __builtin_amdgcn_logf(1.0f + __builtin_amdgcn_exp2f(-fabsf(z2)));
            const bool ok = (kt < qt) || (CROW(r, hi) < r32); L[r] = ok ? -sp : 0.f; s[r] = ok ? (z2 - sp) : -INFINITY; }
        float gt[4], og[4];
#pragma unroll
        for (int g = 0; g < 4; ++g) { gt[g] = (L[4 * g] + L[4 * g + 1]) + (L[4 * g + 2] + L[4 * g + 3]); og[g] = half_other(gt[g], hi); }
        float suf[4];
        { float a = 0.f;
#pragma unroll
          for (int g = 3; g >= 0; --g) { suf[g] = a; a += gt[g]; }
          float bsum = 0.f;
#pragma unroll
          for (int g = 3; g >= 0; --g) { if (hi == 0) { bsum += og[g]; suf[g] += bsum; } else { suf[g] += bsum; bsum += og[g]; } }
        }
#pragma unroll
        for (int g = 0; g < 4; ++g) { const float a3 = R + suf[g], a2 = a3 + L[4 * g + 3], a1 = a2 + L[4 * g + 2], a0 = a1 + L[4 * g + 1];
            s[4 * g + 3] = __builtin_amdgcn_exp2f(s[4 * g + 3] + a3); s[4 * g + 2] = __builtin_amdgcn_exp2f(s[4 * g + 2] + a2);
            s[4 * g + 1] = __builtin_amdgcn_exp2f(s[4 * g + 1] + a1); s[4 * g] = __builtin_amdgcn_exp2f(s[4 * g] + a0); }
        pv_tile(st, s, vf);
        R += ((gt[0] + gt[1]) + (gt[2] + gt[3])) + ((og[0] + og[1]) + (og[2] + og[3]));
        if (__all(R < -THR2)) break;
#pragma unroll
        for (int i = 0; i < 4; ++i) { kf[i] = kn[i]; vf[i] = vn[i]; }
    }
    store_ot(O + (size_t)tg * 1024 + 512 + 64 * h, st.o0, st.o1, 1.0f, hi);
}
__device__ __forceinline__ void attn_dil_unit(Frame& F, int unit, const float* gk) {
    const int h = unit & 3, r16 = (unit >> 2) & 15, blk = (unit >> 6) & 15, b = unit >> 10, r32 = F.lane & 31, hi = F.lane >> 5;
    const bf16* P = (const bf16*)(F.ws + WS_PROJ); bf16* O = (bf16*)(F.ws + WS_O);
    const int t = 512 * blk + r16 + 16 * r32, tg = b * SEQ + t;
    bf16x8v qf[4]; load_q(P + (size_t)tg * NP + C_BQ + 64 * h, hi, qf);
    float mfix;
    { float qn = 0.f, gmax = 0.f;
#pragma unroll
      for (int i = 0; i < 4; ++i)
#pragma unroll
          for (int j = 0; j < 8; ++j) { const float v = bf2f((unsigned short)qf[i][j]); qn += v * v; }
      qn = half_sum(qn);
      for (int d = 0; d < 64; ++d) gmax = fmaxf(gmax, fabsf(gk[d]));
      mfix = sqrtf(qn) * (8.0f * gmax) * QK_C * 1.02f; }
    SoftSt st; soft_init(st);
    bf16x8v kfA[4], vfA[4], kfB[4], vfB[4], kfC[4], vfC[4];
    const int lo0 = 16 * blk - 4 < 0 ? 0 : 16 * blk - 4, lo1 = 4 * blk - 4 < 0 ? 0 : 4 * blk - 4, lo2 = blk - 4 < 0 ? 0 : blk - 4;
    const int n0 = 16 * blk + 15 - lo0 + 1, n1 = 4 * blk + 3 - lo1 + 1, n2 = blk - lo2 + 1;
#define DIL_DEC(i, gi_, tl_) const int gi_ = ((i) >= n0) + ((i) >= n0 + n1); const int tl_ = gi_ == 0 ? lo0 + (i) : gi_ == 1 ? lo1 + ((i) - n0) : lo2 + ((i) - n0 - n1)
#define DIL_PTRS(i, kp, vp) do { DIL_DEC(i, g_, t_); const int sid_ = 4 + 4 * g_ + h; const int tb_ = g_ == 0 ? 0 : g_ == 1 ? (r16 & 3) * 64 : r16 * 16; kp = stream_tile(F, sid_, b, tb_ + t_); vp = stream_tile(F, sid_ + 12, b, tb_ + t_); } while (0)
#define DIL_BODY(i, KF, VF) do { DIL_DEC(i, g_, t_); const int qi_ = g_ == 0 ? t : g_ == 1 ? (t >> 2) : (t >> 4); f32x16 s = qk_tile(KF, qf); \
        _Pragma("unroll") for (int r = 0; r < 16; ++r) { const int df = qi_ - (32 * t_ + CROW(r, hi)); s[r] = (df >= 0 && df <= 128) ? (s[r] * QK_C - mfix) : -INFINITY; } \
        fixed_pv(st, s, VF); } while (0)
    PIPE3(n0 + n1 + n2, DIL_PTRS, DIL_BODY);
#undef DIL_DEC
#undef DIL_PTRS
#undef DIL_BODY
    const float lt = half_sum(st.l);
    store_ot(O + (size_t)tg * 1024 + 256 + 64 * h, st.o0, st.o1, 1.0f / lt, hi);
}

__device__ __forceinline__ void attn_nsa_unit(Frame& F, int unit, const float* qk_gain, unsigned mode) {
    const int b = unit >> 10, t0 = (unit & 1023) * 8, r32 = F.lane & 31, hi = F.lane >> 5, qi = r32 >> 2, head = r32 & 3;
    const int t = t0 + qi, tg = b * SEQ + t;
    const bf16* P = (const bf16*)(F.ws + WS_PROJ); bf16* O = (bf16*)(F.ws + WS_O);
    LAS float* imp = (LAS float*)(F.lds + F.wave * 5120);
    LAS unsigned* selm = (LAS unsigned*)(F.lds + F.wave * 5120 + 4096);
    LAS float* otl = (LAS float*)(F.lds + 40960 + F.wave * 8192) + F.lane;
    const bf16* prow = P + (size_t)tg * NP;
    const float g0 = pg8::sigmoid_f(bf2f(prow[C_AG + 3 * head])), g1 = pg8::sigmoid_f(bf2f(prow[C_AG + 3 * head + 1])), g2 = pg8::sigmoid_f(bf2f(prow[C_AG + 3 * head + 2]));
    bf16x8v qf[4]; load_q(prow + C_NSAQ + 64 * head, hi, qf);
    SoftSt st; bf16x8v kfA[4], vfA[4], kfB[4], vfB[4], kfC[4], vfC[4];
    const int cmax = (t >= 31) ? ((t - 31) >> 4) : -1;
    const int cmax_last = (t0 + 7 >= 31) ? ((t0 + 7 - 31) >> 4) : -1;
    const int ntc = (cmax_last >= 0) ? (cmax_last >> 5) + 1 : 0;
    const int ntc1 = (mode & 1u) ? ntc : 0, ntc2 = (mode & 2u) ? ntc : 0;
    const char* kcb = (const char*)(F.ws + WS_KCMP) + (size_t)b * 65536; const char* vcb = (const char*)(F.ws + WS_VCMP) + (size_t)b * 65536;
    soft_init(st);
#define CMP_PTRS(i, kp, vp) do { kp = kcb + (i) * 4096; vp = vcb + (i) * 4096; } while (0)
#define CMP_BODY(i, KF, VF) do { f32x16 s = qk_tile(KF, qf); _Pragma("unroll") for (int r = 0; r < 16; ++r) s[r] = (32 * (i) + CROW(r, hi) <= cmax) ? s[r] * QK_C : -INFINITY; soft_pv(st, s, VF); } while (0)
    PIPE3(ntc1, CMP_PTRS, CMP_BODY);
#undef CMP_PTRS
#undef CMP_BODY
    float inv;
    { const float lt = half_sum(st.l); inv = lt > 0.f ? 1.0f / lt : 0.f; const float sc = g0 * inv;
#pragma unroll
      for (int r = 0; r < 16; ++r) { otl[r * 64] = st.o0[r] * sc; otl[(16 + r) * 64] = st.o1[r] * sc; } }
    const float mfin = st.m;
    for (int i = F.lane; i < 8 * 128; i += 64) imp[i] = 0.f;
    LDS_WAIT(); asm volatile("" ::: "memory");
    { float carry = 0.f;
      if (ntc2 > 0) {
#pragma unroll
        for (int i = 0; i < 4; ++i) kfA[i] = *(const bf16x8v*)(kcb + i * 1024 + F.lane * 16); }
#pragma unroll 1
      for (int ct = 0; ct < ntc2; ++ct) {
        { const int cq = ct + 1 < ntc2 ? ct + 1 : ct;
#pragma unroll
            for (int i = 0; i < 4; ++i) kfB[i] = *(const bf16x8v*)(kcb + cq * 4096 + i * 1024 + F.lane * 16); }
        f32x16 s = qk_tile(kfA, qf);
#pragma unroll
        for (int i = 0; i < 4; ++i) kfA[i] = kfB[i];
        float Sg[4], X[4];
#pragma unroll
        for (int r = 0; r < 16; ++r) { float p = (32 * ct + CROW(r, hi) <= cmax) ? __builtin_amdgcn_exp2f(s[r] * QK_C - mfin) * inv : 0.f; p += quad_xor1(p); p += quad_xor2(p); s[r] = p; }
#pragma unroll
        for (int g = 0; g < 4; ++g) { Sg[g] = (s[4 * g] + s[4 * g + 1]) + (s[4 * g + 2] + s[4 * g + 3]); X[g] = half_other(s[4 * g + 3], hi); }
        if (head == 0) {
#pragma unroll
            for (int g = 0; g < 4; ++g) { const float prev = hi ? X[g] : (g > 0 ? X[g > 0 ? g - 1 : 0] : carry); imp[qi * 128 + 8 * ct + 2 * g + hi] = Sg[g] + prev; }
        }
        carry = X[3];
      }
      if (head == 0 && hi == 0 && 8 * ntc < 128) imp[qi * 128 + 8 * ntc] = carry;
    }
    LDS_WAIT(); asm volatile("" ::: "memory");
    const int cur = t0 >> 6; const int n_pick = (mode & 2u) ? ((cur + 1 < 16) ? cur + 1 : 16) : 0;
    { const int nforced = cur >= 2 ? 3 : cur + 1; const int need = n_pick - nforced;
#pragma unroll 1
      for (int q = 0; q < 8; ++q) {
          unsigned long long s0 = 0ull, s1 = 0ull;
          if (need > 0) {
              const int j0 = F.lane, j1 = 64 + F.lane;
              const unsigned v0 = (j0 >= 1 && j0 <= cur - 2) ? __float_as_uint(imp[q * 128 + j0]) : 0u, v1 = (j1 <= cur - 2) ? __float_as_uint(imp[q * 128 + j1]) : 0u;
              unsigned T = 0u;
#pragma unroll 1
              for (int bit = 30; bit >= 0; --bit) { const unsigned cand = T | (1u << bit);
                  const int cnt = __popcll(__ballot(v0 >= cand)) + __popcll(__ballot(v1 >= cand)); if (cnt >= need) T = cand; }
              s0 = __ballot(T != 0u && v0 >= T); s1 = __ballot(T != 0u && v1 >= T);
          }
          unsigned w0 = (unsigned)s0 | 1u, w1 = (unsigned)(s0 >> 32), w2 = (unsigned)s1, w3 = (unsigned)(s1 >> 32);
          if (n_pick > 0) {
#pragma unroll
              for (int f = 0; f < 2; ++f) { const int jf = cur - f; if (jf >= 1) { const unsigned bb = 1u << (jf & 31); if ((jf >> 5) == 0) w0 |= bb; else if ((jf >> 5) == 1) w1 |= bb; else if ((jf >> 5) == 2) w2 |= bb; else w3 |= bb; } }
          }
          if (F.lane == 0) { selm[q * 4 + 0] = w0; selm[q * 4 + 1] = w1; selm[q * 4 + 2] = w2; selm[q * 4 + 3] = w3; }
      }
      LDS_WAIT(); asm volatile("" ::: "memory");
    }
    unsigned mk[4], uni[4];
#pragma unroll
    for (int w = 0; w < 4; ++w) { mk[w] = selm[qi * 4 + w]; unsigned u = mk[w]; u |= (unsigned)swz_xor_i<4>((int)u); u |= (unsigned)swz_xor_i<8>((int)u); u |= (unsigned)swz_xor_i<16>((int)u); uni[w] = (unsigned)__builtin_amdgcn_readfirstlane((int)u); }
    { const float* rc = (const float*)(F.ws + WS_ROPE_C) + (size_t)tg * 8; const float* rs = (const float*)(F.ws + WS_ROPE_S) + (size_t)tg * 8; float nv[8];
#pragma unroll
      for (int j = 0; j < 8; ++j) { const float mine = bf2f((unsigned short)qf[0][j]); const float oth = half_other(mine, hi); const float c = rc[j], sn = rs[j]; nv[j] = hi ? (mine * c + oth * sn) : (mine * c - oth * sn); }
      v4u w;
#pragma unroll
      for (int k = 0; k < 4; ++k) w[k] = pk2(nv[2 * k], nv[2 * k + 1]);
      qf[0] = __builtin_bit_cast(bf16x8v, w); }
    float mfs, mfw;
    { float qn = 0.f, g2m = 0.f, g3m = 0.f;
#pragma unroll
      for (int i = 0; i < 4; ++i)
#pragma unroll
          for (int j = 0; j < 8; ++j) { const float v = bf2f((unsigned short)qf[i][j]); qn += v * v; }
      qn = sqrtf(half_sum(qn));
      for (int d = 0; d < 64; ++d) { g2m = fmaxf(g2m, fabsf(qk_gain[2 * 64 + d])); g3m = fmaxf(g3m, fabsf(qk_gain[3 * 64 + d])); }
      mfs = qn * (8.0f * g2m) * QK_C * 1.02f; mfw = qn * (8.0f * g3m) * QK_C * 1.02f; }
    soft_init(st);
    { LAS int* blist = (LAS int*)(F.lds + F.wave * 5120 + 4096 + 128);
      const int c0 = __builtin_popcount(uni[0]), c1 = __builtin_popcount(uni[1]), c2 = __builtin_popcount(uni[2]), c3 = __builtin_popcount(uni[3]);
#pragma unroll
      for (int w2 = 0; w2 < 2; ++w2) { const int jb = F.lane + 64 * w2, wd = jb >> 5, bit = jb & 31;
          const unsigned uw = wd == 0 ? uni[0] : wd == 1 ? uni[1] : wd == 2 ? uni[2] : uni[3]; const int below = wd == 0 ? 0 : wd == 1 ? c0 : wd == 2 ? c0 + c1 : c0 + c1 + c2;
          if ((uw >> bit) & 1u) blist[below + __builtin_popcount(uw & ((1u << bit) - 1u))] = jb; }
      LDS_WAIT(); asm volatile("" ::: "memory");
      const int nblk = c0 + c1 + c2 + c3;
#define SEL_PTRS(i, kp, vp) do { const int jb_ = __builtin_amdgcn_readfirstlane(blist[(i) >> 1]); kp = stream_tile(F, 0, b, 2 * jb_ + ((i) & 1)); vp = stream_tile(F, 1, b, 2 * jb_ + ((i) & 1)); } while (0)
#define SEL_BODY(i, KF, VF) do { const int jb_ = __builtin_amdgcn_readfirstlane(blist[(i) >> 1]); const int wd_ = jb_ >> 5; const unsigned mkw_ = wd_ == 0 ? mk[0] : wd_ == 1 ? mk[1] : wd_ == 2 ? mk[2] : mk[3]; \
        const float cb_ = ((mkw_ >> (jb_ & 31)) & 1u) ? -mfs : -INFINITY; f32x16 s = qk_tile(KF, qf); \
        if (jb_ == cur) { _Pragma("unroll") for (int r = 0; r < 16; ++r) s[r] = (64 * jb_ + 32 * ((i) & 1) + CROW(r, hi) <= t) ? (s[r] * QK_C + cb_) : -INFINITY; } \
        else { _Pragma("unroll") for (int r = 0; r < 16; ++r) s[r] = s[r] * QK_C + cb_; } \
        fixed_pv(st, s, VF); } while (0)
      PIPE3((mode & 4u) ? 2 * nblk : 0, SEL_PTRS, SEL_BODY);
#undef SEL_PTRS
#undef SEL_BODY
    }
    { const float lt = half_sum(st.l); const float sc = g1 / lt;
#pragma unroll
      for (int r = 0; r < 16; ++r) { otl[r * 64] += st.o0[r] * sc; otl[(16 + r) * 64] += st.o1[r] * sc; } }
    soft_init(st);
    { const int lo_t = (t0 >= 511 ? t0 - 511 : 0) >> 5, hi_t = (t0 + 7) >> 5;
#define WIN_PTRS(i, kp, vp) do { kp = stream_tile(F, 2, b, lo_t + (i)); vp = stream_tile(F, 3, b, lo_t + (i)); } while (0)
#define WIN_BODY(i, KF, VF) do { f32x16 s = qk_tile(KF, qf); const int k0_ = 32 * (lo_t + (i)); \
        if (k0_ + 31 > t0 || k0_ + 511 < t0 + 7) { _Pragma("unroll") for (int r = 0; r < 16; ++r) { const int kp2 = k0_ + CROW(r, hi); s[r] = (kp2 <= t && kp2 + 511 >= t) ? (s[r] * QK_C - mfw) : -INFINITY; } } \
        else { _Pragma("unroll") for (int r = 0; r < 16; ++r) s[r] = s[r] * QK_C - mfw; } \
        fixed_pv(st, s, VF); } while (0)
      PIPE3((mode & 8u) ? hi_t - lo_t + 1 : 0, WIN_PTRS, WIN_BODY);
#undef WIN_PTRS
#undef WIN_BODY
    }
    { const float lt = half_sum(st.l); const float sc = g2 / lt;
#pragma unroll
      for (int r = 0; r < 16; ++r) { st.o0[r] = otl[r * 64] + st.o0[r] * sc; st.o1[r] = otl[(16 + r) * 64] + st.o1[r] * sc; } }
    if (mode & 16u) store_ot(O + (size_t)tg * 1024 + 64 * head, st.o0, st.o1, 1.0f, hi);
    LDS_WAIT(); asm volatile("" ::: "memory");
}

__device__ __forceinline__ int pack_tok(int mode, int tile, int i) {
    if (mode == 0) return 32 * tile + i;
    if (mode == 1) return (tile >> 6) + 4 * (32 * (tile & 63) + i);
    return (tile >> 4) + 16 * (32 * (tile & 15) + i);
}
__device__ __forceinline__ void norm_rope_row(const bf16* src, const float* gain, bool rope, const float* rc, const float* rs, int hi, v4u (&w)[4]) {
    float v[4][8]; float ss = 0.f;
#pragma unroll
    for (int d0 = 0; d0 < 4; ++d0) { const v4u raw = *(const v4u*)(src + 16 * d0 + 8 * hi);
#pragma unroll
        for (int k = 0; k < 4; ++k) { v[d0][2 * k] = __uint_as_float(raw[k] << 16); v[d0][2 * k + 1] = __uint_as_float(raw[k] & 0xffff0000u); ss += v[d0][2 * k] * v[d0][2 * k] + v[d0][2 * k + 1] * v[d0][2 * k + 1]; } }
    if (gain) {
        ss = half_sum(ss); const float rinv = 1.0f / sqrtf(ss * (1.f / 64.f) + EPS);
#pragma unroll
        for (int d0 = 0; d0 < 4; ++d0) { const f32x4 ga = *(const f32x4*)(gain + 16 * d0 + 8 * hi), gb = *(const f32x4*)(gain + 16 * d0 + 8 * hi + 4);
#pragma unroll
            for (int j = 0; j < 4; ++j) { v[d0][j] = v[d0][j] * rinv * ga[j]; v[d0][4 + j] = v[d0][4 + j] * rinv * gb[j]; } }
    }
    if (rope) {
#pragma unroll
        for (int j = 0; j < 8; ++j) { const float mine = v[0][j], oth = half_other(mine, hi), c = rc[j], sn = rs[j]; v[0][j] = hi ? (mine * c + oth * sn) : (mine * c - oth * sn); }
    }
#pragma unroll
    for (int d0 = 0; d0 < 4; ++d0)
#pragma unroll
        for (int k = 0; k < 4; ++k) w[d0][k] = pk2(v[d0][2 * k], v[d0][2 * k + 1]);
}
__device__ __forceinline__ void phase_pack(Frame& F, const float* fox_b, const float* qk_gain) {
    bf16* P = (bf16*)(F.ws + WS_PROJ); const float* rc = (const float*)(F.ws + WS_ROPE_C); const float* rs = (const float*)(F.ws + WS_ROPE_S);
    const int pgw = F.gw, pN = F.NGW;
    for (int it = pgw; it < 12 * 512; it += pN) {
        const int qs = it >> 9, tt = it & 511, r32 = F.lane & 31, hi = F.lane >> 5; const int tokg = 32 * tt + r32;
        const int col = (qs < 4) ? C_NSAQ + 64 * qs : (qs < 8) ? C_BQ + 64 * (qs - 4) : C_DQ + 64 * (qs - 8); const int gi = (qs < 4) ? 0 : (qs < 8) ? 4 : 6;
        bf16* row = P + (size_t)tokg * NP + col; v4u w[4];
        norm_rope_row(row, qk_gain + gi * 64, qs >= 4 && qs < 8, rc + (size_t)tokg * 8, rs + (size_t)tokg * 8, hi, w);
#pragma unroll
        for (int d0 = 0; d0 < 4; ++d0) *(v4u*)(row + 16 * d0 + 8 * hi) = w[d0];
    }
    LAS unsigned char* vs = F.lds + 90112 + F.wave * 4608;
    for (int it = pgw; it < 44 * 512; it += pN) {
        const int sid = it >> 9, b = (it >> 8) & 1, tile = it & 255;
        int col, isv, mode, gi = -1; bool rope = false;
        if (sid < 4) { col = (sid == 0) ? C_KSL : (sid == 1) ? C_VSL : (sid == 2) ? C_KW : C_VW; isv = sid & 1; mode = 0; gi = (sid == 0) ? 2 : 3; rope = true; }
        else if (sid < 16) { col = C_BK + 64 * (sid & 3); isv = 0; mode = (sid - 4) >> 2; gi = 5; rope = true; }
        else if (sid < 28) { col = C_BV + 64 * (sid & 3); isv = 1; mode = (sid - 16) >> 2; }
        else if (sid < 32) { col = C_CK + 64 * (sid & 3); isv = 0; mode = 0; }
        else if (sid < 36) { col = C_CV + 64 * (sid & 3); isv = 1; mode = 0; }
        else if (sid < 40) { col = C_DK + 64 * (sid & 3); isv = 0; mode = 0; gi = 7; }
        else { col = C_DV + 64 * (sid & 3); isv = 1; mode = 0; }
        char* dst = (char*)(F.ws + WS_TILED) + (size_t)sid * (2 * MiB) + (size_t)b * MiB + (size_t)tile * 4096;
        if (!isv) {
            const int r32 = F.lane & 31, hi = F.lane >> 5; const int tokg = b * SEQ + pack_tok(mode, tile, r32);
            v4u w[4]; norm_rope_row(P + (size_t)tokg * NP + col, gi >= 0 ? qk_gain + gi * 64 : nullptr, rope, rc + (size_t)tokg * 8, rs + (size_t)tokg * 8, hi, w);
#pragma unroll
            for (int d0 = 0; d0 < 4; ++d0) *(v4u*)(dst + d0 * 1024 + F.lane * 16) = w[d0];
        } else {
            const int key = F.lane >> 1, half = F.lane & 1; const bf16* src = P + (size_t)(b * SEQ + pack_tok(mode, tile, key)) * NP + col + 32 * half;
#pragma unroll
            for (int i = 0; i < 4; ++i) *(LAS v4u*)(vs + key * 144 + half * 64 + i * 16) = *(const v4u*)(src + 8 * i);
            LDS_WAIT(); asm volatile("" ::: "memory");
            const int r32 = F.lane & 31, hi = F.lane >> 5;
#pragma unroll
            for (int f = 0; f < 4; ++f) { const int db = f >> 1, s2 = f & 1; v4u w;
#pragma unroll
                for (int k = 0; k < 4; ++k) { const int j0 = 2 * k, j1 = 2 * k + 1;
                    const int k0 = 16 * s2 + 8 * (j0 >> 2) + 4 * hi + (j0 & 3), k1 = 16 * s2 + 8 * (j1 >> 2) + 4 * hi + (j1 & 3);
                    const unsigned e0 = *(const LAS unsigned short*)(vs + k0 * 144 + (32 * db + r32) * 2), e1 = *(const LAS unsigned short*)(vs + k1 * 144 + (32 * db + r32) * 2);
                    w[k] = e0 | (e1 << 16); }
                *(v4u*)(dst + f * 1024 + F.lane * 16) = w; }
            LDS_WAIT(); asm volatile("" ::: "memory");
        }
    }
    {
        float* LCo = (float*)(F.ws + WS_LC); float* TCo = (float*)(F.ws + WS_TC);
        for (int it = pgw; it < 2 * 256; it += pN) {
            const int b = it >> 8, ch = it & 255, i = F.lane & 31;
            const bf16* prow = P + (size_t)(b * SEQ + 32 * ch + i) * NP + C_DF;
#pragma unroll
            for (int h = 0; h < 4; ++h) {
                const float v = log_sigmoid(bf2f(prow[h]) + fox_b[h]) * LOG2E;
                LAS float* sc = (LAS float*)(vs);
                if (F.lane < 32) sc[i] = v;
                LDS_WAIT(); asm volatile("" ::: "memory");
                float acc = 0.f;
                for (int k = 0; k < 32; ++k) { const float x = sc[k]; acc += (k <= i) ? x : 0.f; }
                LDS_WAIT(); asm volatile("" ::: "memory");
                if (F.lane < 32) { LCo[((size_t)b * 4 + h) * SEQ + 32 * ch + i] = acc; if (i == 31) TCo[((size_t)b * 4 + h) * 256 + ch] = acc; }
            }
        }
    }
}

__device__ __forceinline__ void phase_attention(Frame& F, const float* fox_b, const float* qk_gain, unsigned dupm) {
    const int vgw = ((F.G & 7) == 0 ? ((F.bx & 7) * (F.G >> 3) + (F.bx >> 3)) : F.bx) * NWAVES + F.wave;
    const int xty = (dupm >> 24) & 7u, nit = 4 * 2048 + (xty ? 2048 : 0);
    for (int it = vgw; it < nit; it += F.NGW) {
        const int ty = it < 8192 ? (it >> 11) : xty - 1, sub = it & 2047;
        if (ty == 0) attn_nsa_unit(F, sub, qk_gain, it < 8192 ? 31u : (dupm >> 28));
        else if (ty == 1) attn_dil_unit(F, sub, qk_gain + 5 * 64);
        else if (ty == 2) attn_fox_unit(F, sub, qk_gain + 7 * 64);
        else attn_sb_unit(F, sub);
    }
}

__device__ __forceinline__ void phase_combine(Frame& F, float* out, const float* gate) {
    const bf16* Y = (const bf16*)(F.ws + WS_Y); const int* info = (const int*)(F.ws + WS_TOKINFO);
    int pre[8]; { int p = 0;
#pragma unroll
        for (int e = 0; e < 8; ++e) { int n = (int)__hip_atomic_load(F.ctl + CW_MOECNT + 64 * e, RLX_AGENT); if (n > 16384) n = 16384; pre[e] = p; p += (n + 255) >> 8; } }
    for (int m = F.gw; m < M; m += F.NGW) {
        const int b = m >> 13; const int* ip = info + (size_t)m * 8;
        const int e0 = ip[0], r0 = ip[1], e1 = ip[4], r1 = ip[5]; const float g0 = __int_as_float(ip[2]), g1 = __int_as_float(ip[6]);
        int p0 = 0, p1 = 0;
#pragma unroll
        for (int e = 0; e < 8; ++e) { if (e == e0) p0 = pre[e]; if (e == e1) p1 = pre[e]; }
        const bf16* y0 = Y + ((size_t)p0 * 256 + r0) * 1024; const bf16* y1 = Y + ((size_t)p1 * 256 + r1) * 1024;
#pragma unroll
        for (int j = 0; j < 4; ++j) { const int c = 4 * F.lane + 256 * j;
            const uint2 a0 = *(const uint2*)(y0 + c), a1 = *(const uint2*)(y1 + c); const f32x4 gv = *(const f32x4*)(gate + (size_t)b * 6144 + c); f32x4 xv = *(const f32x4*)(out + (size_t)m * D + c);
            xv.x += gv.x * (g0 * __uint_as_float(a0.x << 16) + g1 * __uint_as_float(a1.x << 16));
            xv.y += gv.y * (g0 * __uint_as_float(a0.x & 0xffff0000u) + g1 * __uint_as_float(a1.x & 0xffff0000u));
            xv.z += gv.z * (g0 * __uint_as_float(a0.y << 16) + g1 * __uint_as_float(a1.y << 16));
            xv.w += gv.w * (g0 * __uint_as_float(a0.y & 0xffff0000u) + g1 * __uint_as_float(a1.y & 0xffff0000u));
            *(f32x4*)(out + (size_t)m * D + c) = xv; }
    }
}

constexpr int PH_PER_LAYER = 11, N_PHASES = 1 + 2 * PH_PER_LAYER;
extern __shared__ __attribute__((aligned(16))) unsigned char lds_dyn[];
#define SITE_PROLOGUE() Frame F; ArgsP ap = (ArgsP)__builtin_amdgcn_kernarg_segment_ptr(); asm volatile("" : "+s"(ap)); l = __builtin_amdgcn_readfirstlane(l); \
    F.lds = (LAS unsigned char*)lds_dyn; F.lane = lane_id_fresh(); F.wave = wave0; F.tid = F.wave * 64 + F.lane; \
    { int bx_ = blockIdx.x; asm volatile("" : "+s"(bx_)); F.bx = bx_; } F.G = gridDim.x; F.gw = F.bx * NWAVES + F.wave; F.NGW = F.G * NWAVES; F.ws = ap->ws; F.ctl = (gu32*)(F.ws + WS_CTL); \
    float* const out = ap->out; const float* const modl = (const float*)(F.ws + WS_MOD) + (size_t)l * 2 * 6144; (void)out; (void)modl
static __device__ __forceinline__ void site_prologue(int l, int wave0) { SITE_PROLOGUE(); phase_prologue(F, ap); }
static __device__ __forceinline__ void site_norm_mix(int l, int wave0) { SITE_PROLOGUE(); const float* xin = (l == 0) ? (const float*)ap->in[0] : (const float*)out;
    phase_norm<false>(F, xin, (const float*)ap->in[5] + l * 1024, modl + 0, modl + 1024, nullptr); }
static __device__ __forceinline__ void site_gemm_in(int l, int wave0) { SITE_PROLOGUE();
    pg8::Gemm g{(const bf16*)(F.ws + WS_H), (const bf16*)(F.ws + WS_WIN) + (size_t)l * NP * 1024, 1024, 1024}; pg8::StaticOrder S; S.init(M, NP, F.G, F.bx);
    pg8::EpiStoreMG E{(bf16*)(F.ws + WS_PROJ), NP};
    pg8::gemm_phase<pg8::EpiStoreMG, pg8::StaticOrder, true, false>(F.lds, g, S, E, F.tid); }
static __device__ __forceinline__ void site_compress(int l, int wave0) { SITE_PROLOGUE();
    phase_compress(F, l, (const float*)ap->in[9] + l * 2048, (const float*)ap->in[10] + l * 2048, (const float*)ap->in[12] + l * 128 * 64, (const float*)ap->in[14] + l * 128 * 64, (const float*)ap->in[8] + l * 512 + 64);
    phase_pack(F, (const float*)ap->in[15] + l * 4, (const float*)ap->in[8] + l * 512); }
static __device__ __forceinline__ void site_attention(int l, int wave0) { SITE_PROLOGUE(); phase_attention(F, (const float*)ap->in[15] + l * 4, (const float*)ap->in[8] + l * 512, ap->dup); }
static __device__ __forceinline__ void site_gemm_branch(int l, int wave0) { SITE_PROLOGUE();
    pg8::Gemm g{(const bf16*)(F.ws + WS_O), (const bf16*)(F.ws + WS_WBR) + (size_t)l * 1024 * 1024, 1024, 1024}; pg8::StaticOrder S; S.init(M, 1024, F.G, F.bx);
    pg8::EpiGateMerge E{(const bf16*)(F.ws + WS_PROJ), NP, C_MG, (bf16*)(F.ws + WS_H)};
    pg8::gemm_phase<pg8::EpiGateMerge, pg8::StaticOrder, false, false>(F.lds, g, S, E, F.tid); }
static __device__ __forceinline__ void site_gemm_out(int l, int wave0) { SITE_PROLOGUE(); const float* xin = (l == 0) ? (const float*)ap->in[0] : (const float*)out;
    pg8::Gemm g{(const bf16*)(F.ws + WS_H), (const bf16*)(F.ws + WS_WOUT) + (size_t)l * 1024 * 1024, 1024, 1024}; pg8::StaticOrder S; S.init(M, 1024, F.G, F.bx);
    pg8::EpiResid E{xin, out, modl + 2048, 6144};
    pg8::gemm_phase<pg8::EpiResid, pg8::StaticOrder, false, false>(F.lds, g, S, E, F.tid); }
static __device__ __forceinline__ void site_norm_ffn(int l, int wave0) { SITE_PROLOGUE();
    if (l == 0) phase_norm<false>(F, out, (const float*)ap->in[6] + l * 1024, modl + 3 * 1024, modl + 4 * 1024, nullptr);
    else { phase_norm<true>(F, out, (const float*)ap->in[6] + l * 1024, modl + 3 * 1024, modl + 4 * 1024, (const float*)ap->in[21]); phase_moe_weights(F, ap); if ((ap->dup >> 27) & 1u) phase_moe_weights(F, ap); } }
static __device__ __forceinline__ void site_gemm_up_dense(int l, int wave0) { SITE_PROLOGUE();
    pg8::Gemm g{(const bf16*)(F.ws + WS_H), (const bf16*)(F.ws + WS_W13), 1024, 1024}; pg8::StaticOrder S; S.init(M, 2 * DFF, F.G, F.bx);
    pg8::EpiSwiglu E{(bf16*)(F.ws + WS_HMID), DFF};
    pg8::gemm_phase<pg8::EpiSwiglu, pg8::StaticOrder, true, false>(F.lds, g, S, E, F.tid); }
static __device__ __forceinline__ void site_gemm_up_moe(int l, int wave0) { SITE_PROLOGUE();
    pg8::Gemm g{(const bf16*)(F.ws + WS_H), (const bf16*)(F.ws + WS_MOEW13), 1024, 1024}; pg8::MoeOrder S; S.init((unsigned*)(F.ctl + CW_MOECNT), (const int*)(F.ws + WS_LIST), 2 * DFF / 256, (size_t)2 * DFF * 1024, F.G, F.bx);
    pg8::EpiSwiglu E{(bf16*)(F.ws + WS_HMID_MOE), DFF};
    pg8::gemm_phase<pg8::EpiSwiglu, pg8::MoeOrder, true, true>(F.lds, g, S, E, F.tid); }
static __device__ __forceinline__ void site_gemm_down_dense(int l, int wave0) { SITE_PROLOGUE();
    pg8::Gemm g{(const bf16*)(F.ws + WS_HMID), (const bf16*)(F.ws + WS_W2), DFF, DFF}; pg8::StaticOrder S; S.init(M, 1024, F.G, F.bx);
    pg8::EpiResid E{out, out, modl + 5 * 1024, 6144};
    pg8::gemm_phase<pg8::EpiResid, pg8::StaticOrder, false, false>(F.lds, g, S, E, F.tid); }
static __device__ __forceinline__ void site_gemm_down_moe(int l, int wave0) { SITE_PROLOGUE();
    pg8::Gemm g{(const bf16*)(F.ws + WS_HMID_MOE), (const bf16*)(F.ws + WS_MOEW2), DFF, DFF}; pg8::MoeOrder S; S.init((unsigned*)(F.ctl + CW_MOECNT), (const int*)(F.ws + WS_LIST), 4, (size_t)1024 * DFF, F.G, F.bx);
    pg8::EpiStore E{(bf16*)(F.ws + WS_Y), 1024};
    pg8::gemm_phase<pg8::EpiStore, pg8::MoeOrder, true, false>(F.lds, g, S, E, F.tid); }
static __device__ __forceinline__ void site_combine(int l, int wave0) { SITE_PROLOGUE(); phase_combine(F, out, modl + 5 * 1024); }

__global__ void __launch_bounds__(NWAVES * 64, 2) fwd_kernel(Args args_unused) {
    (void)args_unused;
    const ArgsP ap0 = (ArgsP)__builtin_amdgcn_kernarg_segment_ptr();
    const int wave0 = __builtin_amdgcn_readfirstlane((int)threadIdx.x >> 6);
    LAS unsigned char* lds = (LAS unsigned char*)lds_dyn;
    volatile LAS unsigned* MISC = (volatile LAS unsigned*)(lds + MISC_OFF);
    for (int u = wave0 * 64 + lane_id_fresh(); u < (LDS_BYTES - RING_BYTES) / 4; u += NWAVES * 64) ((LAS unsigned*)(lds + RING_BYTES))[u] = 0u;
    __syncthreads();
    const int lo = ap0->ph_lo, hi = ap0->ph_hi; const unsigned dupm = ap0->dup;
    unsigned* barw = (unsigned*)(ap0->ws + WS_CTL) + CW_BAR;
    XcdBarrier bar; bar.bar = barw; bar.x = 0; bar.st = nullptr;
#define LEADER() (wave0 == 0 && lane_id_fresh() == 0)
    if (hi - lo > 1) bar = xcd_barrier_post(barw, MISC + 8, LEADER());
#define IN(k) (lo <= (k) && (k) < hi)
#define SEAM(k) do { if (IN(k) && IN((k) + 1)) xcd_barrier(bar, LEADER()); } while (0)
    { const int l = 0; if (PHON(0) && IN(0)) { for (int rep_ = 0; rep_ <= (int)DUP(0); ++rep_) { if (rep_) xcd_barrier(bar, LEADER()); site_prologue(0, wave0); } } }
    SEAM(0);
    for (int l = 0; l < 2; ++l) {
        const int pb = 1 + l * PH_PER_LAYER;
        if (PHON(1) && IN(pb + 0)) { for (int rep_ = 0; rep_ <= (int)DUP(1); ++rep_) { if (rep_) xcd_barrier(bar, LEADER()); site_norm_mix(l, wave0); } }
        SEAM(pb + 0);
        if (PHON(2) && IN(pb + 1)) { for (int rep_ = 0; rep_ <= (int)DUP(2); ++rep_) { if (rep_) xcd_barrier(bar, LEADER()); site_gemm_in(l, wave0); } }
        if (IN(pb + 1) && IN(pb + 3)) xcd_barrier(bar, LEADER());
        if (PHON(4) && IN(pb + 3)) { for (int rep_ = 0; rep_ <= (int)DUP(4); ++rep_) { if (rep_) xcd_barrier(bar, LEADER()); site_compress(l, wave0); } }
        SEAM(pb + 3);
        if (PHON(5) && IN(pb + 4)) { for (int rep_ = 0; rep_ <= (int)DUP(5); ++rep_) { if (rep_) xcd_barrier(bar, LEADER()); site_attention(l, wave0); } }
        SEAM(pb + 4);
        if (PHON(6) && IN(pb + 5)) { for (int rep_ = 0; rep_ <= (int)DUP(6); ++rep_) { if (rep_) xcd_barrier(bar, LEADER()); site_gemm_branch(l, wave0); } }
        SEAM(pb + 5);
        if (PHON(7) && IN(pb + 6)) { for (int rep_ = 0; rep_ <= (int)DUP(7); ++rep_) { if (rep_) xcd_barrier(bar, LEADER()); site_gemm_out(l, wave0); } }
        SEAM(pb + 6);
        if (PHON(8) && IN(pb + 7)) { for (int rep_ = 0; rep_ <= (int)DUP(8); ++rep_) { if (rep_) xcd_barrier(bar, LEADER()); site_norm_ffn(l, wave0); } }
        SEAM(pb + 7);
        if (PHON(9) && IN(pb + 8)) { for (int rep_ = 0; rep_ <= (int)DUP(9); ++rep_) { if (rep_) xcd_barrier(bar, LEADER()); if (l == 0) site_gemm_up_dense(l, wave0); else site_gemm_up_moe(l, wave0); } }
        SEAM(pb + 8);
        if (PHON(10) && IN(pb + 9)) { for (int rep_ = 0; rep_ <= (int)DUP(10); ++rep_) { if (rep_) xcd_barrier(bar, LEADER()); if (l == 0) site_gemm_down_dense(l, wave0); else site_gemm_down_moe(l, wave0); } }
        SEAM(pb + 9);
        if (PHON(11) && IN(pb + 10)) { if (l == 1) site_combine(l, wave0); }
    }
#undef IN
#undef SEAM
}

extern "C" void kernel_launch(void* const* d_in, const int* in_sizes, int n_in, void* d_out, int out_size, void* d_ws, size_t ws_size, hipStream_t stream) {
    static int grid = 0;
    if (grid == 0) {
        if (n_in != 25 || out_size != M * D || ws_size < WS_END) { fprintf(stderr, "kernel_launch: unexpected problem (n_in %d, out %d, ws %zu < %zu)\n", n_in, out_size, ws_size, (size_t)WS_END); grid = -1; return; }
        int dev = 0, cus = 0, per_cu = 0;
        if (hipGetDevice(&dev) != hipSuccess || hipDeviceGetAttribute(&cus, hipDeviceAttributeMultiprocessorCount, dev) != hipSuccess) { grid = -1; return; }
        if (hipFuncSetAttribute((const void*)fwd_kernel, hipFuncAttributeMaxDynamicSharedMemorySize, LDS_BYTES) != hipSuccess) { fprintf(stderr, "kernel_launch: hipFuncSetAttribute failed\n"); grid = -1; return; }
        if (hipOccupancyMaxActiveBlocksPerMultiprocessor(&per_cu, (const void*)fwd_kernel, NWAVES * 64, LDS_BYTES) != hipSuccess || per_cu < 1) fprintf(stderr, "kernel_launch: occupancy query reports %d\n", per_cu);
        (void)hipGetLastError();
        grid = cus;
    }
    if (grid < 0) return;
    if (hipMemsetAsync((char*)d_ws + WS_CTL, 0, CTL_ZERO_BYTES, stream) != hipSuccess) return;
    Args a{};
    for (int i = 0; i < 25; ++i) a.in[i] = d_in[i];
    a.out = (float*)d_out; a.ws = (unsigned char*)d_ws; a.dup = DUPMASK; a.pad = 0;
#if MK_ONE_LAUNCH
    a.ph_lo = 0; a.ph_hi = N_PHASES;
    hipLaunchKernelGGL(fwd_kernel, dim3(grid), dim3(NWAVES * 64), LDS_BYTES, stream, a);
#else
    for (int p = 0; p < N_PHASES; ++p) {
        if (p == 1 + 10) continue;
        a.ph_lo = p; a.ph_hi = p + 1;
        hipLaunchKernelGGL(fwd_kernel, dim3(grid), dim3(NWAVES * 64), LDS_BYTES, stream, a);
    }
#endif
}
```
